# Optimizing an MI355X kernel written in HIP

```python
import math
import jax, jax.numpy as jnp
from jax import lax
import numpy as np

D_MODEL = 1024
BATCH = 4
SEQ = 8192
DEPTH = 2
DEC_BATCH = 2
DEC_SEQ = 8192
PAST_LEN = 128

N_GROUPS = 4
GROUP_W = D_MODEL // N_GROUPS
D_MIX = N_GROUPS * GROUP_W
HEAD_DIM = 64
N_HEADS_G = GROUP_W // HEAD_DIM
FNET_BLOCKS = 4
FNET_BLOCK_W = GROUP_W // FNET_BLOCKS
GDN_CHUNK = 64
CONV_K = 5
GRID_W = 64
NA_KH_MAX = 8
NA_KW = 16
N_MEM = 256
MEM_HEADS = 4
MEM_HEAD_DIM = GROUP_W // MEM_HEADS
EPS = 1e-6

N_GATE_COLS = 4 * N_HEADS_G
IN_SPLITS = (GROUP_W, 2 * GROUP_W, 5 * GROUP_W, 6 * GROUP_W, 6 * GROUP_W + N_GATE_COLS,
             9 * GROUP_W + N_GATE_COLS, 10 * GROUP_W + N_GATE_COLS, 11 * GROUP_W + N_GATE_COLS)
D_IN = 12 * GROUP_W + N_GATE_COLS

kernel_name = 'hybrid_fnet_gdn_natten_mem_encoder'


def rms_norm(x, g):
    xf = x.astype(jnp.float32)
    y = xf * lax.rsqrt(jnp.mean(xf * xf, axis=-1, keepdims=True) + EPS)
    return (y * g.astype(jnp.float32)).astype(x.dtype)


def l2_norm(x):
    return x * lax.rsqrt(jnp.sum(x * x, axis=-1, keepdims=True) + EPS)


def fourier_mix(u, w_fnet):
    b, l, _ = u.shape
    ub = u.astype(jnp.float32).reshape(b, l, FNET_BLOCKS, FNET_BLOCK_W)
    f = jnp.fft.fft2(ub, axes=(1, 3), norm='ortho').real
    return f.reshape(b, l, GROUP_W).astype(u.dtype) @ w_fnet


def centred_dwconv(x, w):
    pad = CONV_K // 2
    return lax.conv_general_dilated(x, w[:, None, :].astype(x.dtype), window_strides=(1,),
                                    padding=[(pad, pad)], dimension_numbers=('NWC', 'WIO', 'NWC'),
                                    feature_group_count=x.shape[-1])


def gdn_chunked(q, k, v, g, beta):
    b, l, h, dk = q.shape
    dv = v.shape[-1]
    c = GDN_CHUNK
    n = l // c

    def to_chunks(t):
        return jnp.moveaxis(t.reshape((b, n, c, h) + t.shape[3:]), 3, 1)

    q, k, v, g, beta = (to_chunks(t) for t in (q, k, v, g, beta))
    g = jnp.cumsum(g, axis=-1)
    idx = jnp.arange(c)
    incl = idx[:, None] >= idx[None, :]
    strict = idx[:, None] > idx[None, :]
    decay = jnp.exp(jnp.where(incl, g[..., :, None] - g[..., None, :], -jnp.inf))
    k_beta = k * beta[..., None]
    l_mat = jnp.where(strict, jnp.einsum('bhncd,bhnsd->bhncs', k_beta, k) * decay, 0.0)
    eye = jnp.eye(c, dtype=jnp.float32)
    rhs = jnp.concatenate([v * beta[..., None], k_beta * jnp.exp(g)[..., None]], axis=-1)
    sol = lax.linalg.triangular_solve(eye + l_mat, rhs, left_side=True, lower=True, unit_diagonal=True)
    u_c, w_c = sol[..., :dv], sol[..., dv:]
    qk = jnp.einsum('bhncd,bhnsd->bhncs', q, k) * decay
    q_dec = q * jnp.exp(g)[..., None]
    k_dec = k * jnp.exp(g[..., -1:] - g)[..., None]
    g_last = jnp.exp(g[..., -1])

    def step(state, xs):
        u_i, w_i, qk_i, qd_i, kd_i, gl_i = xs
        v_new = u_i - jnp.einsum('bhcd,bhde->bhce', w_i, state)
        o = jnp.einsum('bhcd,bhde->bhce', qd_i, state) + jnp.einsum('bhcs,bhse->bhce', qk_i, v_new)
        state = state * gl_i[..., None, None] + jnp.einsum('bhcd,bhce->bhde', kd_i, v_new)
        return state, o

    xs = tuple(jnp.moveaxis(t, 2, 0) for t in (u_c, w_c, qk, q_dec, k_dec, g_last))
    s0 = jnp.zeros((b, h, dk, dv), jnp.float32)
    _, o = lax.scan(step, s0, xs)
    o = jnp.moveaxis(o, 0, 2)
    return jnp.moveaxis(o, 1, 3).reshape(b, l, h, dv)


def gdn_branch(qkv, gates, conv_w, a_log, dt_bias, norm_g):
    b, l, _ = qkv.shape
    h = N_HEADS_G
    act = jax.nn.silu(centred_dwconv(qkv, conv_w)).astype(jnp.float32)
    q, k, v = jnp.split(act, 3, axis=-1)
    q = l2_norm(q.reshape(b, l, h, HEAD_DIM)) * (HEAD_DIM ** -0.5)
    k = l2_norm(k.reshape(b, l, h, HEAD_DIM))
    v = v.reshape(b, l, h, HEAD_DIM)
    gates = gates.astype(jnp.float32)
    a = gates[..., :2 * h].reshape(b, l, 2, h)
    beta = jax.nn.sigmoid(gates[..., 2 * h:].reshape(b, l, 2, h))
    g = -jnp.exp(a_log.astype(jnp.float32)) * jax.nn.softplus(a + dt_bias.astype(jnp.float32))
    o_f = gdn_chunked(q, k, v, g[:, :, 0], beta[:, :, 0])
    rev = lambda t: jnp.flip(t, axis=1)
    o_b = rev(gdn_chunked(rev(q), rev(k), rev(v), rev(g[:, :, 1]), rev(beta[:, :, 1])))
    o = rms_norm(o_f + o_b, norm_g)
    return o.reshape(b, l, GROUP_W).astype(qkv.dtype)


def neighbourhood_attn(q, k, v, rpb):
    b, l, h, d = q.shape
    rows = l // GRID_W
    kh = min(NA_KH_MAX, rows)
    qg = (q * (d ** -0.5)).reshape(b, rows, GRID_W, h, d)
    kg = k.reshape(b, rows, GRID_W, h, d)
    vg = v.reshape(b, rows, GRID_W, h, d)
    cols = np.arange(GRID_W)
    col_start = np.clip(cols - NA_KW // 2, 0, GRID_W - NA_KW)
    col_idx = col_start[:, None] + np.arange(NA_KW)[None, :]
    col_off = col_idx - cols[:, None] + (NA_KW - 1)
    rpb_cols = rpb[:, :, col_off]

    def row_block(r):
        rs = jnp.clip(r - kh // 2, 0, rows - kh)
        k_win = lax.dynamic_slice_in_dim(kg, rs, kh, axis=1)[:, :, col_idx]
        v_win = lax.dynamic_slice_in_dim(vg, rs, kh, axis=1)[:, :, col_idx]
        q_r = lax.dynamic_index_in_dim(qg, r, axis=1, keepdims=False)
        s = jnp.einsum('bwhd,biwjhd->bhwij', q_r, k_win).astype(jnp.float32)
        row_off = rs + jnp.arange(kh) - r + (NA_KH_MAX - 1)
        bias = jnp.take(rpb_cols, row_off, axis=1)
        s = s + jnp.transpose(bias, (0, 2, 1, 3))[None].astype(jnp.float32)
        p = jax.nn.softmax(s.reshape(b, h, GRID_W, kh * NA_KW), axis=-1)
        p = p.reshape(b, h, GRID_W, kh, NA_KW).astype(v.dtype)
        return jnp.einsum('bhwij,biwjhd->bwhd', p, v_win)

    out = lax.map(row_block, jnp.arange(rows))
    return jnp.moveaxis(out, 0, 1).reshape(b, l, h * d)


def memory_attn(q, mem_n, w_mem_kv):
    b, l, _ = q.shape
    m = mem_n.shape[1]
    km, vm = jnp.split(mem_n @ w_mem_kv, 2, axis=-1)
    km = km.reshape(b, m, MEM_HEADS, MEM_HEAD_DIM)
    vm = vm.reshape(b, m, MEM_HEADS, MEM_HEAD_DIM)
    qh = q.reshape(b, l, MEM_HEADS, MEM_HEAD_DIM)
    s = jnp.einsum('blhd,bmhd->bhlm', qh, km).astype(jnp.float32) * (MEM_HEAD_DIM ** -0.5)
    p = jax.nn.softmax(s, axis=-1).astype(q.dtype)
    return jnp.einsum('bhlm,bmhd->blhd', p, vm).reshape(b, l, GROUP_W)


def encoder_layer(x, mem, pre_g, post_g, w_in, w_fnet, conv_w, a_log, dt_bias, gdn_g, rpb, mem_g, w_mem_kv, w_out):
    b, l, _ = x.shape
    hx = rms_norm(x, pre_g)
    proj = hx @ w_in
    a_u, a_z, b_qkv, b_z, b_gates, c_qkv, c_z, d_q, d_z = jnp.split(proj, IN_SPLITS, axis=-1)
    y_a = fourier_mix(a_u, w_fnet) * jax.nn.silu(a_z)
    y_b = gdn_branch(b_qkv, b_gates, conv_w, a_log, dt_bias, gdn_g) * jax.nn.silu(b_z)
    cq, ck, cv = (t.reshape(b, l, N_HEADS_G, HEAD_DIM) for t in jnp.split(c_qkv, 3, axis=-1))
    y_c = neighbourhood_attn(cq, ck, cv, rpb) * jax.nn.silu(c_z)
    y_d = memory_attn(d_q, rms_norm(mem, mem_g), w_mem_kv) * jax.nn.silu(d_z)
    out = jnp.concatenate([y_a, y_b, y_c, y_d], axis=-1) @ w_out
    return x + rms_norm(out, post_g)


def setup_inputs(seed: int = 0) -> dict:
    key = jax.random.key(seed)
    ks = jax.random.split(key, 16)
    f32 = jnp.float32
    h = N_HEADS_G

    def nrm(k, shape, scale):
        return jax.random.normal(k, shape, f32) * scale

    dt = jnp.exp(jax.random.uniform(ks[12], (DEPTH, 2, h), f32, math.log(1e-3), math.log(1e-1)))
    return {
        'x_prompt': nrm(ks[0], (BATCH, SEQ, D_MODEL), 1.0),
        'x_sample': nrm(ks[1], (DEC_BATCH, DEC_SEQ, D_MODEL), 1.0),
        'mem_prompt': nrm(ks[2], (BATCH, N_MEM, D_MODEL), 1.0),
        'mem_sample': nrm(ks[3], (DEC_BATCH, N_MEM, D_MODEL), 1.0),
        'pre_norm_g': 1.0 + nrm(ks[4], (DEPTH, D_MODEL), 0.05),
        'post_norm_g': 1.0 + nrm(ks[5], (DEPTH, D_MODEL), 0.05),
        'w_in': nrm(ks[6], (DEPTH, D_MODEL, D_IN), D_MODEL ** -0.5),
        'w_fnet': nrm(ks[7], (DEPTH, GROUP_W, GROUP_W), GROUP_W ** -0.5),
        'gdn_conv_w': nrm(ks[8], (DEPTH, CONV_K, 3 * GROUP_W), CONV_K ** -0.5),
        'gdn_a_log': jnp.log(jax.random.uniform(ks[9], (DEPTH, 2, h), f32, 1.0, 16.0)),
        'gdn_dt_bias': dt + jnp.log(-jnp.expm1(-dt)),
        'gdn_norm_g': 1.0 + nrm(ks[10], (DEPTH, HEAD_DIM), 0.05),
        'na_rpb': nrm(ks[11], (DEPTH, h, 2 * NA_KH_MAX - 1, 2 * NA_KW - 1), 0.1),
        'mem_norm_g': 1.0 + nrm(ks[13], (DEPTH, D_MODEL), 0.05),
        'w_mem_kv': nrm(ks[14], (DEPTH, D_MODEL, 2 * GROUP_W), D_MODEL ** -0.5),
        'w_out': nrm(ks[15], (DEPTH, D_MIX, D_MODEL), D_MIX ** -0.5),
    }


def reference(x_prompt, x_sample, mem_prompt, mem_sample, pre_norm_g, post_norm_g, w_in, w_fnet,
              gdn_conv_w, gdn_a_log, gdn_dt_bias, gdn_norm_g, na_rpb, mem_norm_g, w_mem_kv, w_out):
    def trunk(x, mem):
        for i in range(DEPTH):
            x = encoder_layer(x, mem, pre_norm_g[i], post_norm_g[i], w_in[i], w_fnet[i], gdn_conv_w[i],
                              gdn_a_log[i], gdn_dt_bias[i], gdn_norm_g[i], na_rpb[i], mem_norm_g[i],
                              w_mem_kv[i], w_out[i])
        return x

    y_prompt = trunk(x_prompt, mem_prompt)
    y_sample = trunk(x_sample, mem_sample)
    return (y_prompt, y_sample)
```

```cpp
#include <hip/hip_runtime.h>
#include <hip/hip_cooperative_groups.h>
#include <cstdio>
namespace cg = cooperative_groups;

typedef unsigned short bf16_t;
typedef short bf16x8 __attribute__((ext_vector_type(8)));
typedef float f32x4 __attribute__((ext_vector_type(4)));

#define NT 256
#define DI __device__ __forceinline__
#define MFMA16(a, b, c) __builtin_amdgcn_mfma_f32_16x16x32_bf16((a), (b), (c), 0, 0, 0)

constexpr int SEQL = 8192, NTOK = 49152;
constexpr size_t MiB = (size_t)1 << 20;
constexpr size_t OFF_WIN = 0, OFF_WOUT = 13107200, OFF_WMEM = 17301504, OFF_WF = 19398656, OFF_MEMN = 19922944,
                 OFF_KMEM = 23068672, OFF_VMEMT = 24641536, OFF_TW = 26214400;
constexpr size_t OFF_AU = 26 * MiB, OFF_AZ = 50 * MiB, OFF_BZ = 74 * MiB, OFF_CQ = 98 * MiB, OFF_CZ = 122 * MiB,
                 OFF_DQ = 146 * MiB, OFF_DZ = 170 * MiB, OFF_GATES = 194 * MiB, OFF_X = 197 * MiB,
                 OFF_BQKV = 293 * MiB, OFF_CK = 365 * MiB, OFF_CVT = 389 * MiB;
constexpr size_t OFF_H = OFF_X, OFF_QN = 245 * MiB, OFF_KN = 269 * MiB, OFF_KT = 464 * MiB, OFF_VN = 488 * MiB;
constexpr size_t OFF_CHW = 293 * MiB, OFF_CHU = 341 * MiB, OFF_CHQK = 389 * MiB, OFF_CVEC = 437 * MiB;
constexpr size_t OFF_OF = OFF_KN, OFF_OB = OFF_VN, OFF_OUTTMP = 293 * MiB;
constexpr size_t WS_NEED = 512 * MiB;

struct Params {
  const float* x_prompt; const float* x_sample; const float* mem_prompt; const float* mem_sample;
  const float* pre_g; const float* post_g; const float* w_in; const float* w_fnet; const float* conv_w;
  const float* a_log; const float* dt_bias; const float* gdn_g; const float* rpb; const float* mem_g;
  const float* w_mem_kv; const float* w_out;
  float* out; unsigned char* ws;
};

DI bf16_t f2bf(float x) { unsigned u = __float_as_uint(x); u += 0x7fffu + ((u >> 16) & 1u); return (bf16_t)(u >> 16); }
DI float bf2f(bf16_t h) { return __uint_as_float(((unsigned)h) << 16); }
DI unsigned pack2(float lo, float hi) { return (unsigned)f2bf(lo) | ((unsigned)f2bf(hi) << 16); }
DI float bflo(unsigned u) { return __uint_as_float(u << 16); }
DI float bfhi(unsigned u) { return __uint_as_float(u & 0xffff0000u); }
DI float wave_sum(float v) {
#pragma unroll
  for (int m = 32; m >= 1; m >>= 1) v += __shfl_xor(v, m, 64);
  return v;
}
DI float silu(float x) { return x / (1.f + __expf(-x)); }
DI bf16x8 pack8(const f32x4& a, const f32x4& b) {
  uint4 u; u.x = pack2(a[0], a[1]); u.y = pack2(a[2], a[3]); u.z = pack2(b[0], b[1]); u.w = pack2(b[2], b[3]);
  return __builtin_bit_cast(bf16x8, u);
}
DI bf16x8 ld8(const bf16_t* p) { return *(const bf16x8*)p; }
DI bf16x8 ld4x2(const bf16_t* lo, const bf16_t* hi) {
  uint2 a = *(const uint2*)lo, b = *(const uint2*)hi; uint4 u; u.x = a.x; u.y = a.y; u.z = b.x; u.w = b.y;
  return __builtin_bit_cast(bf16x8, u);
}
DI int ltid() { int t = threadIdx.x; asm volatile("" : "+v"(t)); return t; }
DI Params launder(Params p) { asm volatile("" : "+s"(p.ws)); return p; }
DI const float* xrow(const Params& p, int tok) {
  return tok < 32768 ? p.x_prompt + (size_t)tok * 1024 : p.x_sample + (size_t)(tok - 32768) * 1024;
}

DI void norm_row_bf16(const float* src, bf16_t* dst, int lane) {
  float4 v[4]; float ss = 0.f;
#pragma unroll
  for (int i = 0; i < 4; ++i) { v[i] = *(const float4*)(src + i * 256 + lane * 4); ss += v[i].x * v[i].x + v[i].y * v[i].y + v[i].z * v[i].z + v[i].w * v[i].w; }
  ss = wave_sum(ss);
  const float rs = rsqrtf(ss * (1.f / 1024.f) + 1e-6f);
#pragma unroll
  for (int i = 0; i < 4; ++i) { uint2 o; o.x = pack2(v[i].x * rs, v[i].y * rs); o.y = pack2(v[i].z * rs, v[i].w * rs); *(uint2*)(dst + i * 256 + lane * 4) = o; }
}

__device__ void phase0(const Params& p, const int tid) {
  const int gtid = blockIdx.x * NT + tid, gsz = gridDim.x * NT;
  bf16_t* WinT = (bf16_t*)(p.ws + OFF_WIN);
  for (int idx = gtid; idx < 2 * 3200 * 128; idx += gsz) {
    const int l = idx / (3200 * 128); const int rem = idx - l * 3200 * 128; const int k8 = rem / 3200; const int r = rem - k8 * 3200;
    const int src = r < 1536 ? r : (r < 3072 ? r + 16 : (r < 3088 ? 1536 + (r - 3072) : -1));
    uint4 o = make_uint4(0, 0, 0, 0);
    if (src >= 0) {
      const float* w = p.w_in + ((size_t)l * 1024 + k8 * 8) * 3088 + src;
      const float* g = p.pre_g + l * 1024 + k8 * 8;
      float v[8];
#pragma unroll
      for (int j = 0; j < 8; ++j) v[j] = w[(size_t)j * 3088] * g[j];
      o.x = pack2(v[0], v[1]); o.y = pack2(v[2], v[3]); o.z = pack2(v[4], v[5]); o.w = pack2(v[6], v[7]);
    }
    *(uint4*)(WinT + ((size_t)l * 3200 + r) * 1024 + k8 * 8) = o;
  }
  bf16_t* WoutT = (bf16_t*)(p.ws + OFF_WOUT);
  for (int idx = gtid; idx < 2 * 1024 * 128; idx += gsz) {
    const int l = idx / (1024 * 128); const int rem = idx - l * 1024 * 128; const int k8 = rem / 1024; const int r = rem - k8 * 1024;
    const float* w = p.w_out + ((size_t)l * 1024 + k8 * 8) * 1024 + r;
    float v[8];
#pragma unroll
    for (int j = 0; j < 8; ++j) v[j] = w[(size_t)j * 1024];
    uint4 o; o.x = pack2(v[0], v[1]); o.y = pack2(v[2], v[3]); o.z = pack2(v[4], v[5]); o.w = pack2(v[6], v[7]);
    *(uint4*)(WoutT + ((size_t)l * 1024 + r) * 1024 + k8 * 8) = o;
  }
  bf16_t* WmemT = (bf16_t*)(p.ws + OFF_WMEM);
  for (int idx = gtid; idx < 2 * 512 * 128; idx += gsz) {
    const int l = idx / (512 * 128); const int rem = idx - l * 512 * 128; const int k8 = rem / 512; const int r = rem - k8 * 512;
    const float* w = p.w_mem_kv + ((size_t)l * 1024 + k8 * 8) * 512 + r;
    const float* g = p.mem_g + l * 1024 + k8 * 8;
    float v[8];
#pragma unroll
    for (int j = 0; j < 8; ++j) v[j] = w[(size_t)j * 512] * g[j];
    uint4 o; o.x = pack2(v[0], v[1]); o.y = pack2(v[2], v[3]); o.z = pack2(v[4], v[5]); o.w = pack2(v[6], v[7]);
    *(uint4*)(WmemT + ((size_t)l * 512 + r) * 1024 + k8 * 8) = o;
  }
  bf16_t* WfT = (bf16_t*)(p.ws + OFF_WF);
  const float fscale = 0.00138106793f;
  for (int idx = gtid; idx < 2 * 256 * 512; idx += gsz) {
    const int l = idx >> 17; const int rem = idx & 131071; const int kk = rem >> 8; const int j = rem & 255;
    const int k2 = kk & 255, blk = k2 >> 6, cp = k2 & 63;
    const float* w = p.w_fnet + ((size_t)l * 256 + blk * 64) * 256 + j;
    float a = 0.f;
    for (int c = 0; c < 64; ++c) {
      const float ang = (float)((c * cp) & 63) * (1.f / 32.f);
      const float tr = kk < 256 ? cospif(ang) : sinpif(ang);
      a += tr * w[(size_t)c * 256];
    }
    WfT[((size_t)l * 256 + j) * 512 + kk] = f2bf(a * fscale);
  }
  float2* tw = (float2*)(p.ws + OFF_TW);
  for (int t = gtid; t < 4096; t += gsz) { float s, c; sincospif((float)t * (1.f / 4096.f), &s, &c); tw[t] = make_float2(c, -s); }
  const int lane = tid & 63, gw = blockIdx.x * (NT / 64) + (tid >> 6), nw = gridDim.x * (NT / 64);
  bf16_t* memn = (bf16_t*)(p.ws + OFF_MEMN);
  for (int r = gw; r < 1536; r += nw) {
    const float* src = r < 1024 ? p.mem_prompt + (size_t)r * 1024 : p.mem_sample + (size_t)(r - 1024) * 1024;
    norm_row_bf16(src, memn + (size_t)r * 1024, lane);
  }
  bf16_t* xn = (bf16_t*)(p.ws + OFF_X);
  for (int t = gw; t < NTOK; t += nw) norm_row_bf16(xrow(p, t), xn + (size_t)t * 1024, lane);
}

struct BOperand { const bf16_t* b0; const bf16_t* b1; const bf16_t* b2; const bf16_t* b3; int ld;
  DI const bf16_t* base(int i) const { return i == 0 ? b0 : i == 1 ? b1 : i == 2 ? b2 : b3; } };
template <class Epi>
DI void gemm_tile(const bf16_t* __restrict__ A, int lda, const BOperand& Bop, int m0, int n0, int K, bf16_t* lds, const Epi& epi, const int tid) {
  const int lane = tid & 63, wave = tid >> 6;
  const int wm = wave >> 1, wn = wave & 1, fr = lane & 15, fq = lane >> 4;
  bf16_t* sA = lds; bf16_t* sB = lds + 128 * 72;
  f32x4 acc[4][4];
#pragma unroll
  for (int i = 0; i < 4; ++i)
#pragma unroll
    for (int j = 0; j < 4; ++j) acc[i][j] = (f32x4){0.f, 0.f, 0.f, 0.f};
  const int lrow = tid >> 3, lch = tid & 7;
  uint4 ra0, ra1, ra2, ra3, rb0, rb1, rb2, rb3;
  const bf16_t* Ap = A + (size_t)(m0 + lrow) * lda + lch * 8;
  const size_t lda32 = (size_t)32 * lda, ldb32 = (size_t)32 * Bop.ld;
  {
    const bf16_t* bb = Bop.b0 + (size_t)(n0 + lrow) * Bop.ld + lch * 8;
    ra0 = *(const uint4*)(Ap); ra1 = *(const uint4*)(Ap + lda32); ra2 = *(const uint4*)(Ap + 2 * lda32); ra3 = *(const uint4*)(Ap + 3 * lda32);
    rb0 = *(const uint4*)(bb); rb1 = *(const uint4*)(bb + ldb32); rb2 = *(const uint4*)(bb + 2 * ldb32); rb3 = *(const uint4*)(bb + 3 * ldb32);
  }
  bf16_t* sAw = sA + lrow * 72 + lch * 8; bf16_t* sBw = sB + lrow * 72 + lch * 8;
  for (int k0 = 0; k0 < K; k0 += 64) {
    __syncthreads();
    *(uint4*)(sAw) = ra0; *(uint4*)(sAw + 32 * 72) = ra1; *(uint4*)(sAw + 64 * 72) = ra2; *(uint4*)(sAw + 96 * 72) = ra3;
    *(uint4*)(sBw) = rb0; *(uint4*)(sBw + 32 * 72) = rb1; *(uint4*)(sBw + 64 * 72) = rb2; *(uint4*)(sBw + 96 * 72) = rb3;
    __syncthreads();
    if (k0 + 64 < K) {
      const int k1 = k0 + 64;
      const bf16_t* aa = Ap + k1;
      const bf16_t* bb = Bop.base(k1 >> 8) + (k1 & 255) + (size_t)(n0 + lrow) * Bop.ld + lch * 8;
      ra0 = *(const uint4*)(aa); ra1 = *(const uint4*)(aa + lda32); ra2 = *(const uint4*)(aa + 2 * lda32); ra3 = *(const uint4*)(aa + 3 * lda32);
      rb0 = *(const uint4*)(bb); rb1 = *(const uint4*)(bb + ldb32); rb2 = *(const uint4*)(bb + 2 * ldb32); rb3 = *(const uint4*)(bb + 3 * ldb32);
    }
#pragma unroll
    for (int kk = 0; kk < 2; ++kk) {
      bf16x8 af[4], bfr[4];
#pragma unroll
      for (int i = 0; i < 4; ++i) af[i] = *(const bf16x8*)(sA + (wm * 64 + i * 16 + fr) * 72 + kk * 32 + fq * 8);
#pragma unroll
      for (int j = 0; j < 4; ++j) bfr[j] = *(const bf16x8*)(sB + (wn * 64 + j * 16 + fr) * 72 + kk * 32 + fq * 8);
#pragma unroll
      for (int i = 0; i < 4; ++i)
#pragma unroll
        for (int j = 0; j < 4; ++j) acc[i][j] = MFMA16(af[i], bfr[j], acc[i][j]);
    }
  }
#pragma unroll
  for (int i = 0; i < 4; ++i)
#pragma unroll
    for (int j = 0; j < 4; ++j) epi(m0 + wm * 64 + i * 16 + fq * 4, n0 + wn * 64 + j * 16 + fr, acc[i][j]);
  __syncthreads();
}

struct InProjEpi {
  unsigned char* ws;
  DI void operator()(int m, int n, const f32x4& v) const {
    if (m < 3072) {
      const int blk = m >> 8, c = m & 255;
      if (blk == 8) {
        bf16_t* cvt = (bf16_t*)(ws + OFF_CVT);
        const int seq = n >> 13, l = n & 8191;
        bf16_t* d = cvt + ((size_t)(seq * 256 + c)) * 8192 + l;
#pragma unroll
        for (int e = 0; e < 4; ++e) d[(size_t)e * 8192] = f2bf(v[e]);
      } else {
        bf16_t* d;
        if (blk >= 2 && blk <= 4) d = (bf16_t*)(ws + OFF_BQKV) + (size_t)n * 768 + (blk - 2) * 256 + c;
        else {
          size_t off = blk == 0 ? OFF_AU : blk == 1 ? OFF_AZ : blk == 5 ? OFF_BZ : blk == 6 ? OFF_CQ : blk == 7 ? OFF_CK : blk == 9 ? OFF_CZ : blk == 10 ? OFF_DQ : OFF_DZ;
          d = (bf16_t*)(ws + off) + (size_t)n * 256 + c;
        }
        uint2 o; o.x = pack2(v[0], v[1]); o.y = pack2(v[2], v[3]); *(uint2*)d = o;
      }
    } else if (m < 3088) {
      float* g = (float*)(ws + OFF_GATES) + (size_t)n * 16 + (m - 3072);
      *(float4*)g = make_float4(v[0], v[1], v[2], v[3]);
    }
  }
};
struct MemKvEpi {
  unsigned char* ws; int l;
  DI void operator()(int m, int n, const f32x4& v) const {
    const int seq = n >> 8, key = n & 255;
    if (m < 256) {
      const int head = m >> 6, dim = m & 63;
      bf16_t* d = (bf16_t*)(ws + OFF_KMEM) + ((size_t)((l * 6 + seq) * 4 + head) * 256 + key) * 64 + dim;
      uint2 o; o.x = pack2(v[0], v[1]); o.y = pack2(v[2], v[3]); *(uint2*)d = o;
    } else {
      const int c = m - 256, head = c >> 6, dim = c & 63;
      bf16_t* d = (bf16_t*)(ws + OFF_VMEMT) + ((size_t)((l * 6 + seq) * 4 + head) * 64 + dim) * 256 + key;
#pragma unroll
      for (int e = 0; e < 4; ++e) d[e * 256] = f2bf(v[e]);
    }
  }
};
struct FnetEpi {
  unsigned char* ws;
  DI void operator()(int m, int n, const f32x4& v) const {
    const uint2 z = *(const uint2*)((const bf16_t*)(ws + OFF_AZ) + (size_t)n * 256 + m);
    uint2 o; o.x = pack2(v[0] * silu(bflo(z.x)), v[1] * silu(bfhi(z.x))); o.y = pack2(v[2] * silu(bflo(z.y)), v[3] * silu(bfhi(z.y)));
    *(uint2*)((bf16_t*)(ws + OFF_AU) + (size_t)n * 256 + m) = o;
  }
};
struct OutEpi {
  float* dst;
  DI void operator()(int m, int n, const f32x4& v) const { *(float4*)(dst + (size_t)n * 1024 + m) = make_float4(v[0], v[1], v[2], v[3]); }
};

__device__ void fft_task(const Params& p, int task, float2* z, const int tid) {
  const int seq = task >> 7, cp = task & 127;
  const unsigned* au = (const unsigned*)(p.ws + OFF_AU) + (size_t)seq * 8192 * 128 + cp;
  const float2* tw = (const float2*)(p.ws + OFF_TW);
  for (int i = tid; i < 8192; i += NT) { const unsigned u = au[(size_t)i * 128]; z[i] = make_float2(bflo(u), bfhi(u)); }
  __syncthreads();
  for (int half = 4096, sh = 0; half >= 1; half >>= 1, ++sh) {
    for (int b = tid; b < 4096; b += NT) {
      const int j = b & (half - 1), i0 = ((b - j) << 1) + j, i1 = i0 + half;
      const float2 a = z[i0], c = z[i1], w = tw[j << sh];
      z[i0] = make_float2(a.x + c.x, a.y + c.y);
      const float dx = a.x - c.x, dy = a.y - c.y;
      z[i1] = make_float2(dx * w.x - dy * w.y, dx * w.y + dy * w.x);
    }
    __syncthreads();
  }
  unsigned* H = (unsigned*)(p.ws + OFF_H) + (size_t)seq * 8192 * 256;
  for (int k = tid; k < 8192; k += NT) {
    const int bk = __brev((unsigned)k) >> 19, bn = __brev((unsigned)((8192 - k) & 8191)) >> 19;
    const float2 zk = z[bk], zn = z[bn];
    H[(size_t)k * 256 + cp] = pack2(0.5f * (zk.x + zn.x), 0.5f * (zk.y + zn.y));
    H[(size_t)k * 256 + 128 + cp] = pack2(0.5f * (zk.y - zn.y), -0.5f * (zk.x - zn.x));
  }
  __syncthreads();
}

template <bool NA>
DI void attn_task(const Params& p, int layer, int task, int lane) {
  const int fr = lane & 15, fq = lane >> 4;
  int seq, h, tok0, r = 0, c0 = 0, rs = 0, wsx = 0;
  if (NA) { h = task & 3; const int ct = (task >> 2) & 3; r = (task >> 4) & 127; seq = task >> 11; c0 = ct * 16; tok0 = seq * 8192 + r * 64 + c0;
            rs = min(max(r - 4, 0), 120); wsx = min(max(c0 - 8, 0), 32); }
  else { h = task & 3; tok0 = (task >> 2) * 16; seq = tok0 >> 13; }
  bf16_t* Q = (bf16_t*)(p.ws + (NA ? OFF_CQ : OFF_DQ));
  const bf16_t* Z = (const bf16_t*)(p.ws + (NA ? OFF_CZ : OFF_DZ));
  const bf16_t* qp = Q + (size_t)(tok0 + fr) * 256 + h * 64 + fq * 8;
  bf16x8 qf[2]; qf[0] = ld8(qp); qf[1] = ld8(qp + 32);
  const bf16_t* Kb; const bf16_t* Vb;
  if (NA) { Kb = (const bf16_t*)(p.ws + OFF_CK) + (size_t)(seq * 8192) * 256 + h * 64; Vb = (const bf16_t*)(p.ws + OFF_CVT) + (size_t)(seq * 4 + h) * 64 * 8192; }
  else { Kb = (const bf16_t*)(p.ws + OFF_KMEM) + (size_t)((layer * 6 + seq) * 4 + h) * 256 * 64; Vb = (const bf16_t*)(p.ws + OFF_VMEMT) + (size_t)((layer * 6 + seq) * 4 + h) * 64 * 256; }
  f32x4 s[16];
#pragma unroll
  for (int kt = 0; kt < 16; ++kt) {
    const bf16_t* kp = NA ? Kb + (size_t)((rs + (kt >> 1)) * 64 + wsx + (kt & 1) * 16 + fr) * 256 + fq * 8 : Kb + (size_t)(kt * 16 + fr) * 64 + fq * 8;
    f32x4 a = (f32x4){0.f, 0.f, 0.f, 0.f};
    a = MFMA16(ld8(kp), qf[0], a);
    a = MFMA16(ld8(kp + 32), qf[1], a);
    s[kt] = a;
  }
  float mx = -1e30f;
  if (NA) {
    const float* rpb = p.rpb + (size_t)(layer * 4 + h) * 15 * 31;
    const int c = c0 + fr, cs = min(max(c - 8, 0), 48);
#pragma unroll
    for (int kt = 0; kt < 16; ++kt) {
      const int kr = rs + (kt >> 1);
      const float* rb = rpb + (kr - r + 7) * 31;
#pragma unroll
      for (int e = 0; e < 4; ++e) {
        const int kc = wsx + (kt & 1) * 16 + 4 * fq + e;
        const bool valid = kc >= cs && kc < cs + 16;
        float v = -1e30f;
        if (valid) v = s[kt][e] * 0.125f + rb[kc - c + 15];
        s[kt][e] = v; mx = fmaxf(mx, v);
      }
    }
  } else {
#pragma unroll
    for (int kt = 0; kt < 16; ++kt)
#pragma unroll
      for (int e = 0; e < 4; ++e) { const float v = s[kt][e] * 0.125f; s[kt][e] = v; mx = fmaxf(mx, v); }
  }
  mx = fmaxf(mx, __shfl_xor(mx, 16, 64)); mx = fmaxf(mx, __shfl_xor(mx, 32, 64));
  float sum = 0.f;
#pragma unroll
  for (int kt = 0; kt < 16; ++kt)
#pragma unroll
    for (int e = 0; e < 4; ++e) { const float pv = __expf(s[kt][e] - mx); s[kt][e] = pv; sum += pv; }
  sum += __shfl_xor(sum, 16, 64); sum += __shfl_xor(sum, 32, 64);
  const float inv = 1.f / sum;
  f32x4 o[4];
#pragma unroll
  for (int mt = 0; mt < 4; ++mt) o[mt] = (f32x4){0.f, 0.f, 0.f, 0.f};
#pragma unroll
  for (int u = 0; u < 8; ++u) {
    const bf16x8 pb = pack8(s[2 * u], s[2 * u + 1]);
#pragma unroll
    for (int mt = 0; mt < 4; ++mt) {
      const bf16_t* vp = NA ? Vb + (size_t)(16 * mt + fr) * 8192 + (rs + u) * 64 + wsx + 4 * fq : Vb + (size_t)(16 * mt + fr) * 256 + 32 * u + 4 * fq;
      o[mt] = MFMA16(ld4x2(vp, vp + 16), pb, o[mt]);
    }
  }
  const size_t orow = (size_t)(tok0 + fr) * 256 + h * 64 + 4 * fq;
#pragma unroll
  for (int mt = 0; mt < 4; ++mt) {
    const uint2 z = *(const uint2*)(Z + orow + 16 * mt);
    uint2 w; w.x = pack2(o[mt][0] * inv * silu(bflo(z.x)), o[mt][1] * inv * silu(bfhi(z.x)));
    w.y = pack2(o[mt][2] * inv * silu(bflo(z.y)), o[mt][3] * inv * silu(bfhi(z.y)));
    *(uint2*)(Q + orow + 16 * mt) = w;
  }
}

DI void gdn_prep_token(const Params& p, int layer, int tok, int lane) {
  const int seq = tok >> 13, l = tok & 8191;
  const bf16_t* X = (const bf16_t*)(p.ws + OFF_BQKV);
  const float* cw = p.conv_w + (size_t)layer * 5 * 768;
  float v[3][4];
#pragma unroll
  for (int i = 0; i < 3; ++i) {
    const int c = i * 256 + lane * 4;
    float a0 = 0.f, a1 = 0.f, a2 = 0.f, a3 = 0.f;
#pragma unroll
    for (int j = 0; j < 5; ++j) {
      const int ll = l + j - 2;
      if (ll >= 0 && ll < 8192) {
        const uint2 x = *(const uint2*)(X + (size_t)(tok + j - 2) * 768 + c);
        const float4 w = *(const float4*)(cw + j * 768 + c);
        a0 += w.x * bflo(x.x); a1 += w.y * bfhi(x.x); a2 += w.z * bflo(x.y); a3 += w.w * bfhi(x.y);
      }
    }
    v[i][0] = silu(a0); v[i][1] = silu(a1); v[i][2] = silu(a2); v[i][3] = silu(a3);
  }
#pragma unroll
  for (int i = 0; i < 2; ++i) {
    float ss = v[i][0] * v[i][0] + v[i][1] * v[i][1] + v[i][2] * v[i][2] + v[i][3] * v[i][3];
    ss += __shfl_xor(ss, 1, 64); ss += __shfl_xor(ss, 2, 64); ss += __shfl_xor(ss, 4, 64); ss += __shfl_xor(ss, 8, 64);
    const float rs = rsqrtf(ss + 1e-6f) * (i == 0 ? 0.125f : 1.f);
#pragma unroll
    for (int e = 0; e < 4; ++e) v[i][e] *= rs;
  }
  const size_t ro = (size_t)tok * 256 + lane * 4;
  uint2 o;
  o.x = pack2(v[0][0], v[0][1]); o.y = pack2(v[0][2], v[0][3]); *(uint2*)((bf16_t*)(p.ws + OFF_QN) + ro) = o;
  o.x = pack2(v[1][0], v[1][1]); o.y = pack2(v[1][2], v[1][3]); *(uint2*)((bf16_t*)(p.ws + OFF_KN) + ro) = o;
  o.x = pack2(v[2][0], v[2][1]); o.y = pack2(v[2][2], v[2][3]); *(uint2*)((bf16_t*)(p.ws + OFF_VN) + ro) = o;
  bf16_t* kT = (bf16_t*)(p.ws + OFF_KT) + ((size_t)seq * 256 + lane * 4) * 8192 + l;
#pragma unroll
  for (int e = 0; e < 4; ++e) kT[(size_t)e * 8192] = f2bf(v[1][e]);
  if (lane < 16) {
    float* g = (float*)(p.ws + OFF_GATES) + (size_t)tok * 16 + lane;
    const float x = *g;
    float r;
    if (lane < 8) {
      const float y = x + p.dt_bias[layer * 8 + lane];
      const float sp = y > 20.f ? y : log1pf(expf(y));
      r = -expf(p.a_log[layer * 8 + lane]) * sp;
    } else r = 1.f / (1.f + expf(-x));
    *g = r;
  }
}

__device__ void chunk_task(const Params& p, int bt, char* smem, const int tid) {
  const int n = bt & 127, head = (bt >> 7) & 3, seq = bt >> 9;
  const int lane = tid & 63, wave = tid >> 6, fr = lane & 15, fq = lane >> 4;
  float* sL = (float*)smem;
  float* sg = (float*)(smem + 32768);
  float* sbeta = sg + 128; float* sG = sbeta + 128;
  const float* gb = (const float*)(p.ws + OFF_GATES);
  const bf16_t* qn = (const bf16_t*)(p.ws + OFF_QN); const bf16_t* kn = (const bf16_t*)(p.ws + OFF_KN); const bf16_t* vn = (const bf16_t*)(p.ws + OFF_VN);
  const int tokbase = seq * 8192;
  if (tid < 128) {
    const int d = tid >> 6, r = tid & 63; const int pos = d ? 8191 - 64 * n - r : 64 * n + r;
    sg[tid] = gb[(size_t)(tokbase + pos) * 16 + d * 4 + head]; sbeta[tid] = gb[(size_t)(tokbase + pos) * 16 + 8 + d * 4 + head];
  }
  __syncthreads();
  if (tid < 128) { const int d = tid >> 6, r = tid & 63; float a = 0.f; for (int rr = 0; rr <= r; ++rr) a += sg[d * 64 + rr]; sG[tid] = a; }
  __syncthreads();
  {
    const int d = wave >> 1;
    const int ct = ((seq * 4 + head) * 2 + d) * 128 + n;
    if ((wave & 1) == 0) {
      float* cv = (float*)(p.ws + OFF_CVEC) + (size_t)ct * 256;
      const float G = sG[d * 64 + lane], Gl = sG[d * 64 + 63];
      cv[lane] = __expf(G); cv[64 + lane] = __expf(Gl - G); if (lane == 0) cv[128] = __expf(Gl);
    }
    bf16_t* chqk = (bf16_t*)(p.ws + OFF_CHQK) + (size_t)ct * 4096;
    const int hoff = head * 64 + fq * 8;
#pragma unroll
    for (int si = 0; si < 2; ++si) {
      const int strip = 2 * (wave & 1) + si;
      const int rA = 16 * strip + fr; const int posA = d ? 8191 - 64 * n - rA : 64 * n + rA;
      const size_t oa = (size_t)(tokbase + posA) * 256 + hoff;
      const bf16x8 kA0 = ld8(kn + oa), kA1 = ld8(kn + oa + 32), qA0 = ld8(qn + oa), qA1 = ld8(qn + oa + 32);
#pragma unroll
      for (int nt = 0; nt < 4; ++nt) {
        const int rB = 16 * nt + fr; const int posB = d ? 8191 - 64 * n - rB : 64 * n + rB;
        const size_t ob = (size_t)(tokbase + posB) * 256 + hoff;
        const bf16x8 kB0 = ld8(kn + ob), kB1 = ld8(kn + ob + 32);
        f32x4 kk = (f32x4){0.f, 0.f, 0.f, 0.f}, qk = (f32x4){0.f, 0.f, 0.f, 0.f};
        kk = MFMA16(kA0, kB0, kk); kk = MFMA16(kA1, kB1, kk);
        qk = MFMA16(qA0, kB0, qk); qk = MFMA16(qA1, kB1, qk);
        const int sc = 16 * nt + fr;
#pragma unroll
        for (int e = 0; e < 4; ++e) {
          const int r = 16 * strip + 4 * fq + e;
          const float dec = sc <= r ? __expf(sG[d * 64 + r] - sG[d * 64 + sc]) : 0.f;
          sL[d * 4096 + r * 64 + sc] = sc < r ? sbeta[d * 64 + r] * kk[e] * dec : 0.f;
          chqk[r * 64 + sc] = f2bf(qk[e] * dec);
        }
      }
    }
  }
  __syncthreads();
  {
    const int d = wave >> 1, half = wave & 1;
    const int ct = ((seq * 4 + head) * 2 + d) * 128 + n;
    const bf16_t* src = (half ? kn : vn) + head * 64 + lane;
    float sol[64];
#pragma unroll
    for (int r = 0; r < 64; ++r) {
      const int pos = d ? 8191 - 64 * n - r : 64 * n + r;
      float x = bf2f(src[(size_t)(tokbase + pos) * 256]) * sbeta[d * 64 + r];
      if (half) x *= __expf(sG[d * 64 + r]);
      sol[r] = x;
    }
    const float* Ld = sL + d * 4096;
#pragma unroll
    for (int i = 1; i < 64; ++i) {
      float a = sol[i];
#pragma unroll
      for (int j4 = 0; j4 * 4 < i; ++j4) {
        const float4 lv = *(const float4*)(Ld + i * 64 + j4 * 4);
        if (j4 * 4 + 0 < i) a -= lv.x * sol[j4 * 4 + 0];
        if (j4 * 4 + 1 < i) a -= lv.y * sol[j4 * 4 + 1];
        if (j4 * 4 + 2 < i) a -= lv.z * sol[j4 * 4 + 2];
        if (j4 * 4 + 3 < i) a -= lv.w * sol[j4 * 4 + 3];
      }
      sol[i] = a;
    }
    if (!half) {
      bf16_t* chu = (bf16_t*)(p.ws + OFF_CHU) + (size_t)ct * 4096 + lane * 64;
#pragma unroll
      for (int r8 = 0; r8 < 8; ++r8) {
        uint4 o; o.x = pack2(sol[r8 * 8 + 0], sol[r8 * 8 + 1]); o.y = pack2(sol[r8 * 8 + 2], sol[r8 * 8 + 3]);
        o.z = pack2(sol[r8 * 8 + 4], sol[r8 * 8 + 5]); o.w = pack2(sol[r8 * 8 + 6], sol[r8 * 8 + 7]);
        *(uint4*)(chu + r8 * 8) = o;
      }
    } else {
      bf16_t* chw = (bf16_t*)(p.ws + OFF_CHW) + (size_t)ct * 4096 + lane;
#pragma unroll
      for (int r = 0; r < 64; ++r) chw[r * 64] = f2bf(sol[r]);
    }
  }
  __syncthreads();
}

DI uint4 rev8(uint4 v) {
  uint4 r;
  r.x = (v.w >> 16) | (v.w << 16); r.y = (v.z >> 16) | (v.z << 16); r.z = (v.y >> 16) | (v.y << 16); r.w = (v.x >> 16) | (v.x << 16);
  return r;
}
__device__ void scan_task(const Params& p, int task, char* smem, const int tid) {
  const int d = task & 1, head = (task >> 1) & 3, seq = task >> 3;
  const int lane = tid & 63, wave = tid >> 6, fr = lane & 15, fq = lane >> 4;
  bf16_t* sW = (bf16_t*)smem; bf16_t* sQK = sW + 64 * 72; bf16_t* sQ = sQK + 64 * 72; bf16_t* sKT = sQ + 64 * 72; bf16_t* sU = sKT + 64 * 72;
  float* sV = (float*)(smem + 5 * 64 * 72 * 2);
  const int ctb = ((seq * 4 + head) * 2 + d) * 128;
  const bf16_t* chw = (const bf16_t*)(p.ws + OFF_CHW); const bf16_t* chu = (const bf16_t*)(p.ws + OFF_CHU); const bf16_t* chqk = (const bf16_t*)(p.ws + OFF_CHQK);
  const float* cvec = (const float*)(p.ws + OFF_CVEC);
  const bf16_t* qn = (const bf16_t*)(p.ws + OFF_QN) + (size_t)seq * 8192 * 256 + head * 64;
  const bf16_t* kT = (const bf16_t*)(p.ws + OFF_KT) + (size_t)(seq * 256 + head * 64) * 8192;
  bf16_t* O = (bf16_t*)(p.ws + (d ? OFF_OB : OFF_OF)) + (size_t)seq * 8192 * 256 + head * 64 + 16 * wave + fr;
  const int row0 = tid >> 3, c8 = (tid & 7) * 8, rc8 = (7 - (tid & 7)) * 8;
  uint4 rw0, rw1, rqk0, rqk1, rq0, rq1, rkt0, rkt1, ru0, ru1; float rv = 0.f;
#define SCAN_GLOAD(n_) do { \
    const size_t cb = (size_t)(ctb + (n_)) * 4096; \
    rw0 = *(const uint4*)(chw + cb + row0 * 64 + c8); rw1 = *(const uint4*)(chw + cb + (row0 + 32) * 64 + c8); \
    rqk0 = *(const uint4*)(chqk + cb + row0 * 64 + c8); rqk1 = *(const uint4*)(chqk + cb + (row0 + 32) * 64 + c8); \
    ru0 = *(const uint4*)(chu + cb + row0 * 64 + c8); ru1 = *(const uint4*)(chu + cb + (row0 + 32) * 64 + c8); \
    const int pos0 = d ? 8191 - 64 * (n_) - row0 : 64 * (n_) + row0, pos1 = d ? pos0 - 32 : pos0 + 32; \
    rq0 = *(const uint4*)(qn + (size_t)pos0 * 256 + c8); rq1 = *(const uint4*)(qn + (size_t)pos1 * 256 + c8); \
    const int lbase = d ? 8191 - 64 * (n_) - 63 : 64 * (n_); \
    rkt0 = *(const uint4*)(kT + (size_t)row0 * 8192 + lbase + c8); rkt1 = *(const uint4*)(kT + (size_t)(row0 + 32) * 8192 + lbase + c8); \
    if (tid < 129) rv = cvec[(size_t)(ctb + (n_)) * 256 + tid]; } while (0)
#define SCAN_LSTORE() do { \
    *(uint4*)(sW + row0 * 72 + c8) = rw0; *(uint4*)(sW + (row0 + 32) * 72 + c8) = rw1; \
    *(uint4*)(sQK + row0 * 72 + c8) = rqk0; *(uint4*)(sQK + (row0 + 32) * 72 + c8) = rqk1; \
    *(uint4*)(sU + row0 * 72 + c8) = ru0; *(uint4*)(sU + (row0 + 32) * 72 + c8) = ru1; \
    *(uint4*)(sQ + row0 * 72 + c8) = rq0; *(uint4*)(sQ + (row0 + 32) * 72 + c8) = rq1; \
    if (d) { *(uint4*)(sKT + row0 * 72 + rc8) = rev8(rkt0); *(uint4*)(sKT + (row0 + 32) * 72 + rc8) = rev8(rkt1); } \
    else { *(uint4*)(sKT + row0 * 72 + c8) = rkt0; *(uint4*)(sKT + (row0 + 32) * 72 + c8) = rkt1; } \
    if (tid < 129) sV[tid] = rv; } while (0)
  f32x4 S[4];
#pragma unroll
  for (int mt = 0; mt < 4; ++mt) S[mt] = (f32x4){0.f, 0.f, 0.f, 0.f};
  __syncthreads();
  SCAN_GLOAD(0); SCAN_LSTORE();
  __syncthreads();
  for (int n = 0; n < 128; ++n) {
    if (n + 1 < 128) SCAN_GLOAD(n + 1);
    bf16x8 Sb[2]; Sb[0] = pack8(S[0], S[1]); Sb[1] = pack8(S[2], S[3]);
    f32x4 v[4], vk[4];
#pragma unroll
    for (int mt = 0; mt < 4; ++mt) {
      f32x4 a = (f32x4){0.f, 0.f, 0.f, 0.f};
      const bf16_t* wp = sW + (16 * mt + fr) * 72 + 4 * fq;
      a = MFMA16(ld4x2(wp, wp + 16), Sb[0], a);
      a = MFMA16(ld4x2(wp + 32, wp + 48), Sb[1], a);
      const uint2 u = *(const uint2*)(sU + (16 * wave + fr) * 72 + 16 * mt + 4 * fq);
      const float4 ek = *(const float4*)(sV + 64 + 16 * mt + 4 * fq);
      v[mt][0] = bflo(u.x) - a[0]; v[mt][1] = bfhi(u.x) - a[1]; v[mt][2] = bflo(u.y) - a[2]; v[mt][3] = bfhi(u.y) - a[3];
      vk[mt][0] = v[mt][0] * ek.x; vk[mt][1] = v[mt][1] * ek.y; vk[mt][2] = v[mt][2] * ek.z; vk[mt][3] = v[mt][3] * ek.w;
    }
    bf16x8 Vb[2], Vkb[2];
    Vb[0] = pack8(v[0], v[1]); Vb[1] = pack8(v[2], v[3]); Vkb[0] = pack8(vk[0], vk[1]); Vkb[1] = pack8(vk[2], vk[3]);
    const float gl = sV[128];
#pragma unroll
    for (int mt = 0; mt < 4; ++mt) {
      f32x4 a = (f32x4){0.f, 0.f, 0.f, 0.f};
      const bf16_t* qp = sQ + (16 * mt + fr) * 72 + 4 * fq;
      a = MFMA16(ld4x2(qp, qp + 16), Sb[0], a);
      a = MFMA16(ld4x2(qp + 32, qp + 48), Sb[1], a);
      const float4 eg = *(const float4*)(sV + 16 * mt + 4 * fq);
      a[0] *= eg.x; a[1] *= eg.y; a[2] *= eg.z; a[3] *= eg.w;
      const bf16_t* kp = sQK + (16 * mt + fr) * 72 + 4 * fq;
      a = MFMA16(ld4x2(kp, kp + 16), Vb[0], a);
      a = MFMA16(ld4x2(kp + 32, kp + 48), Vb[1], a);
#pragma unroll
      for (int e = 0; e < 4; ++e) {
        const int r = 16 * mt + 4 * fq + e; const int pos = d ? 8191 - 64 * n - r : 64 * n + r;
        O[(size_t)pos * 256] = f2bf(a[e]);
      }
    }
#pragma unroll
    for (int mt = 0; mt < 4; ++mt) {
      f32x4 a; a[0] = S[mt][0] * gl; a[1] = S[mt][1] * gl; a[2] = S[mt][2] * gl; a[3] = S[mt][3] * gl;
      const bf16_t* tp = sKT + (16 * mt + fr) * 72 + 4 * fq;
      a = MFMA16(ld4x2(tp, tp + 16), Vkb[0], a);
      a = MFMA16(ld4x2(tp + 32, tp + 48), Vkb[1], a);
      S[mt] = a;
    }
    __syncthreads();
    if (n + 1 < 128) SCAN_LSTORE();
    __syncthreads();
  }
}

DI void gdn_finish_token(const Params& p, int layer, int tok, int lane) {
  const size_t ro = (size_t)tok * 256 + lane * 4;
  const uint2 a = *(const uint2*)((const bf16_t*)(p.ws + OFF_OF) + ro), b = *(const uint2*)((const bf16_t*)(p.ws + OFF_OB) + ro);
  float o0 = bflo(a.x) + bflo(b.x), o1 = bfhi(a.x) + bfhi(b.x), o2 = bflo(a.y) + bflo(b.y), o3 = bfhi(a.y) + bfhi(b.y);
  float ss = o0 * o0 + o1 * o1 + o2 * o2 + o3 * o3;
  ss += __shfl_xor(ss, 1, 64); ss += __shfl_xor(ss, 2, 64); ss += __shfl_xor(ss, 4, 64); ss += __shfl_xor(ss, 8, 64);
  const float rs = rsqrtf(ss * (1.f / 64.f) + 1e-6f);
  const float4 g = *(const float4*)(p.gdn_g + layer * 64 + (lane & 15) * 4);
  bf16_t* bz = (bf16_t*)(p.ws + OFF_BZ) + ro;
  const uint2 z = *(const uint2*)bz;
  uint2 w; w.x = pack2(o0 * rs * g.x * silu(bflo(z.x)), o1 * rs * g.y * silu(bfhi(z.x)));
  w.y = pack2(o2 * rs * g.z * silu(bflo(z.y)), o3 * rs * g.w * silu(bfhi(z.y)));
  *(uint2*)bz = w;
}

DI void post_token(const Params& p, int layer, int tok, int lane) {
  const float* o = (const float*)(p.ws + OFF_OUTTMP) + (size_t)tok * 1024;
  const float* xr = layer == 0 ? xrow(p, tok) : p.out + (size_t)tok * 1024;
  const float* pg = p.post_g + layer * 1024;
  float4 v[4]; float ss = 0.f;
#pragma unroll
  for (int i = 0; i < 4; ++i) { v[i] = *(const float4*)(o + i * 256 + lane * 4); ss += v[i].x * v[i].x + v[i].y * v[i].y + v[i].z * v[i].z + v[i].w * v[i].w; }
  ss = wave_sum(ss);
  const float rs = rsqrtf(ss * (1.f / 1024.f) + 1e-6f);
  float ss2 = 0.f;
#pragma unroll
  for (int i = 0; i < 4; ++i) {
    const float4 x = *(const float4*)(xr + i * 256 + lane * 4); const float4 g = *(const float4*)(pg + i * 256 + lane * 4);
    v[i].x = x.x + v[i].x * rs * g.x; v[i].y = x.y + v[i].y * rs * g.y; v[i].z = x.z + v[i].z * rs * g.z; v[i].w = x.w + v[i].w * rs * g.w;
    ss2 += v[i].x * v[i].x + v[i].y * v[i].y + v[i].z * v[i].z + v[i].w * v[i].w;
    *(float4*)(p.out + (size_t)tok * 1024 + i * 256 + lane * 4) = v[i];
  }
  if (layer == 0) {
    ss2 = wave_sum(ss2);
    const float rs2 = rsqrtf(ss2 * (1.f / 1024.f) + 1e-6f);
    bf16_t* dst = (bf16_t*)(p.ws + OFF_X) + (size_t)tok * 1024;
#pragma unroll
    for (int i = 0; i < 4; ++i) { uint2 w; w.x = pack2(v[i].x * rs2, v[i].y * rs2); w.y = pack2(v[i].z * rs2, v[i].w * rs2); *(uint2*)(dst + i * 256 + lane * 4) = w; }
  }
}

__global__ void __launch_bounds__(NT, 2) fwd_megakernel(Params p0) {
  cg::grid_group grid = cg::this_grid();
  __shared__ __attribute__((aligned(16))) char smem[65536];
  const int nb = gridDim.x, bid = blockIdx.x, nw = gridDim.x * (NT / 64);
#define PH_BEGIN const Params p = launder(p0); const int tid = ltid(); const int lane = tid & 63; const int gw = bid * (NT / 64) + (tid >> 6); (void)lane; (void)gw;
  { PH_BEGIN phase0(p, tid); }
  grid.sync();
#pragma unroll 1
  for (int layer = 0; layer < 2; ++layer) {
    {
      PH_BEGIN
      BOperand bop; const bf16_t* xn = (const bf16_t*)(p.ws + OFF_X);
      bop.b0 = xn; bop.b1 = xn + 256; bop.b2 = xn + 512; bop.b3 = xn + 768; bop.ld = 1024;
      const bf16_t* W = (const bf16_t*)(p.ws + OFF_WIN) + (size_t)layer * 3200 * 1024;
      InProjEpi epi{p.ws};
#pragma unroll 1
      for (int t = bid; t < 25 * 384; t += nb) { const int nt = t / 25, mt = t - nt * 25; gemm_tile(W, 1024, bop, mt * 128, nt * 128, 1024, (bf16_t*)smem, epi, tid); }
    }
    if (layer == 0) {
      PH_BEGIN
      BOperand mop; const bf16_t* mn = (const bf16_t*)(p.ws + OFF_MEMN);
      mop.b0 = mn; mop.b1 = mn + 256; mop.b2 = mn + 512; mop.b3 = mn + 768; mop.ld = 1024;
#pragma unroll 1
      for (int t = bid; t < 96; t += nb) {
        const int l2 = t / 48, r2 = t - l2 * 48, nt = r2 >> 2, mt = r2 & 3;
        MemKvEpi me{p.ws, l2};
        gemm_tile((const bf16_t*)(p.ws + OFF_WMEM) + (size_t)l2 * 512 * 1024, 1024, mop, mt * 128, nt * 128, 1024, (bf16_t*)smem, me, tid);
      }
    }
    grid.sync();
    { PH_BEGIN
#pragma unroll 1
      for (int t = bid; t < 768; t += nb) fft_task(p, t, (float2*)smem, tid); }
    { PH_BEGIN
#pragma unroll 1
      for (int t = gw; t < 12288; t += nw) attn_task<true>(p, layer, t, lane); }
    { PH_BEGIN
#pragma unroll 1
      for (int t = gw; t < 12288; t += nw) attn_task<false>(p, layer, t, lane); }
    { PH_BEGIN
#pragma unroll 1
      for (int t = gw; t < NTOK; t += nw) gdn_prep_token(p, layer, t, lane); }
    grid.sync();
    { PH_BEGIN
#pragma unroll 1
      for (int t = bid; t < 3072; t += nb) chunk_task(p, t, smem, tid); }
    {
      PH_BEGIN
      BOperand hop; const bf16_t* H = (const bf16_t*)(p.ws + OFF_H);
      hop.b0 = H; hop.b1 = H + 256; hop.b2 = H; hop.b3 = H; hop.ld = 512;
      FnetEpi fe{p.ws};
      const bf16_t* Wf = (const bf16_t*)(p.ws + OFF_WF) + (size_t)layer * 256 * 512;
#pragma unroll 1
      for (int t = bid; t < 768; t += nb) { const int nt = t >> 1, mt = t & 1; gemm_tile(Wf, 512, hop, mt * 128, nt * 128, 512, (bf16_t*)smem, fe, tid); }
    }
    grid.sync();
    { PH_BEGIN
#pragma unroll 1
      for (int t = bid; t < 48; t += nb) scan_task(p, t, smem, tid); }
    grid.sync();
    { PH_BEGIN
#pragma unroll 1
      for (int t = gw; t < NTOK; t += nw) gdn_finish_token(p, layer, t, lane); }
    grid.sync();
    {
      PH_BEGIN
      BOperand mop;
      mop.b0 = (const bf16_t*)(p.ws + OFF_AU); mop.b1 = (const bf16_t*)(p.ws + OFF_BZ); mop.b2 = (const bf16_t*)(p.ws + OFF_CQ); mop.b3 = (const bf16_t*)(p.ws + OFF_DQ);
      mop.ld = 256;
      OutEpi oe{(float*)(p.ws + OFF_OUTTMP)};
      const bf16_t* W = (const bf16_t*)(p.ws + OFF_WOUT) + (size_t)layer * 1024 * 1024;
#pragma unroll 1
      for (int t = bid; t < 8 * 384; t += nb) { const int nt = t >> 3, mt = t & 7; gemm_tile(W, 1024, mop, mt * 128, nt * 128, 1024, (bf16_t*)smem, oe, tid); }
    }
    grid.sync();
    { PH_BEGIN
#pragma unroll 1
      for (int t = gw; t < NTOK; t += nw) post_token(p, layer, t, lane); }
    grid.sync();
  }
}

extern "C" void kernel_launch(void* const* d_in, const int* in_sizes, int n_in, void* d_out, int out_size, void* d_ws, size_t ws_size, hipStream_t stream) {
  static int grid_blocks = 0;
  if (!grid_blocks) {
    int dev = 0, cus = 0, per_cu = 0;
    (void)hipGetDevice(&dev);
    (void)hipDeviceGetAttribute(&cus, hipDeviceAttributeMultiprocessorCount, dev);
    (void)hipOccupancyMaxActiveBlocksPerMultiprocessor(&per_cu, fwd_megakernel, NT, 0);
    if (per_cu > 2) per_cu = 2;
    grid_blocks = cus * per_cu;
    if (grid_blocks <= 0) { fprintf(stderr, "occupancy query returned %d x %d\n", cus, per_cu); grid_blocks = -1; }
  }
  if (grid_blocks < 0) return;
  if (ws_size < WS_NEED || n_in != 16) { fprintf(stderr, "kernel_launch: need %zu bytes of workspace, got %zu (n_in %d)\n", (size_t)WS_NEED, ws_size, n_in); return; }
  Params p{};
  p.x_prompt = (const float*)d_in[0]; p.x_sample = (const float*)d_in[1]; p.mem_prompt = (const float*)d_in[2]; p.mem_sample = (const float*)d_in[3];
  p.pre_g = (const float*)d_in[4]; p.post_g = (const float*)d_in[5]; p.w_in = (const float*)d_in[6]; p.w_fnet = (const float*)d_in[7];
  p.conv_w = (const float*)d_in[8]; p.a_log = (const float*)d_in[9]; p.dt_bias = (const float*)d_in[10]; p.gdn_g = (const float*)d_in[11];
  p.rpb = (const float*)d_in[12]; p.mem_g = (const float*)d_in[13]; p.w_mem_kv = (const float*)d_in[14]; p.w_out = (const float*)d_in[15];
  p.out = (float*)d_out; p.ws = (unsigned char*)d_ws;
  void* args[] = {&p};
  hipError_t e = hipLaunchCooperativeKernel((void*)fwd_megakernel, dim3(grid_blocks), dim3(NT), args, 0, stream);
  if (e != hipSuccess) fprintf(stderr, "cooperative launch failed: %s (grid %d)\n", hipGetErrorString(e), grid_blocks);
}
```

```cpp
#include <hip/hip_runtime.h>
#include <hip/hip_cooperative_groups.h>
#include <cstdio>
namespace cg = cooperative_groups;

typedef unsigned short bf16_t;
typedef short bf16x8 __attribute__((ext_vector_type(8)));
typedef float f32x4 __attribute__((ext_vector_type(4)));

#define NT 512
#define DI __device__ __forceinline__
#define MFMA16(a, b, c) __builtin_amdgcn_mfma_f32_16x16x32_bf16((a), (b), (c), 0, 0, 0)

constexpr int SEQL = 8192, NTOK = 49152;
constexpr size_t MiB = (size_t)1 << 20;
constexpr int NPAD = 3328;
constexpr size_t OFF_WIN = 0, OFF_WOUT = 13631488, OFF_WMEM = 17825792, OFF_WF = 19922944, OFF_MEMN = 20447232,
                 OFF_KMEM = 23592960, OFF_VMEMT = 25165824, OFF_TW = 26738688;
constexpr size_t OFF_MIX = 26 * MiB, OFF_AZ = 122 * MiB, OFF_CZ = 146 * MiB, OFF_DZ = 170 * MiB, OFF_GATES = 194 * MiB, OFF_X = 197 * MiB,
                 OFF_BQKV = 293 * MiB, OFF_CK = 365 * MiB, OFF_CVT = 389 * MiB;
constexpr size_t OFF_H = OFF_X, OFF_QN = 245 * MiB, OFF_KN = 269 * MiB, OFF_KT = 464 * MiB, OFF_VN = 488 * MiB;
constexpr size_t OFF_CHW = 293 * MiB, OFF_CHU = 341 * MiB, OFF_CHQK = 389 * MiB, OFF_CVEC = 437 * MiB;
constexpr size_t OFF_OF = OFF_KN, OFF_OB = OFF_VN, OFF_OUTTMP = 293 * MiB;
constexpr size_t OFF_BAR = 26771456;
constexpr size_t WS_NEED = 512 * MiB;

struct Params {
  const float* x_prompt; const float* x_sample; const float* mem_prompt; const float* mem_sample;
  const float* pre_g; const float* post_g; const float* w_in; const float* w_fnet; const float* conv_w;
  const float* a_log; const float* dt_bias; const float* gdn_g; const float* rpb; const float* mem_g;
  const float* w_mem_kv; const float* w_out;
  float* out; unsigned char* ws;
};

typedef float f32x2_t __attribute__((ext_vector_type(2)));
typedef __bf16 bf16x2_t __attribute__((ext_vector_type(2)));
DI unsigned pack2(float lo, float hi) { f32x2_t f = {lo, hi}; return __builtin_bit_cast(unsigned, __builtin_convertvector(f, bf16x2_t)); }
DI bf16_t f2bf(float x) { return (bf16_t)(pack2(x, 0.f) & 0xffffu); }
DI float bf2f(bf16_t h) { return __uint_as_float(((unsigned)h) << 16); }
DI float bflo(unsigned u) { return __uint_as_float(u << 16); }
DI float bfhi(unsigned u) { return __uint_as_float(u & 0xffff0000u); }
DI float wave_sum(float v) {
#pragma unroll
  for (int m = 32; m >= 1; m >>= 1) v += __shfl_xor(v, m, 64);
  return v;
}
DI float silu(float x) { return x / (1.f + __expf(-x)); }
DI bf16x8 pack8(const f32x4& a, const f32x4& b) {
  uint4 u; u.x = pack2(a[0], a[1]); u.y = pack2(a[2], a[3]); u.z = pack2(b[0], b[1]); u.w = pack2(b[2], b[3]);
  return __builtin_bit_cast(bf16x8, u);
}
DI bf16x8 ld8(const bf16_t* p) { return *(const bf16x8*)p; }
DI bf16x8 ld4x2(const bf16_t* lo, const bf16_t* hi) {
  uint2 a = *(const uint2*)lo, b = *(const uint2*)hi; uint4 u; u.x = a.x; u.y = a.y; u.z = b.x; u.w = b.y;
  return __builtin_bit_cast(bf16x8, u);
}
DI int ltid() { int t = threadIdx.x; asm volatile("" : "+v"(t)); return t; }
DI Params launder(Params p) { size_t z = 0; asm volatile("" : "+s"(z)); p.ws = p.ws + z; return p; }
DI const float* xrow(const Params& p, int tok) {
  return tok < 32768 ? p.x_prompt + (size_t)tok * 1024 : p.x_sample + (size_t)(tok - 32768) * 1024;
}

DI void norm_row_bf16(const float* src, bf16_t* dst, int lane) {
  float4 v[4]; float ss = 0.f;
#pragma unroll
  for (int i = 0; i < 4; ++i) { v[i] = *(const float4*)(src + i * 256 + lane * 4); ss += v[i].x * v[i].x + v[i].y * v[i].y + v[i].z * v[i].z + v[i].w * v[i].w; }
  ss = wave_sum(ss);
  const float rs = rsqrtf(ss * (1.f / 1024.f) + 1e-6f);
#pragma unroll
  for (int i = 0; i < 4; ++i) { uint2 o; o.x = pack2(v[i].x * rs, v[i].y * rs); o.y = pack2(v[i].z * rs, v[i].w * rs); *(uint2*)(dst + i * 256 + lane * 4) = o; }
}

DI void phase0(const Params& p, const int tid) {
  const int gtid = blockIdx.x * NT + tid, gsz = gridDim.x * NT;
  bf16_t* WinT = (bf16_t*)(p.ws + OFF_WIN);
  for (int idx = gtid; idx < 2 * NPAD * 128; idx += gsz) {
    const int l = idx / (NPAD * 128); const int rem = idx - l * NPAD * 128; const int k8 = rem / NPAD; const int r = rem - k8 * NPAD;
    const int src = r < 1536 ? r : (r < 3072 ? r + 16 : (r < 3088 ? 1536 + (r - 3072) : -1));
    uint4 o = make_uint4(0, 0, 0, 0);
    if (src >= 0) {
      const float* w = p.w_in + ((size_t)l * 1024 + k8 * 8) * 3088 + src;
      const float* g = p.pre_g + l * 1024 + k8 * 8;
      float v[8];
#pragma unroll
      for (int j = 0; j < 8; ++j) v[j] = w[(size_t)j * 3088] * g[j];
      o.x = pack2(v[0], v[1]); o.y = pack2(v[2], v[3]); o.z = pack2(v[4], v[5]); o.w = pack2(v[6], v[7]);
    }
    *(uint4*)(WinT + ((size_t)l * NPAD + r) * 1024 + k8 * 8) = o;
  }
  bf16_t* WoutT = (bf16_t*)(p.ws + OFF_WOUT);
  for (int idx = gtid; idx < 2 * 1024 * 128; idx += gsz) {
    const int l = idx / (1024 * 128); const int rem = idx - l * 1024 * 128; const int k8 = rem / 1024; const int r = rem - k8 * 1024;
    const float* w = p.w_out + ((size_t)l * 1024 + k8 * 8) * 1024 + r;
    float v[8];
#pragma unroll
    for (int j = 0; j < 8; ++j) v[j] = w[(size_t)j * 1024];
    uint4 o; o.x = pack2(v[0], v[1]); o.y = pack2(v[2], v[3]); o.z = pack2(v[4], v[5]); o.w = pack2(v[6], v[7]);
    *(uint4*)(WoutT + ((size_t)l * 1024 + r) * 1024 + k8 * 8) = o;
  }
  bf16_t* WmemT = (bf16_t*)(p.ws + OFF_WMEM);
  for (int idx = gtid; idx < 2 * 512 * 128; idx += gsz) {
    const int l = idx / (512 * 128); const int rem = idx - l * 512 * 128; const int k8 = rem / 512; const int r = rem - k8 * 512;
    const float* w = p.w_mem_kv + ((size_t)l * 1024 + k8 * 8) * 512 + r;
    const float* g = p.mem_g + l * 1024 + k8 * 8;
    float v[8];
#pragma unroll
    for (int j = 0; j < 8; ++j) v[j] = w[(size_t)j * 512] * g[j];
    uint4 o; o.x = pack2(v[0], v[1]); o.y = pack2(v[2], v[3]); o.z = pack2(v[4], v[5]); o.w = pack2(v[6], v[7]);
    *(uint4*)(WmemT + ((size_t)l * 512 + r) * 1024 + k8 * 8) = o;
  }
  bf16_t* WfT = (bf16_t*)(p.ws + OFF_WF);
  const float fscale = 0.00138106793f;
  for (int idx = gtid; idx < 2 * 256 * 512; idx += gsz) {
    const int l = idx >> 17; const int rem = idx & 131071; const int kk = rem >> 8; const int j = rem & 255;
    const int k2 = kk & 255, blk = k2 >> 6, cp = k2 & 63;
    const float* w = p.w_fnet + ((size_t)l * 256 + blk * 64) * 256 + j;
    float a = 0.f;
    for (int c = 0; c < 64; ++c) {
      const float ang = (float)((c * cp) & 63) * (1.f / 32.f);
      const float tr = kk < 256 ? cospif(ang) : sinpif(ang);
      a += tr * w[(size_t)c * 256];
    }
    WfT[((size_t)l * 256 + j) * 512 + kk] = f2bf(a * fscale);
  }
  float2* tw = (float2*)(p.ws + OFF_TW);
  for (int t = gtid; t < 4096; t += gsz) { float s, c; sincospif((float)t * (1.f / 4096.f), &s, &c); tw[t] = make_float2(c, -s); }
  const int lane = tid & 63, gw = blockIdx.x * (NT / 64) + (tid >> 6), nw = gridDim.x * (NT / 64);
  bf16_t* memn = (bf16_t*)(p.ws + OFF_MEMN);
  for (int r = gw; r < 1536; r += nw) {
    const float* src = r < 1024 ? p.mem_prompt + (size_t)r * 1024 : p.mem_sample + (size_t)(r - 1024) * 1024;
    norm_row_bf16(src, memn + (size_t)r * 1024, lane);
  }
  bf16_t* xn = (bf16_t*)(p.ws + OFF_X);
  for (int t = gw; t < NTOK / 2; t += nw) {
    const float* s0 = xrow(p, 2 * t); const float* s1 = xrow(p, 2 * t + 1);
    float4 v0[4], v1[4]; float a0 = 0.f, a1 = 0.f;
#pragma unroll
    for (int i = 0; i < 4; ++i) { v0[i] = *(const float4*)(s0 + i * 256 + lane * 4); v1[i] = *(const float4*)(s1 + i * 256 + lane * 4); }
#pragma unroll
    for (int i = 0; i < 4; ++i) { a0 += v0[i].x * v0[i].x + v0[i].y * v0[i].y + v0[i].z * v0[i].z + v0[i].w * v0[i].w; a1 += v1[i].x * v1[i].x + v1[i].y * v1[i].y + v1[i].z * v1[i].z + v1[i].w * v1[i].w; }
    a0 = wave_sum(a0); a1 = wave_sum(a1);
    const float r0 = rsqrtf(a0 * (1.f / 1024.f) + 1e-6f), r1 = rsqrtf(a1 * (1.f / 1024.f) + 1e-6f);
    bf16_t* d0 = xn + (size_t)(2 * t) * 1024; bf16_t* d1 = d0 + 1024;
#pragma unroll
    for (int i = 0; i < 4; ++i) {
      uint2 o; o.x = pack2(v0[i].x * r0, v0[i].y * r0); o.y = pack2(v0[i].z * r0, v0[i].w * r0); *(uint2*)(d0 + i * 256 + lane * 4) = o;
      o.x = pack2(v1[i].x * r1, v1[i].y * r1); o.y = pack2(v1[i].z * r1, v1[i].w * r1); *(uint2*)(d1 + i * 256 + lane * 4) = o;
    }
  }
}

namespace pg8 {
#define PG8_LAS __attribute__((address_space(3)))
typedef unsigned short bf16_t;
typedef short bf16x8 __attribute__((ext_vector_type(8)));
typedef float f32x4 __attribute__((ext_vector_type(4)));
typedef unsigned u32x4 __attribute__((ext_vector_type(4)));
constexpr int BM = 256, BK = 64, HALF = 128, HTB = HALF * BK * 2  , STAGE_BYTES = 8 * HTB, NXCD = 8, WGM = 8;

__host__ __device__ __forceinline__ int lds_byte(int r, int c) { const int st = (r >> 4) * 2 + (c >> 5), rr = r & 15, cc = c & 31, ob = rr * 64 + cc * 2; return st * 1024 + (ob ^ (((ob >> 9) & 1) << 5)); }
__host__ __device__ __forceinline__ void stage_rc(int b, int& R, int& C) { const int st = b / 1024, sb = b % 1024, swz = sb ^ (((sb >> 9) & 1) << 5); R = (st >> 1) * 16 + swz / 64; C = (st & 1) * 32 + (swz % 64) / 2; }
__host__ __device__ __forceinline__ int perm32(int rho) { const int n = rho >> 4, i = rho & 15; return 8 * (i >> 2) + 4 * n + (i & 3); }

struct Unit { int pm, pn; };
struct Gemm { const bf16_t* A; const bf16_t* Bt; int M, N, K; };

struct StaticOrder {
    int nM, nN, nwg, G, c;
    __host__ __device__ void init(int M, int N, int G_, int c_) { nM = M / BM; nN = N / BM; nwg = nM * nN; G = G_; c = c_; }
    __host__ __device__ bool next(int i, Unit& u) const {
        const long L = (long)i * G + c; if (L >= nwg) return false;
        int wgid = (int)L; { const int q = nwg / NXCD, r = nwg % NXCD, xcd = wgid % NXCD, off = wgid / NXCD; wgid = (xcd < r ? xcd * (q + 1) : r * (q + 1) + (xcd - r) * q) + off; }
        const int nig = WGM * nN, gid = wgid / nig, fm = gid * WGM, gsz = (nM - fm) < WGM ? (nM - fm) : WGM;
        u.pm = fm + ((wgid % nig) % gsz); u.pn = (wgid % nig) / gsz; return true;
    }
    __device__ __forceinline__ void a_ready(const Unit&) const {}
    __device__ __forceinline__ void done(const Unit&) const {}
};
template <class Epi, class Sched, bool STAMP = false>
__device__ __forceinline__ void gemm_phase(PG8_LAS unsigned char* lds, const Gemm g, const Sched& S, const Epi& E, unsigned long long* stamps, const int tid_in) {
    const int tid = tid_in, wid = __builtin_amdgcn_readfirstlane(tid >> 6), lane = tid & 63, wr = wid >> 2, wc = wid & 3, fr = lane & 15, fq = lane >> 4;
    const int K = g.K, nt = K / BK;
    int ts_lo = 0, ts_hi = 0, nts = 0; const unsigned long long rt_entry = STAMP ? (unsigned long long)wall_clock64() : 0ull;
#define PG8_STAMP() do { if (STAMP && wid == 0 && nts < 64) { const unsigned long long _c = (unsigned long long)clock64(); \
        ts_lo = (lane == nts) ? (int)(unsigned)_c : ts_lo; ts_hi = (lane == nts) ? (int)(unsigned)(_c >> 32) : ts_hi; ++nts; } } while (0)
    PG8_STAMP();
    unsigned voffA[2], voffB[2];
#pragma unroll
    for (int i = 0; i < 2; ++i) { int R, C; stage_rc(tid * 16 + i * 8192, R, C); const int Rb = Epi::PERM ? ((R & ~31) + perm32(R & 31)) : R;
        voffA[i] = (unsigned)(R * K + C) * 2u; voffB[i] = (unsigned)(Rb * K + C) * 2u; }
    const size_t kstep = (size_t)(BK * 2);
    const size_t hstep = (size_t)HALF * K * 2;
    const size_t tstep = 2 * hstep;
    const unsigned ldsw = (unsigned)wid * 1024u;
    const int aoff = lds_byte(wr * 64 + fr, fq * 8), boff = lds_byte(wc * 32 + fr, fq * 8);
#define PG8_SA(b, h) (((b) * 2 + (h)) * HTB)
#define PG8_SB(b, h) ((4 + (b) * 2 + (h)) * HTB)
#define PG8_STAGE(bufoff, gbase, voff) do { _Pragma("unroll") for (int _i = 0; _i < 2; ++_i) \
        __builtin_amdgcn_global_load_lds((const unsigned*)((const char*)(gbase) + (voff)[_i]), (PG8_LAS unsigned*)(lds + (bufoff) + ldsw + _i * 8192), 16, 0, 0); } while (0)
#define PG8_LDA(dst, b, h) do { _Pragma("unroll") for (int m = 0; m < 4; ++m) _Pragma("unroll") for (int k = 0; k < 2; ++k) dst[m][k] = *(const PG8_LAS bf16x8*)(lds + PG8_SA(b, h) + aoff + m * 2048 + k * 1024); } while (0)
#define PG8_LDB(dst, b, h) do { _Pragma("unroll") for (int n = 0; n < 2; ++n) _Pragma("unroll") for (int k = 0; k < 2; ++k) dst[n][k] = *(const PG8_LAS bf16x8*)(lds + PG8_SB(b, h) + boff + n * 2048 + k * 1024); } while (0)
#define PG8_MMA(ai, bj, At, Bt) do { __builtin_amdgcn_s_setprio(1); _Pragma("unroll") for (int m = 0; m < 4; ++m) _Pragma("unroll") for (int n = 0; n < 2; ++n) _Pragma("unroll") for (int k = 0; k < 2; ++k) \
        acc[ai][bj][m][n] = __builtin_amdgcn_mfma_f32_16x16x32_bf16(Bt[n][k], At[m][k], acc[ai][bj][m][n], 0, 0, 0); __builtin_amdgcn_s_setprio(0); } while (0)
#define PG8_WAIT_V(n) asm volatile("s_waitcnt vmcnt(" #n ")" ::: "memory")
#define PG8_WAIT_L(n) asm volatile("s_waitcnt lgkmcnt(" #n ")" ::: "memory")
#define PG8_BAR __builtin_amdgcn_s_barrier()
#define PG8_SCHED __builtin_amdgcn_sched_barrier(0)
    Unit cur, nxt; int ui = 0;
    if (!S.next(0, cur)) return;
    f32x4 acc[2][2][4][2];
#pragma unroll
    for (int a = 0; a < 2; ++a)
#pragma unroll
        for (int b = 0; b < 2; ++b)
#pragma unroll
            for (int m = 0; m < 4; ++m)
#pragma unroll
                for (int n = 0; n < 2; ++n) acc[a][b][m][n] = (f32x4){0.f, 0.f, 0.f, 0.f};
    bf16x8 At[4][2], B0[2][2], B1[2][2];
    const char* cA = (const char*)g.A + (size_t)cur.pm * tstep; const char* cB = (const char*)g.Bt + (size_t)cur.pn * tstep;
    S.a_ready(cur);
    PG8_STAGE(PG8_SB(0, 0), cB, voffB); PG8_STAGE(PG8_SA(0, 0), cA, voffA); PG8_STAGE(PG8_SB(0, 1), cB + hstep, voffB); PG8_STAGE(PG8_SA(0, 1), cA + hstep, voffA);
    if (wr == 1) PG8_BAR;
    PG8_WAIT_V(4); PG8_BAR;
    PG8_STAGE(PG8_SB(1, 0), cB + kstep, voffB); PG8_STAGE(PG8_SA(1, 0), cA + kstep, voffA); PG8_STAGE(PG8_SB(1, 1), cB + hstep + kstep, voffB);
    PG8_WAIT_V(6); PG8_BAR;
    PG8_STAMP();
    for (;;) {
        const bool has_next = S.next(ui + 1, nxt);
        const char* nA = has_next ? (const char*)g.A + (size_t)nxt.pm * tstep : cA; const char* nB = has_next ? (const char*)g.Bt + (size_t)nxt.pn * tstep : cB;
        for (int t = 0; t < nt; t += 2) {
            const bool last = (t == nt - 2);
            const char* a1 = cA + (size_t)(t + 1) * kstep;
            const char* a2 = last ? nA : cA + (size_t)(t + 2) * kstep; const char* b2 = last ? nB : cB + (size_t)(t + 2) * kstep;
            const char* a3 = a2 + kstep; const char* b3 = b2 + kstep;
            if (last && has_next) S.a_ready(nxt);
            PG8_LDB(B0, 0, 0); PG8_SCHED; PG8_LDA(At, 0, 0); PG8_STAGE(PG8_SA(1, 1), a1 + hstep, voffA);
            PG8_WAIT_L(8); PG8_BAR; PG8_WAIT_L(0); PG8_MMA(0, 0, At, B0); PG8_BAR; PG8_SCHED;
            PG8_LDB(B1, 0, 1); PG8_STAGE(PG8_SB(0, 0), b2, voffB);
            PG8_BAR; PG8_WAIT_L(0); PG8_MMA(0, 1, At, B1); PG8_BAR;
            PG8_LDA(At, 0, 1); PG8_STAGE(PG8_SA(0, 0), a2, voffA);
            PG8_BAR; PG8_WAIT_L(0); PG8_MMA(1, 0, At, B0); PG8_BAR; PG8_SCHED;
            PG8_STAGE(PG8_SB(0, 1), b2 + hstep, voffB);
            PG8_WAIT_V(6); PG8_BAR; PG8_MMA(1, 1, At, B1); PG8_BAR;
            PG8_LDB(B0, 1, 0); PG8_SCHED; PG8_LDA(At, 1, 0); PG8_STAGE(PG8_SA(0, 1), a2 + hstep, voffA);
            PG8_WAIT_L(8); PG8_BAR; PG8_WAIT_L(0); PG8_MMA(0, 0, At, B0); PG8_BAR; PG8_SCHED;
            PG8_LDB(B1, 1, 1); PG8_STAGE(PG8_SB(1, 0), b3, voffB);
            PG8_BAR; PG8_WAIT_L(0); PG8_MMA(0, 1, At, B1); PG8_BAR;
            PG8_LDA(At, 1, 1); PG8_STAGE(PG8_SA(1, 0), a3, voffA);
            PG8_BAR; PG8_WAIT_L(0); PG8_MMA(1, 0, At, B0); PG8_BAR; PG8_SCHED;
            PG8_STAGE(PG8_SB(1, 1), b3 + hstep, voffB);
            PG8_WAIT_V(6); PG8_BAR; PG8_MMA(1, 1, At, B1); PG8_BAR;
        }
        PG8_STAMP();
        if constexpr (!Epi::AFTER_DRAIN) { E(acc, cur, wr, wc, fr, fq); S.done(cur); }
        PG8_STAMP();
        if (!has_next) break;
#pragma unroll
        for (int a = 0; a < 2; ++a)
#pragma unroll
            for (int b = 0; b < 2; ++b)
#pragma unroll
                for (int m = 0; m < 4; ++m)
#pragma unroll
                    for (int n = 0; n < 2; ++n) acc[a][b][m][n] = (f32x4){0.f, 0.f, 0.f, 0.f};
        cur = nxt; cA = nA; cB = nB; ++ui;
    }
    PG8_WAIT_V(0);
    if (wr == 0) PG8_BAR;
    PG8_BAR;
    if constexpr (Epi::AFTER_DRAIN) { E.fused(acc, cur, wr, wc, fr, fq, lds, wid, lane); S.done(cur); }
    PG8_STAMP();
    if (STAMP && wid == 0) { stamps[lane] = lane < nts ? (((unsigned long long)(unsigned)ts_hi << 32) | (unsigned)ts_lo) : 0ull;
        if (lane == 62) stamps[62] = rt_entry; if (lane == 63) stamps[63] = (unsigned long long)wall_clock64(); }
#undef PG8_STAMP
#undef PG8_SA
#undef PG8_SB
#undef PG8_STAGE
#undef PG8_LDA
#undef PG8_LDB
#undef PG8_MMA
#undef PG8_WAIT_V
#undef PG8_WAIT_L
#undef PG8_BAR
#undef PG8_SCHED
}
}

template <class F> struct EpiWrap {
  static constexpr bool PERM = false, AFTER_DRAIN = false;
  F f;
  DI void operator()(const f32x4 (&acc)[2][2][4][2], const pg8::Unit& u, int wr, int wc, int fr, int fq) const {
#pragma unroll
    for (int ai = 0; ai < 2; ++ai)
#pragma unroll
      for (int m = 0; m < 4; ++m) {
        const int row = u.pm * 256 + ai * 128 + wr * 64 + m * 16 + fr;
#pragma unroll
        for (int bj = 0; bj < 2; ++bj)
#pragma unroll
          for (int n = 0; n < 2; ++n) f(u.pn * 256 + bj * 128 + wc * 32 + n * 16 + 4 * fq, row, acc[ai][bj][m][n]);
      }
  }
};
template <class F>
DI void run_gemm_on(PG8_LAS unsigned char* lds, const bf16_t* A, const bf16_t* Bt, int M, int N, int K, const F& f, const int tid, int G, int c) {
  pg8::Gemm g; g.A = A; g.Bt = Bt; g.M = M; g.N = N; g.K = K;
  pg8::StaticOrder S; S.init(M, N, G, c);
  EpiWrap<F> E{f};
  pg8::gemm_phase<EpiWrap<F>, pg8::StaticOrder, false>(lds, g, S, E, nullptr, tid);
  __syncthreads();
}
template <class F>
DI void run_gemm(PG8_LAS unsigned char* lds, const bf16_t* A, const bf16_t* Bt, int M, int N, int K, const F& f, const int tid) {
  pg8::Gemm g; g.A = A; g.Bt = Bt; g.M = M; g.N = N; g.K = K;
  pg8::StaticOrder S; S.init(M, N, (int)gridDim.x, (int)blockIdx.x);
  EpiWrap<F> E{f};
  pg8::gemm_phase<EpiWrap<F>, pg8::StaticOrder, false>(lds, g, S, E, nullptr, tid);
  __syncthreads();
}

struct InProjEpi {
  unsigned char* ws;
  DI void operator()(int m, int n, const f32x4& v) const {
    if (m < 3072) {
      const int blk = m >> 8, c = m & 255;
      if (blk == 8) {
        bf16_t* cvt = (bf16_t*)(ws + OFF_CVT);
        const int seq = n >> 13, l = n & 8191;
        bf16_t* d = cvt + ((size_t)(seq * 256 + c)) * 8192 + l;
#pragma unroll
        for (int e = 0; e < 4; ++e) d[(size_t)e * 8192] = f2bf(v[e]);
      } else {
        bf16_t* d;
        if (blk >= 2 && blk <= 4) d = (bf16_t*)(ws + OFF_BQKV) + (size_t)n * 768 + (blk - 2) * 256 + c;
        else if (blk == 0 || blk == 5 || blk == 6 || blk == 10) d = (bf16_t*)(ws + OFF_MIX) + (size_t)n * 1024 + (blk == 0 ? 0 : blk == 5 ? 256 : blk == 6 ? 512 : 768) + c;
        else {
          size_t off = blk == 1 ? OFF_AZ : blk == 7 ? OFF_CK : blk == 9 ? OFF_CZ : OFF_DZ;
          d = (bf16_t*)(ws + off) + (size_t)n * 256 + c;
        }
        uint2 o; o.x = pack2(v[0], v[1]); o.y = pack2(v[2], v[3]); *(uint2*)d = o;
      }
    } else if (m < 3088) {
      float* g = (float*)(ws + OFF_GATES) + (size_t)n * 16 + (m - 3072);
      *(float4*)g = make_float4(v[0], v[1], v[2], v[3]);
    }
  }
};
struct MemKvEpi {
  unsigned char* ws; int l;
  DI void operator()(int m, int n, const f32x4& v) const {
    const int seq = n >> 8, key = n & 255;
    if (m < 256) {
      const int head = m >> 6, dim = m & 63;
      bf16_t* d = (bf16_t*)(ws + OFF_KMEM) + ((size_t)((l * 6 + seq) * 4 + head) * 256 + key) * 64 + dim;
      uint2 o; o.x = pack2(v[0], v[1]); o.y = pack2(v[2], v[3]); *(uint2*)d = o;
    } else {
      const int c = m - 256, head = c >> 6, dim = c & 63;
      bf16_t* d = (bf16_t*)(ws + OFF_VMEMT) + ((size_t)((l * 6 + seq) * 4 + head) * 64 + dim) * 256 + key;
#pragma unroll
      for (int e = 0; e < 4; ++e) d[e * 256] = f2bf(v[e]);
    }
  }
};
struct FnetEpi {
  unsigned char* ws;
  DI void operator()(int m, int n, const f32x4& v) const {
    const uint2 z = *(const uint2*)((const bf16_t*)(ws + OFF_AZ) + (size_t)n * 256 + m);
    uint2 o; o.x = pack2(v[0] * silu(bflo(z.x)), v[1] * silu(bfhi(z.x))); o.y = pack2(v[2] * silu(bflo(z.y)), v[3] * silu(bfhi(z.y)));
    *(uint2*)((bf16_t*)(ws + OFF_MIX) + (size_t)n * 1024 + m) = o;
  }
};
struct OutEpi {
  bf16_t* dst;
  DI void operator()(int m, int n, const f32x4& v) const { uint2 o; o.x = pack2(v[0], v[1]); o.y = pack2(v[2], v[3]); *(uint2*)(dst + (size_t)n * 1024 + m) = o; }
};

DI int fft_pos(int k) {
  return ((k & 1) << 12) | (((k >> 1) & 3) << 10) | (((k >> 3) & 3) << 8) | (((k >> 5) & 3) << 6) | (((k >> 7) & 3) << 4) | (((k >> 9) & 3) << 2) | ((k >> 11) & 3);
}
DI void fft_task(const Params& p, int task, float2* z, const int tid) {
  const int seq = task >> 7, cp = task & 127;
  const unsigned* au = (const unsigned*)(p.ws + OFF_MIX) + (size_t)seq * 8192 * 512 + cp;
  const float2* tw = (const float2*)(p.ws + OFF_TW);
  for (int i = tid; i < 8192; i += NT) { const unsigned u = au[(size_t)i * 512]; z[i] = make_float2(bflo(u), bfhi(u)); }
  __syncthreads();
  for (int b = tid; b < 4096; b += NT) {
    const float2 a = z[b], c = z[b + 4096], w = tw[b];
    z[b] = make_float2(a.x + c.x, a.y + c.y);
    const float dx = a.x - c.x, dy = a.y - c.y;
    z[b + 4096] = make_float2(dx * w.x - dy * w.y, dx * w.y + dy * w.x);
  }
  __syncthreads();
#pragma unroll 1
  for (int s4 = 0; s4 < 6; ++s4) {
    const int lq = 10 - 2 * s4, q = 1 << lq;
    for (int b = tid; b < 2048; b += NT) {
      const int j = b & (q - 1), i0 = ((b >> lq) << (lq + 2)) + j;
      const float2 a0 = z[i0], a1 = z[i0 + q], a2 = z[i0 + 2 * q], a3 = z[i0 + 3 * q];
      const float2 w1 = tw[j << (1 + 2 * s4)];
      const float2 w2 = make_float2(w1.x * w1.x - w1.y * w1.y, 2.f * w1.x * w1.y);
      const float2 w3 = make_float2(w2.x * w1.x - w2.y * w1.y, w2.x * w1.y + w2.y * w1.x);
      const float t0x = a0.x + a2.x, t0y = a0.y + a2.y, t1x = a0.x - a2.x, t1y = a0.y - a2.y;
      const float t2x = a1.x + a3.x, t2y = a1.y + a3.y, t3x = a1.y - a3.y, t3y = -(a1.x - a3.x);
      z[i0] = make_float2(t0x + t2x, t0y + t2y);
      const float y1x = t1x + t3x, y1y = t1y + t3y, y2x = t0x - t2x, y2y = t0y - t2y, y3x = t1x - t3x, y3y = t1y - t3y;
      z[i0 + q] = make_float2(y1x * w1.x - y1y * w1.y, y1x * w1.y + y1y * w1.x);
      z[i0 + 2 * q] = make_float2(y2x * w2.x - y2y * w2.y, y2x * w2.y + y2y * w2.x);
      z[i0 + 3 * q] = make_float2(y3x * w3.x - y3y * w3.y, y3x * w3.y + y3y * w3.x);
    }
    __syncthreads();
  }
  unsigned* H = (unsigned*)(p.ws + OFF_H) + (size_t)seq * 8192 * 256;
  for (int k = tid; k < 8192; k += NT) {
    const float2 zk = z[fft_pos(k)], zn = z[fft_pos((8192 - k) & 8191)];
    H[(size_t)k * 256 + cp] = pack2(0.5f * (zk.x + zn.x), 0.5f * (zk.y + zn.y));
    H[(size_t)k * 256 + 128 + cp] = pack2(0.5f * (zk.y - zn.y), -0.5f * (zk.x - zn.x));
  }
  __syncthreads();
}

template <bool NA>
DI void attn_core(const Params& p, int layer, int h, int tok0, int r, int c0, int rs, int wsx, const bf16_t* sK, const bf16_t* sVT, const float* sBias, int kb, int pitch, int vstride, int lane) {
  const int fr = lane & 15, fq = lane >> 4;
  bf16_t* Q = (bf16_t*)(p.ws + OFF_MIX) + (NA ? 512 : 768);
  const bf16_t* Z = (const bf16_t*)(p.ws + (NA ? OFF_CZ : OFF_DZ));
  const bf16_t* qp = Q + (size_t)(tok0 + fr) * 1024 + h * 64 + fq * 8;
  bf16x8 qf[2]; qf[0] = ld8(qp); qf[1] = ld8(qp + 32);
  f32x4 s[16];
  {
    bf16x8 kfA[4][2], kfB[4][2];
#define ATT_LDK(f_, k4_) do { _Pragma("unroll") for (int q = 0; q < 4; ++q) { const int kt = 4 * (k4_) + q; \
      const bf16_t* kp = sK + (kb + (kt >> 1) * pitch + (kt & 1) * 16 + fr) * 72 + fq * 8; f_[q][0] = ld8(kp); f_[q][1] = ld8(kp + 32); } } while (0)
#define ATT_MMK(f_, k4_) do { _Pragma("unroll") for (int q = 0; q < 4; ++q) { f32x4 a = MFMA16(f_[q][0], qf[0], ((f32x4){0.f, 0.f, 0.f, 0.f})); s[4 * (k4_) + q] = MFMA16(f_[q][1], qf[1], a); } } while (0)
    ATT_LDK(kfA, 0); __builtin_amdgcn_sched_barrier(0);
    ATT_LDK(kfB, 1); ATT_MMK(kfA, 0); __builtin_amdgcn_sched_barrier(0);
    ATT_LDK(kfA, 2); ATT_MMK(kfB, 1); __builtin_amdgcn_sched_barrier(0);
    ATT_LDK(kfB, 3); ATT_MMK(kfA, 2); __builtin_amdgcn_sched_barrier(0);
    ATT_MMK(kfB, 3);
#undef ATT_LDK
#undef ATT_MMK
  }
  float mx = -1e30f;
  if (NA) {
    const int c = c0 + fr, cs = min(max(c - 8, 0), 48);
#pragma unroll
    for (int kt = 0; kt < 16; ++kt) {
      const int kr = rs + (kt >> 1);
      const float* rb = sBias + (kr - r + 7) * 31;
#pragma unroll
      for (int e = 0; e < 4; ++e) {
        const int kc = wsx + (kt & 1) * 16 + 4 * fq + e;
        const bool valid = kc >= cs && kc < cs + 16;
        const float bias = rb[min(max(kc - c + 15, 0), 30)];
        const float v = valid ? s[kt][e] * 0.125f + bias : -1e30f;
        s[kt][e] = v; mx = fmaxf(mx, v);
      }
    }
  } else {
#pragma unroll
    for (int kt = 0; kt < 16; ++kt)
#pragma unroll
      for (int e = 0; e < 4; ++e) { const float v = s[kt][e] * 0.125f; s[kt][e] = v; mx = fmaxf(mx, v); }
  }
  mx = fmaxf(mx, __shfl_xor(mx, 16, 64)); mx = fmaxf(mx, __shfl_xor(mx, 32, 64));
  float sum = 0.f;
#pragma unroll
  for (int kt = 0; kt < 16; ++kt)
#pragma unroll
    for (int e = 0; e < 4; ++e) { const float pv = __expf(s[kt][e] - mx); s[kt][e] = pv; sum += pv; }
  sum += __shfl_xor(sum, 16, 64); sum += __shfl_xor(sum, 32, 64);
  const float inv = 1.f / sum;
  f32x4 o[4];
#pragma unroll
  for (int mt = 0; mt < 4; ++mt) o[mt] = (f32x4){0.f, 0.f, 0.f, 0.f};
  {
    bf16x8 vfA[2][4], vfB[2][4];
#define ATT_LDV(f_, u2_) do { _Pragma("unroll") for (int q = 0; q < 2; ++q) _Pragma("unroll") for (int mt = 0; mt < 4; ++mt) { \
      const bf16_t* vp = sVT + (16 * mt + fr) * vstride + kb + (2 * (u2_) + q) * pitch + 4 * fq; f_[q][mt] = ld4x2(vp, vp + 16); } } while (0)
#define ATT_MMV(f_, u2_) do { _Pragma("unroll") for (int q = 0; q < 2; ++q) { const bf16x8 pb = pack8(s[2 * (2 * (u2_) + q)], s[2 * (2 * (u2_) + q) + 1]); \
      _Pragma("unroll") for (int mt = 0; mt < 4; ++mt) o[mt] = MFMA16(f_[q][mt], pb, o[mt]); } } while (0)
    ATT_LDV(vfA, 0); __builtin_amdgcn_sched_barrier(0);
    ATT_LDV(vfB, 1); ATT_MMV(vfA, 0); __builtin_amdgcn_sched_barrier(0);
    ATT_LDV(vfA, 2); ATT_MMV(vfB, 1); __builtin_amdgcn_sched_barrier(0);
    ATT_LDV(vfB, 3); ATT_MMV(vfA, 2); __builtin_amdgcn_sched_barrier(0);
    ATT_MMV(vfB, 3);
#undef ATT_LDV
#undef ATT_MMV
  }
  const size_t orow = (size_t)(tok0 + fr) * 256 + h * 64 + 4 * fq, qrow = (size_t)(tok0 + fr) * 1024 + h * 64 + 4 * fq;
#pragma unroll
  for (int mt = 0; mt < 4; ++mt) {
    const uint2 z = *(const uint2*)(Z + orow + 16 * mt);
    uint2 w; w.x = pack2(o[mt][0] * inv * silu(bflo(z.x)), o[mt][1] * inv * silu(bfhi(z.x)));
    w.y = pack2(o[mt][2] * inv * silu(bflo(z.y)), o[mt][3] * inv * silu(bfhi(z.y)));
    *(uint2*)(Q + qrow + 16 * mt) = w;
  }
}
DI void na_block(const Params& p, int layer, int bt, char* smem, const int tid) {
  const int half = bt & 1, rg = (bt >> 1) & 31, h = (bt >> 6) & 3, seq = bt >> 8;
  const int r0 = rg * 4, rsmin = min(max(r0 - 4, 0), 120), nrows = min(11, 128 - rsmin), colbase = half ? 24 : 0;
  bf16_t* sK = (bf16_t*)smem; bf16_t* sVT = sK + 440 * 72; float* sBias = (float*)(sVT + 64 * 456);
  if (tid < 465) sBias[tid] = p.rpb[(size_t)(layer * 4 + h) * 465 + tid];
  const bf16_t* CK = (const bf16_t*)(p.ws + OFF_CK) + (size_t)(seq * 8192 + rsmin * 64 + colbase) * 256 + h * 64;
  const bf16_t* CVT = (const bf16_t*)(p.ws + OFF_CVT) + (size_t)(seq * 4 + h) * 64 * 8192 + rsmin * 64 + colbase;
  {
    const int nk = nrows * 40 * 8, per_dim = nrows * 5, nv = 64 * per_dim;
    uint4 rk[7], rv[7]; int dk[7], dv[7];
#pragma unroll
    for (int i = 0; i < 7; ++i) {
      const int idx = tid + NT * i;
      const int key = idx >> 3, ch = idx & 7, ri = key / 40, cj = key - ri * 40;
      dk[i] = idx < nk ? key * 72 + ch * 8 : -1;
      rk[i] = idx < nk ? *(const uint4*)(CK + (size_t)(ri * 64 + cj) * 256 + ch * 8) : make_uint4(0, 0, 0, 0);
      const int dim = idx / per_dim, rem = idx - dim * per_dim, r2 = rem / 5, c5 = rem - r2 * 5;
      dv[i] = idx < nv ? dim * 456 + r2 * 40 + c5 * 8 : -1;
      rv[i] = idx < nv ? *(const uint4*)(CVT + (size_t)dim * 8192 + r2 * 64 + c5 * 8) : make_uint4(0, 0, 0, 0);
    }
#pragma unroll
    for (int i = 0; i < 7; ++i) { if (dk[i] >= 0) *(uint4*)(sK + dk[i]) = rk[i]; if (dv[i] >= 0) *(uint4*)(sVT + dv[i]) = rv[i]; }
  }
  __syncthreads();
  {
    const int wave = tid >> 6, lane = tid & 63;
    const int r = r0 + (wave >> 1), c0 = 32 * half + 16 * (wave & 1);
    const int rs = min(max(r - 4, 0), 120), wsx = min(max(c0 - 8, 0), 32);
    attn_core<true>(p, layer, h, seq * 8192 + r * 64 + c0, r, c0, rs, wsx, sK, sVT, sBias, (rs - rsmin) * 40 + (wsx - colbase), 40, 456, lane);
  }
  __syncthreads();
}
DI void mem_block(const Params& p, int layer, int bt, char* smem, const int tid) {
  const int g = bt & 31, h = (bt >> 5) & 3, seq = bt >> 7;
  bf16_t* sK = (bf16_t*)smem; bf16_t* sVT = sK + 256 * 72;
  const bf16_t* Kg = (const bf16_t*)(p.ws + OFF_KMEM) + (size_t)((layer * 6 + seq) * 4 + h) * 256 * 64;
  const bf16_t* Vg = (const bf16_t*)(p.ws + OFF_VMEMT) + (size_t)((layer * 6 + seq) * 4 + h) * 64 * 256;
  {
    uint4 rk[4], rv[4];
#pragma unroll
    for (int i = 0; i < 4; ++i) { const int idx = tid + NT * i; rk[i] = *(const uint4*)(Kg + (size_t)idx * 8); rv[i] = *(const uint4*)(Vg + (size_t)idx * 8); }
#pragma unroll
    for (int i = 0; i < 4; ++i) { const int idx = tid + NT * i; *(uint4*)(sK + (idx >> 3) * 72 + (idx & 7) * 8) = rk[i]; *(uint4*)(sVT + (idx >> 5) * 264 + (idx & 31) * 8) = rv[i]; }
  }
  __syncthreads();
  {
    const int wave = tid >> 6, lane = tid & 63;
#pragma unroll 1
    for (int i = 0; i < 2; ++i) { int kb0 = 0; asm volatile("" : "+v"(kb0));
      attn_core<false>(p, layer, h, seq * 8192 + (g * 16 + wave * 2 + i) * 16, 0, 0, 0, 0, sK, sVT, nullptr, kb0, 32, 264, lane); }
  }
  __syncthreads();
}

DI void gdn_prep_tok8(const Params& p, int layer, int task, int lane) {
  const int tok0 = task * 8, seq = tok0 >> 13, l0 = tok0 & 8191;
  const bf16_t* X = (const bf16_t*)(p.ws + OFF_BQKV);
  const float* cw = p.conv_w + (size_t)layer * 5 * 768;
  unsigned kp[4][4];
#pragma unroll
  for (int i = 0; i < 3; ++i) {
    const int c = i * 256 + lane * 4;
    uint2 x[12];
#pragma unroll
    for (int jj = 0; jj < 12; ++jj) {
      const int ll = l0 + jj - 2;
      x[jj] = (ll >= 0 && ll < 8192) ? *(const uint2*)(X + (size_t)(tok0 + jj - 2) * 768 + c) : make_uint2(0u, 0u);
    }
    float4 w[5];
#pragma unroll
    for (int j = 0; j < 5; ++j) w[j] = *(const float4*)(cw + j * 768 + c);
    bf16_t* dst = (bf16_t*)(p.ws + (i == 0 ? OFF_QN : i == 1 ? OFF_KN : OFF_VN)) + (size_t)tok0 * 256 + lane * 4;
#pragma unroll
    for (int t = 0; t < 8; ++t) {
      float a0 = 0.f, a1 = 0.f, a2 = 0.f, a3 = 0.f;
#pragma unroll
      for (int j = 0; j < 5; ++j) { const uint2 xv = x[t + j]; a0 += w[j].x * bflo(xv.x); a1 += w[j].y * bfhi(xv.x); a2 += w[j].z * bflo(xv.y); a3 += w[j].w * bfhi(xv.y); }
      a0 = silu(a0); a1 = silu(a1); a2 = silu(a2); a3 = silu(a3);
      if (i < 2) {
        float ss = a0 * a0 + a1 * a1 + a2 * a2 + a3 * a3;
        ss += __shfl_xor(ss, 1, 64); ss += __shfl_xor(ss, 2, 64); ss += __shfl_xor(ss, 4, 64); ss += __shfl_xor(ss, 8, 64);
        const float rs = rsqrtf(ss + 1e-6f) * (i == 0 ? 0.125f : 1.f);
        a0 *= rs; a1 *= rs; a2 *= rs; a3 *= rs;
      }
      uint2 o; o.x = pack2(a0, a1); o.y = pack2(a2, a3);
      *(uint2*)(dst + (size_t)t * 256) = o;
      if (i == 1) {
        if (t & 1) { kp[0][t >> 1] |= (unsigned)f2bf(a0) << 16; kp[1][t >> 1] |= (unsigned)f2bf(a1) << 16; kp[2][t >> 1] |= (unsigned)f2bf(a2) << 16; kp[3][t >> 1] |= (unsigned)f2bf(a3) << 16; }
        else { kp[0][t >> 1] = f2bf(a0); kp[1][t >> 1] = f2bf(a1); kp[2][t >> 1] = f2bf(a2); kp[3][t >> 1] = f2bf(a3); }
      }
    }
  }
  bf16_t* kT = (bf16_t*)(p.ws + OFF_KT) + ((size_t)seq * 256 + lane * 4) * 8192 + l0;
#pragma unroll
  for (int e = 0; e < 4; ++e) *(uint4*)(kT + (size_t)e * 8192) = make_uint4(kp[e][0], kp[e][1], kp[e][2], kp[e][3]);
#pragma unroll
  for (int i2 = 0; i2 < 2; ++i2) {
    const int idx = lane + 64 * i2, gi = idx & 15;
    float* g = (float*)(p.ws + OFF_GATES) + (size_t)tok0 * 16 + idx;
    const float x = *g;
    float r;
    if (gi < 8) {
      const float y = x + p.dt_bias[layer * 8 + gi];
      const float sp = fmaxf(y, 0.f) + __logf(1.f + __expf(-fabsf(y)));
      r = -__expf(p.a_log[layer * 8 + gi]) * sp;
    } else r = 1.f / (1.f + __expf(-x));
    *g = r;
  }
}

DI void chunk_task(const Params& p, int bt, char* smem, const int tid) {
  const int n = bt & 127, head = (bt >> 7) & 3, seq = bt >> 9;
  const int lane = tid & 63, wave = tid >> 6, fr = lane & 15, fq = lane >> 4;
  float* sL = (float*)smem;
  float* sg = (float*)(smem + 32768);
  float* sbeta = sg + 128; float* sG = sbeta + 128;
  const float* gb = (const float*)(p.ws + OFF_GATES);
  const bf16_t* qn = (const bf16_t*)(p.ws + OFF_QN); const bf16_t* kn = (const bf16_t*)(p.ws + OFF_KN); const bf16_t* vn = (const bf16_t*)(p.ws + OFF_VN);
  const int tokbase = seq * 8192;
  if (tid < 128) {
    const int d = tid >> 6, r = tid & 63; const int pos = d ? 8191 - 64 * n - r : 64 * n + r;
    sg[tid] = gb[(size_t)(tokbase + pos) * 16 + d * 4 + head]; sbeta[tid] = gb[(size_t)(tokbase + pos) * 16 + 8 + d * 4 + head];
  }
  __syncthreads();
  if (tid < 128) {
    float a = sg[tid];
#pragma unroll
    for (int off = 1; off < 64; off <<= 1) { const float t = __shfl_up(a, off, 64); if (lane >= off) a += t; }
    sG[tid] = a;
  }
  __syncthreads();
  {
    const int d = wave >> 1;
    const int ct = ((seq * 4 + head) * 2 + d) * 128 + n;
    if ((wave & 1) == 0) {
      float* cv = (float*)(p.ws + OFF_CVEC) + (size_t)ct * 256;
      const float G = sG[d * 64 + lane], Gl = sG[d * 64 + 63];
      cv[lane] = __expf(G); cv[64 + lane] = __expf(Gl - G); if (lane == 0) cv[128] = __expf(Gl);
    }
    bf16_t* chqk = (bf16_t*)(p.ws + OFF_CHQK) + (size_t)ct * 4096;
    const int hoff = head * 64 + fq * 8;
    bf16x8 kB[4][2];
#pragma unroll
    for (int nt = 0; nt < 4; ++nt) {
      const int rB = 16 * nt + fr; const int posB = d ? 8191 - 64 * n - rB : 64 * n + rB;
      const size_t ob = (size_t)(tokbase + posB) * 256 + hoff;
      kB[nt][0] = ld8(kn + ob); kB[nt][1] = ld8(kn + ob + 32);
    }
    bf16x8 kA[2][2], qA[2][2];
#pragma unroll
    for (int si = 0; si < 2; ++si) {
      const int rA = 16 * (2 * (wave & 1) + si) + fr; const int posA = d ? 8191 - 64 * n - rA : 64 * n + rA;
      const size_t oa = (size_t)(tokbase + posA) * 256 + hoff;
      kA[si][0] = ld8(kn + oa); kA[si][1] = ld8(kn + oa + 32); qA[si][0] = ld8(qn + oa); qA[si][1] = ld8(qn + oa + 32);
    }
#pragma unroll
    for (int si = 0; si < 2; ++si) {
      const int strip = 2 * (wave & 1) + si;
#pragma unroll
      for (int nt = 0; nt < 4; ++nt) {
        f32x4 kk = (f32x4){0.f, 0.f, 0.f, 0.f}, qk = (f32x4){0.f, 0.f, 0.f, 0.f};
        kk = MFMA16(kA[si][0], kB[nt][0], kk); kk = MFMA16(kA[si][1], kB[nt][1], kk);
        qk = MFMA16(qA[si][0], kB[nt][0], qk); qk = MFMA16(qA[si][1], kB[nt][1], qk);
        const int sc = 16 * nt + fr;
#pragma unroll
        for (int e = 0; e < 4; ++e) {
          const int r = 16 * strip + 4 * fq + e;
          const float dec = sc <= r ? __expf(sG[d * 64 + r] - sG[d * 64 + sc]) : 0.f;
          sL[d * 4096 + r * 64 + sc] = sc < r ? sbeta[d * 64 + r] * kk[e] * dec : 0.f;
          chqk[r * 64 + sc] = f2bf(qk[e] * dec);
        }
      }
    }
  }
  __syncthreads();
  {
    const int wvu = __builtin_amdgcn_readfirstlane(wave);
    const int d = wvu >> 1, half = wvu & 1;
    const int ct = ((seq * 4 + head) * 2 + d) * 128 + n;
    const bf16_t* src = (half ? kn : vn) + (size_t)(tokbase + (d ? 8191 - 64 * n : 64 * n)) * 256 + head * 64 + lane;
    const int rstep = d ? -256 : 256;
    float sol[64];
#pragma unroll
    for (int r = 0; r < 64; ++r) sol[r] = bf2f(src[r * rstep]);
#pragma unroll
    for (int r4 = 0; r4 < 16; ++r4) {
      const float4 b4 = *(const float4*)(sbeta + d * 64 + 4 * r4); const float4 g4 = *(const float4*)(sG + d * 64 + 4 * r4);
      sol[4 * r4 + 0] *= half ? b4.x * __expf(g4.x) : b4.x; sol[4 * r4 + 1] *= half ? b4.y * __expf(g4.y) : b4.y;
      sol[4 * r4 + 2] *= half ? b4.z * __expf(g4.z) : b4.z; sol[4 * r4 + 3] *= half ? b4.w * __expf(g4.w) : b4.w;
    }
    const float* Ld = sL + d * 4096;
#pragma unroll
    for (int b = 0; b < 4; ++b) {
#pragma unroll
      for (int j4 = 0; j4 < 4 * b; ++j4) {
        float4 lv[16];
#pragma unroll
        for (int q = 0; q < 16; ++q) lv[q] = *(const float4*)(Ld + (16 * b + q) * 64 + 4 * j4);
#pragma unroll
        for (int q = 0; q < 16; ++q) {
          float a = sol[16 * b + q];
          a -= lv[q].x * sol[4 * j4 + 0]; a -= lv[q].y * sol[4 * j4 + 1]; a -= lv[q].z * sol[4 * j4 + 2]; a -= lv[q].w * sol[4 * j4 + 3];
          sol[16 * b + q] = a;
        }
      }
#pragma unroll
      for (int g4 = 0; g4 < 4; ++g4) {
        float4 lv[16];
#pragma unroll
        for (int q = 4 * g4 + 1; q < 16; ++q) lv[q] = *(const float4*)(Ld + (16 * b + q) * 64 + 16 * b + 4 * g4);
        sol[16 * b + 4 * g4 + 1] -= lv[4 * g4 + 1].x * sol[16 * b + 4 * g4];
        sol[16 * b + 4 * g4 + 2] -= lv[4 * g4 + 2].x * sol[16 * b + 4 * g4] + lv[4 * g4 + 2].y * sol[16 * b + 4 * g4 + 1];
        sol[16 * b + 4 * g4 + 3] -= lv[4 * g4 + 3].x * sol[16 * b + 4 * g4] + lv[4 * g4 + 3].y * sol[16 * b + 4 * g4 + 1] + lv[4 * g4 + 3].z * sol[16 * b + 4 * g4 + 2];
#pragma unroll
        for (int q = 4 * g4 + 4; q < 16; ++q) {
          float a = sol[16 * b + q];
          a -= lv[q].x * sol[16 * b + 4 * g4 + 0]; a -= lv[q].y * sol[16 * b + 4 * g4 + 1]; a -= lv[q].z * sol[16 * b + 4 * g4 + 2]; a -= lv[q].w * sol[16 * b + 4 * g4 + 3];
          sol[16 * b + q] = a;
        }
      }
    }
    if (!half) {
      bf16_t* chu = (bf16_t*)(p.ws + OFF_CHU) + (size_t)ct * 4096 + lane * 64;
#pragma unroll
      for (int r8 = 0; r8 < 8; ++r8) {
        uint4 o; o.x = pack2(sol[r8 * 8 + 0], sol[r8 * 8 + 1]); o.y = pack2(sol[r8 * 8 + 2], sol[r8 * 8 + 3]);
        o.z = pack2(sol[r8 * 8 + 4], sol[r8 * 8 + 5]); o.w = pack2(sol[r8 * 8 + 6], sol[r8 * 8 + 7]);
        *(uint4*)(chu + r8 * 8) = o;
      }
    } else {
      bf16_t* chw = (bf16_t*)(p.ws + OFF_CHW) + (size_t)ct * 4096 + lane;
#pragma unroll
      for (int r = 0; r < 64; ++r) chw[r * 64] = f2bf(sol[r]);
    }
  }
  __syncthreads();
}

DI uint4 rev8(uint4 v) {
  uint4 r;
  r.x = (v.w >> 16) | (v.w << 16); r.y = (v.z >> 16) | (v.z << 16); r.z = (v.y >> 16) | (v.y << 16); r.w = (v.x >> 16) | (v.x << 16);
  return r;
}
DI void scan_task(const Params& p, int task, char* smem, const int tid) {
  const int d = task & 1, head = (task >> 1) & 3, seq = task >> 3;
  const bool loader = tid >= 256;
  const int lt = tid & 255, lane = tid & 63, wave = lt >> 6, fr = lane & 15, fq = lane >> 4;
  const int row0 = lt >> 3, c8 = (lt & 7) * 8, rc8 = (7 - (lt & 7)) * 8;
  constexpr int BUFB = 49152;
  const int ctb = ((seq * 4 + head) * 2 + d) * 128;
  const bf16_t* chw = (const bf16_t*)(p.ws + OFF_CHW); const bf16_t* chu = (const bf16_t*)(p.ws + OFF_CHU); const bf16_t* chqk = (const bf16_t*)(p.ws + OFF_CHQK);
  const float* cvec = (const float*)(p.ws + OFF_CVEC);
  const bf16_t* qn = (const bf16_t*)(p.ws + OFF_QN) + (size_t)seq * 8192 * 256 + head * 64;
  const bf16_t* kT = (const bf16_t*)(p.ws + OFF_KT) + (size_t)(seq * 256 + head * 64) * 8192;
  bf16_t* O = (bf16_t*)(p.ws + (d ? OFF_OB : OFF_OF)) + (size_t)seq * 8192 * 256 + head * 64 + 32 * (wave & 1) + fr;
#define SCAN_STAGE(n_, buf_) do { \
    const size_t cb = (size_t)(ctb + (n_)) * 4096 + row0 * 64 + c8; \
    const uint4 rw0 = *(const uint4*)(chw + cb), rw1 = *(const uint4*)(chw + cb + 2048); \
    const uint4 rqk0 = *(const uint4*)(chqk + cb), rqk1 = *(const uint4*)(chqk + cb + 2048); \
    const uint4 ru0 = *(const uint4*)(chu + cb), ru1 = *(const uint4*)(chu + cb + 2048); \
    const int pos0 = d ? 8191 - 64 * (n_) - row0 : 64 * (n_) + row0, pos1 = d ? pos0 - 32 : pos0 + 32; \
    const uint4 rq0 = *(const uint4*)(qn + (size_t)pos0 * 256 + c8), rq1 = *(const uint4*)(qn + (size_t)pos1 * 256 + c8); \
    const int lbase = d ? 8191 - 64 * (n_) - 63 : 64 * (n_); \
    const uint4 rkt0 = *(const uint4*)(kT + (size_t)row0 * 8192 + lbase + c8), rkt1 = *(const uint4*)(kT + (size_t)(row0 + 32) * 8192 + lbase + c8); \
    const float rv = cvec[(size_t)(ctb + (n_)) * 256 + (lt < 129 ? lt : 128)]; \
    bf16_t* sW_ = (bf16_t*)(smem + (buf_) * BUFB); bf16_t* sQK_ = sW_ + 64 * 72; bf16_t* sQ_ = sQK_ + 64 * 72; bf16_t* sKT_ = sQ_ + 64 * 72; bf16_t* sU_ = sKT_ + 64 * 72; \
    float* sV_ = (float*)(smem + (buf_) * BUFB + 5 * 64 * 72 * 2); \
    *(uint4*)(sW_ + row0 * 72 + c8) = rw0; *(uint4*)(sW_ + (row0 + 32) * 72 + c8) = rw1; \
    *(uint4*)(sQK_ + row0 * 72 + c8) = rqk0; *(uint4*)(sQK_ + (row0 + 32) * 72 + c8) = rqk1; \
    *(uint4*)(sU_ + row0 * 72 + c8) = ru0; *(uint4*)(sU_ + (row0 + 32) * 72 + c8) = ru1; \
    *(uint4*)(sQ_ + row0 * 72 + c8) = rq0; *(uint4*)(sQ_ + (row0 + 32) * 72 + c8) = rq1; \
    if (d) { *(uint4*)(sKT_ + row0 * 72 + rc8) = rev8(rkt0); *(uint4*)(sKT_ + (row0 + 32) * 72 + rc8) = rev8(rkt1); } \
    else { *(uint4*)(sKT_ + row0 * 72 + c8) = rkt0; *(uint4*)(sKT_ + (row0 + 32) * 72 + c8) = rkt1; } \
    if (lt < 129) sV_[lt] = rv; } while (0)
#define SCAN_BAR() do { asm volatile("s_waitcnt lgkmcnt(0)" ::: "memory"); __builtin_amdgcn_s_barrier(); asm volatile("" ::: "memory"); } while (0)
  f32x4 S[4][2];
#pragma unroll
  for (int mt = 0; mt < 4; ++mt) { S[mt][0] = (f32x4){0.f, 0.f, 0.f, 0.f}; S[mt][1] = (f32x4){0.f, 0.f, 0.f, 0.f}; }
#define SCAN_LDF(f_, base_, h2_) do { _Pragma("unroll") for (int m2 = 0; m2 < 2; ++m2) { const bf16_t* p_ = (base_) + (16 * (2 * (h2_) + m2) + fr) * 72 + 4 * fq; \
    f_[m2][0] = ld4x2(p_, p_ + 16); f_[m2][1] = ld4x2(p_ + 32, p_ + 48); } } while (0)
#define SCAN_SB() __builtin_amdgcn_sched_barrier(0)
#define SCAN_COMPUTE(n_, buf_) do { \
    const bf16_t* sW = (const bf16_t*)(smem + (buf_) * BUFB); const bf16_t* sQK = sW + 64 * 72; const bf16_t* sQ = sQK + 64 * 72; const bf16_t* sKT = sQ + 64 * 72; const bf16_t* sU = sKT + 64 * 72; \
    const float* sV = (const float*)(smem + (buf_) * BUFB + 5 * 64 * 72 * 2); \
    bf16x8 fA[2][2], fB[2][2]; \
    SCAN_LDF(fA, sW, 0); SCAN_SB(); \
    bf16x8 Sb[2][2]; \
    _Pragma("unroll") for (int nt = 0; nt < 2; ++nt) { Sb[0][nt] = pack8(S[0][nt], S[1][nt]); Sb[1][nt] = pack8(S[2][nt], S[3][nt]); } \
    f32x4 v[4][2], o[4][2]; \
      \
    SCAN_LDF(fB, sW, 1); \
    _Pragma("unroll") for (int m2 = 0; m2 < 2; ++m2) _Pragma("unroll") for (int nt = 0; nt < 2; ++nt) { \
      v[m2][nt] = MFMA16(fA[m2][0], Sb[0][nt], ((f32x4){0.f, 0.f, 0.f, 0.f})); v[m2][nt] = MFMA16(fA[m2][1], Sb[1][nt], v[m2][nt]); } \
    SCAN_SB(); \
    SCAN_LDF(fA, sQ, 0); \
    _Pragma("unroll") for (int m2 = 0; m2 < 2; ++m2) _Pragma("unroll") for (int nt = 0; nt < 2; ++nt) { \
      v[2 + m2][nt] = MFMA16(fB[m2][0], Sb[0][nt], ((f32x4){0.f, 0.f, 0.f, 0.f})); v[2 + m2][nt] = MFMA16(fB[m2][1], Sb[1][nt], v[2 + m2][nt]); } \
    SCAN_SB(); \
    SCAN_LDF(fB, sQ, 1); \
    _Pragma("unroll") for (int m2 = 0; m2 < 2; ++m2) _Pragma("unroll") for (int nt = 0; nt < 2; ++nt) { \
      o[m2][nt] = MFMA16(fA[m2][0], Sb[0][nt], ((f32x4){0.f, 0.f, 0.f, 0.f})); o[m2][nt] = MFMA16(fA[m2][1], Sb[1][nt], o[m2][nt]); } \
    SCAN_SB(); \
    SCAN_LDF(fA, sKT, 0); \
    _Pragma("unroll") for (int m2 = 0; m2 < 2; ++m2) _Pragma("unroll") for (int nt = 0; nt < 2; ++nt) { \
      o[2 + m2][nt] = MFMA16(fB[m2][0], Sb[0][nt], ((f32x4){0.f, 0.f, 0.f, 0.f})); o[2 + m2][nt] = MFMA16(fB[m2][1], Sb[1][nt], o[2 + m2][nt]); } \
    SCAN_SB(); \
    bf16x8 Vb[2][2], Vkb[2][2]; \
    {   \
      _Pragma("unroll") for (int mt = 0; mt < 4; ++mt) { \
        const float4 eg = *(const float4*)(sV + 16 * mt + 4 * fq); \
        _Pragma("unroll") for (int nt = 0; nt < 2; ++nt) { \
          const uint2 u = *(const uint2*)(sU + (32 * wave + 16 * nt + fr) * 72 + 16 * mt + 4 * fq); \
          v[mt][nt][0] = bflo(u.x) - v[mt][nt][0]; v[mt][nt][1] = bfhi(u.x) - v[mt][nt][1]; v[mt][nt][2] = bflo(u.y) - v[mt][nt][2]; v[mt][nt][3] = bfhi(u.y) - v[mt][nt][3]; \
          o[mt][nt][0] *= eg.x; o[mt][nt][1] *= eg.y; o[mt][nt][2] *= eg.z; o[mt][nt][3] *= eg.w; } \
      } \
      _Pragma("unroll") for (int nt = 0; nt < 2; ++nt) { \
        Vb[0][nt] = pack8(v[0][nt], v[1][nt]); Vb[1][nt] = pack8(v[2][nt], v[3][nt]); } \
      _Pragma("unroll") for (int mt = 0; mt < 4; ++mt) { \
        const float4 ek = *(const float4*)(sV + 64 + 16 * mt + 4 * fq); \
        _Pragma("unroll") for (int nt = 0; nt < 2; ++nt) { v[mt][nt][0] *= ek.x; v[mt][nt][1] *= ek.y; v[mt][nt][2] *= ek.z; v[mt][nt][3] *= ek.w; } } \
      _Pragma("unroll") for (int nt = 0; nt < 2; ++nt) { \
        Vkb[0][nt] = pack8(v[0][nt], v[1][nt]); Vkb[1][nt] = pack8(v[2][nt], v[3][nt]); } \
    } \
    const float gl = sV[128]; \
    SCAN_SB(); \
    SCAN_LDF(fB, sKT, 1); \
    _Pragma("unroll") for (int m2 = 0; m2 < 2; ++m2) _Pragma("unroll") for (int nt = 0; nt < 2; ++nt) { \
      f32x4 a; a[0] = S[m2][nt][0] * gl; a[1] = S[m2][nt][1] * gl; a[2] = S[m2][nt][2] * gl; a[3] = S[m2][nt][3] * gl; \
      a = MFMA16(fA[m2][0], Vkb[0][nt], a); S[m2][nt] = MFMA16(fA[m2][1], Vkb[1][nt], a); } \
    SCAN_SB(); \
    SCAN_LDF(fA, sQK, 0); \
    _Pragma("unroll") for (int m2 = 0; m2 < 2; ++m2) _Pragma("unroll") for (int nt = 0; nt < 2; ++nt) { \
      f32x4 a; a[0] = S[2 + m2][nt][0] * gl; a[1] = S[2 + m2][nt][1] * gl; a[2] = S[2 + m2][nt][2] * gl; a[3] = S[2 + m2][nt][3] * gl; \
      a = MFMA16(fB[m2][0], Vkb[0][nt], a); S[2 + m2][nt] = MFMA16(fB[m2][1], Vkb[1][nt], a); } \
    SCAN_SB(); \
    SCAN_LDF(fB, sQK, 1); \
    _Pragma("unroll") for (int m2 = 0; m2 < 2; ++m2) _Pragma("unroll") for (int nt = 0; nt < 2; ++nt) { \
      o[m2][nt] = MFMA16(fA[m2][0], Vb[0][nt], o[m2][nt]); o[m2][nt] = MFMA16(fA[m2][1], Vb[1][nt], o[m2][nt]); } \
    SCAN_SB(); \
    _Pragma("unroll") for (int m2 = 0; m2 < 2; ++m2) _Pragma("unroll") for (int nt = 0; nt < 2; ++nt) { \
      o[2 + m2][nt] = MFMA16(fB[m2][0], Vb[0][nt], o[2 + m2][nt]); o[2 + m2][nt] = MFMA16(fB[m2][1], Vb[1][nt], o[2 + m2][nt]); } \
    _Pragma("unroll") for (int mt = 0; mt < 4; ++mt) _Pragma("unroll") for (int e = 0; e < 4; ++e) { \
      const int r_ = 16 * mt + 4 * fq + e; const int pos = d ? 8191 - 64 * (n_) - r_ : 64 * (n_) + r_; \
      O[(size_t)pos * 256] = f2bf(o[mt][0][e]); O[(size_t)pos * 256 + 16] = f2bf(o[mt][1][e]); \
    } } while (0)
  __syncthreads();
  if (loader) SCAN_STAGE(0, 0);
  SCAN_BAR();
#pragma unroll 1
  for (int n = 0; n < 128; ++n) {
    if (loader) { if (n + 1 < 128) SCAN_STAGE(n + 1, ((n + 1) & 1)); }
    else if (wave < 2) SCAN_COMPUTE(n, (n & 1));
    SCAN_BAR();
  }
  asm volatile("s_waitcnt vmcnt(0)" ::: "memory");
  __syncthreads();
#undef SCAN_STAGE
#undef SCAN_BAR
#undef SCAN_COMPUTE
#undef SCAN_LDF
#undef SCAN_SB
}

DI void gdn_finish_tok4(const Params& p, int layer, int tok0, int lane) {
  const float4 g = *(const float4*)(p.gdn_g + layer * 64 + (lane & 15) * 4);
  uint2 a[4], b[4], z[4];
#pragma unroll
  for (int t = 0; t < 4; ++t) {
    const size_t ro = (size_t)(tok0 + t) * 256 + lane * 4;
    a[t] = *(const uint2*)((const bf16_t*)(p.ws + OFF_OF) + ro); b[t] = *(const uint2*)((const bf16_t*)(p.ws + OFF_OB) + ro);
    z[t] = *(const uint2*)((const bf16_t*)(p.ws + OFF_MIX) + (size_t)(tok0 + t) * 1024 + 256 + lane * 4);
  }
#pragma unroll
  for (int t = 0; t < 4; ++t) {
    const float o0 = bflo(a[t].x) + bflo(b[t].x), o1 = bfhi(a[t].x) + bfhi(b[t].x), o2 = bflo(a[t].y) + bflo(b[t].y), o3 = bfhi(a[t].y) + bfhi(b[t].y);
    float ss = o0 * o0 + o1 * o1 + o2 * o2 + o3 * o3;
    ss += __shfl_xor(ss, 1, 64); ss += __shfl_xor(ss, 2, 64); ss += __shfl_xor(ss, 4, 64); ss += __shfl_xor(ss, 8, 64);
    const float rs = rsqrtf(ss * (1.f / 64.f) + 1e-6f);
    uint2 w; w.x = pack2(o0 * rs * g.x * silu(bflo(z[t].x)), o1 * rs * g.y * silu(bfhi(z[t].x)));
    w.y = pack2(o2 * rs * g.z * silu(bflo(z[t].y)), o3 * rs * g.w * silu(bfhi(z[t].y)));
    *(uint2*)((bf16_t*)(p.ws + OFF_MIX) + (size_t)(tok0 + t) * 1024 + 256 + lane * 4) = w;
  }
}

DI void post_token2(const Params& p, int layer, int tok0, int lane) {
  const float* pg = p.post_g + layer * 1024;
  uint2 ob[2][4]; float4 xr[2][4], g[4];
#pragma unroll
  for (int t = 0; t < 2; ++t) {
    const bf16_t* o = (const bf16_t*)(p.ws + OFF_OUTTMP) + (size_t)(tok0 + t) * 1024;
    const float* xp = layer == 0 ? xrow(p, tok0 + t) : p.out + (size_t)(tok0 + t) * 1024;
#pragma unroll
    for (int i = 0; i < 4; ++i) { ob[t][i] = *(const uint2*)(o + i * 256 + lane * 4); xr[t][i] = *(const float4*)(xp + i * 256 + lane * 4); }
  }
#pragma unroll
  for (int i = 0; i < 4; ++i) g[i] = *(const float4*)(pg + i * 256 + lane * 4);
#pragma unroll
  for (int t = 0; t < 2; ++t) {
    float4 v[4]; float ss = 0.f;
#pragma unroll
    for (int i = 0; i < 4; ++i) { const uint2 u = ob[t][i]; v[i] = make_float4(bflo(u.x), bfhi(u.x), bflo(u.y), bfhi(u.y));
      ss += v[i].x * v[i].x + v[i].y * v[i].y + v[i].z * v[i].z + v[i].w * v[i].w; }
    ss = wave_sum(ss);
    const float rs = rsqrtf(ss * (1.f / 1024.f) + 1e-6f);
    float ss2 = 0.f;
#pragma unroll
    for (int i = 0; i < 4; ++i) {
      const float4 x = xr[t][i];
      v[i].x = x.x + v[i].x * rs * g[i].x; v[i].y = x.y + v[i].y * rs * g[i].y; v[i].z = x.z + v[i].z * rs * g[i].z; v[i].w = x.w + v[i].w * rs * g[i].w;
      ss2 += v[i].x * v[i].x + v[i].y * v[i].y + v[i].z * v[i].z + v[i].w * v[i].w;
      *(float4*)(p.out + (size_t)(tok0 + t) * 1024 + i * 256 + lane * 4) = v[i];
    }
    if (layer == 0) {
      ss2 = wave_sum(ss2);
      const float rs2 = rsqrtf(ss2 * (1.f / 1024.f) + 1e-6f);
      bf16_t* dst = (bf16_t*)(p.ws + OFF_X) + (size_t)(tok0 + t) * 1024;
#pragma unroll
      for (int i = 0; i < 4; ++i) { uint2 w; w.x = pack2(v[i].x * rs2, v[i].y * rs2); w.y = pack2(v[i].z * rs2, v[i].w * rs2); *(uint2*)(dst + i * 256 + lane * 4) = w; }
    }
  }
}

#define XB_TMO      128
#define XB_XCNT(j)  (256  + 64 * (j))
#define XB_XSUB(j)  (1280 + 64 * (j))
#define XB_XGEN(j)  (2304 + 64 * (j))
#define XB_TOP      3328
#define XB_TOPGEN   3392
#define XCD_BAR_WORDS 3456
#define XB_SPIN_CAP (1u << 18)
#define XLAS __attribute__((address_space(3)))

__device__ __forceinline__ unsigned xb_ld(unsigned* p)              { return __hip_atomic_load(p, __ATOMIC_RELAXED, __HIP_MEMORY_SCOPE_AGENT); }
__device__ __forceinline__ unsigned xb_add(unsigned* p, unsigned v) { return __hip_atomic_fetch_add(p, v, __ATOMIC_RELAXED, __HIP_MEMORY_SCOPE_AGENT); }
__device__ __forceinline__ unsigned xb_xcc_id() { return (unsigned)__builtin_amdgcn_s_getreg((3 << 11) | 20) & 0xFu; }
#define XB_SPIN(cond, bar) do { unsigned _sp = 0; while (cond) { __builtin_amdgcn_s_sleep(1); \
    if ((++_sp & 255u) == 0u) { if (xb_ld(&(bar)[XB_TMO])) break; if (_sp > XB_SPIN_CAP) { atomicAdd(&(bar)[XB_TMO], 1u); break; } } } } while (0)

struct XcdBarrier {
    unsigned* bar; unsigned x;
    volatile XLAS unsigned* st;
};

__device__ __forceinline__ XcdBarrier xcd_barrier_post(unsigned* bar, volatile XLAS unsigned* st) {
    XcdBarrier b; b.bar = bar; b.x = xb_xcc_id(); b.st = st;
    if (threadIdx.x == 0) (void)xb_add(&bar[XB_XCNT(b.x)], 1u);
    return b;
}
__device__ __forceinline__ void xcd_barrier_complete(unsigned* bar, unsigned x, unsigned& nloc, unsigned& nx) {
    const unsigned G = gridDim.x * gridDim.y * gridDim.z;
    unsigned sum, cnt, mine, sp = 0u;
    for (;;) {
        sum = 0u; cnt = 0u; mine = 0u;
#pragma unroll
        for (unsigned j = 0; j < 16; ++j) { const unsigned c = xb_ld(&bar[XB_XCNT(j)]); sum += c; cnt += (c > 0u) ? 1u : 0u; mine = (j == x) ? c : mine; }
        if (sum == G) break;
        __builtin_amdgcn_s_sleep(1);
        if ((++sp & 255u) == 0u) { if (xb_ld(&bar[XB_TMO])) break; if (sp > XB_SPIN_CAP) { atomicAdd(&bar[XB_TMO], 1u); break; } }
    }
    nloc = mine > 0u ? mine : 1u; nx = cnt > 0u ? cnt : 1u;
}

__device__ __forceinline__ void xcd_barrier(const XcdBarrier& b) {
    asm volatile("s_waitcnt vmcnt(0)" ::: "memory");
    __syncthreads();
    if (threadIdx.x == 0) {
        unsigned* bar = b.bar;
        __builtin_amdgcn_s_waitcnt(0);
        unsigned nloc = b.st[0], nx = b.st[1];
        if (nloc == 0u) { xcd_barrier_complete(bar, b.x, nloc, nx); b.st[0] = nloc; b.st[1] = nx; }
        const unsigned old = xb_add(&bar[XB_XSUB(b.x)], 1u);
        const unsigned gen = old / nloc;
        if (old + 1u == (gen + 1u) * nloc) {
            __builtin_amdgcn_fence(__ATOMIC_RELEASE, "agent");
            asm volatile("s_waitcnt vmcnt(0)" ::: "memory");
            const unsigned og = xb_add(&bar[XB_TOP], 1u);
            const unsigned tg = og / nx;
            if (og + 1u == (tg + 1u) * nx) xb_add(&bar[XB_TOPGEN], 1u);
            else XB_SPIN(xb_ld(&bar[XB_TOPGEN]) == tg, bar);
            __builtin_amdgcn_fence(__ATOMIC_ACQUIRE, "agent");
            xb_add(&bar[XB_XGEN(b.x)], 1u);
            asm volatile("s_waitcnt vmcnt(0)" ::: "memory");
        } else {
            XB_SPIN(xb_ld(&bar[XB_XGEN(b.x)]) == gen, bar);
            __builtin_amdgcn_fence(__ATOMIC_ACQUIRE, "agent");
            asm volatile("s_waitcnt vmcnt(0)" ::: "memory");
        }
    }
    __syncthreads();
}

constexpr int LDS_BYTES = 131072;
__global__ void __launch_bounds__(NT, 2) fwd_megakernel(Params p0) {
  cg::grid_group grid = cg::this_grid();
  extern __shared__ __attribute__((aligned(16))) unsigned char shm[];
  char* smem = (char*)shm;
  PG8_LAS unsigned char* lds = (PG8_LAS unsigned char*)shm;
  const int nb = gridDim.x, bid = blockIdx.x, nw = gridDim.x * (NT / 64);
  __shared__ __attribute__((aligned(16))) unsigned xb_st[4];
  if (threadIdx.x < 4) xb_st[threadIdx.x] = 0u;
  __syncthreads();
  const XcdBarrier xbar = xcd_barrier_post((unsigned*)(p0.ws + OFF_BAR), (volatile XLAS unsigned*)xb_st);
#define GSYNC() xcd_barrier(xbar)
#define PH_BEGIN const Params p = launder(p0); const int tid = ltid(); const int lane = tid & 63; const int gw = bid * (NT / 64) + (tid >> 6); (void)lane; (void)gw;
  { PH_BEGIN phase0(p, tid); }
  grid.sync();
#pragma unroll 1
  for (int layer = 0; layer < 2; ++layer) {
    {
      PH_BEGIN
      InProjEpi epi{p.ws};
      run_gemm(lds, (const bf16_t*)(p.ws + OFF_X), (const bf16_t*)(p.ws + OFF_WIN) + (size_t)layer * NPAD * 1024, NTOK, NPAD, 1024, epi, tid);
    }
    if (layer == 0 && bid >= 192 && bid < 216) {
      PH_BEGIN
      const int l2 = (bid - 192) / 12, c = (bid - 192) - 12 * l2;
      MemKvEpi me{p.ws, l2};
      run_gemm_on(lds, (const bf16_t*)(p.ws + OFF_MEMN), (const bf16_t*)(p.ws + OFF_WMEM) + (size_t)l2 * 512 * 1024, 1536, 512, 1024, me, tid, 12, c);
    }
    GSYNC();
    { PH_BEGIN
#pragma unroll 1
      for (int t = bid; t < 1536; t += nb) na_block(p, layer, t, smem, tid); }
    { PH_BEGIN
#pragma unroll 1
      for (int t = gw; t < NTOK / 8; t += nw) gdn_prep_tok8(p, layer, t, lane); }
    GSYNC();
    { PH_BEGIN
      const int half = tid >> 8;
#pragma unroll 1
      for (int t = bid; t < 1536; t += nb) chunk_task(p, 2 * t + half, smem + half * 36864, tid & 255); }
    GSYNC();
    if (bid < 48) { PH_BEGIN scan_task(p, bid, smem, tid); }
    else { PH_BEGIN
#pragma unroll 1
      for (int t = bid - 48; t < 768; t += nb - 48) fft_task(p, t, (float2*)smem, tid);
#pragma unroll 1
      for (int t = bid - 48; t < 768; t += nb - 48) mem_block(p, layer, t, smem, tid); }
    GSYNC();
    { PH_BEGIN
#pragma unroll 1
      for (int t = gw; t < NTOK / 4; t += nw) gdn_finish_tok4(p, layer, 4 * t, lane); }
    {
      PH_BEGIN
      FnetEpi fe{p.ws};
      run_gemm(lds, (const bf16_t*)(p.ws + OFF_H), (const bf16_t*)(p.ws + OFF_WF) + (size_t)layer * 256 * 512, NTOK, 256, 512, fe, tid);
    }
    GSYNC();
    {
      PH_BEGIN
      OutEpi oe{(bf16_t*)(p.ws + OFF_OUTTMP)};
      run_gemm(lds, (const bf16_t*)(p.ws + OFF_MIX), (const bf16_t*)(p.ws + OFF_WOUT) + (size_t)layer * 1024 * 1024, NTOK, 1024, 1024, oe, tid);
    }
    GSYNC();
    { PH_BEGIN
#pragma unroll 1
      for (int t = gw; t < NTOK / 2; t += nw) post_token2(p, layer, 2 * t, lane); }
    if (layer == 0) GSYNC();
  }
}

extern "C" void kernel_launch(void* const* d_in, const int* in_sizes, int n_in, void* d_out, int out_size, void* d_ws, size_t ws_size, hipStream_t stream) {
  static int grid_blocks = 0;
  if (!grid_blocks) {
    int dev = 0, cus = 0, per_cu = 0;
    (void)hipGetDevice(&dev);
    (void)hipDeviceGetAttribute(&cus, hipDeviceAttributeMultiprocessorCount, dev);
    if (hipFuncSetAttribute((const void*)fwd_megakernel, hipFuncAttributeMaxDynamicSharedMemorySize, LDS_BYTES) != hipSuccess) fprintf(stderr, "hipFuncSetAttribute failed\n");
    (void)hipOccupancyMaxActiveBlocksPerMultiprocessor(&per_cu, fwd_megakernel, NT, LDS_BYTES);
    if (per_cu > 1) per_cu = 1;
    grid_blocks = cus * per_cu;
    if (grid_blocks <= 0) { fprintf(stderr, "occupancy query returned %d x %d\n", cus, per_cu); grid_blocks = -1; }
  }
  if (grid_blocks < 0) return;
  if (ws_size < WS_NEED || n_in != 16) { fprintf(stderr, "kernel_launch: need %zu bytes of workspace, got %zu (n_in %d)\n", (size_t)WS_NEED, ws_size, n_in); return; }
  Params p{};
  p.x_prompt = (const float*)d_in[0]; p.x_sample = (const float*)d_in[1]; p.mem_prompt = (const float*)d_in[2]; p.mem_sample = (const float*)d_in[3];
  p.pre_g = (const float*)d_in[4]; p.post_g = (const float*)d_in[5]; p.w_in = (const float*)d_in[6]; p.w_fnet = (const float*)d_in[7];
  p.conv_w = (const float*)d_in[8]; p.a_log = (const float*)d_in[9]; p.dt_bias = (const float*)d_in[10]; p.gdn_g = (const float*)d_in[11];
  p.rpb = (const float*)d_in[12]; p.mem_g = (const float*)d_in[13]; p.w_mem_kv = (const float*)d_in[14]; p.w_out = (const float*)d_in[15];
  p.out = (float*)d_out; p.ws = (unsigned char*)d_ws;
  if (hipMemsetAsync((unsigned char*)d_ws + OFF_BAR, 0, XCD_BAR_WORDS * sizeof(unsigned), stream) != hipSuccess) { fprintf(stderr, "memset failed\n"); return; }
  void* args[] = {&p};
  hipError_t e = hipLaunchCooperativeKernel((void*)fwd_megakernel, dim3(grid_blocks), dim3(NT), args, LDS_BYTES, stream);
  if (e != hipSuccess) fprintf(stderr, "cooperative launch failed: %s (grid %d)\n", hipGetErrorString(e), grid_blocks);
}
```

```cpp
#include <hip/hip_runtime.h>
#include <hip/hip_cooperative_groups.h>
#include <cstdio>
namespace cg = cooperative_groups;

typedef unsigned short bf16_t;
typedef short bf16x8 __attribute__((ext_vector_type(8)));
typedef float f32x4 __attribute__((ext_vector_type(4)));

#define NT 512
#define DI __device__ __forceinline__
#define MFMA16(a, b, c) __builtin_amdgcn_mfma_f32_16x16x32_bf16((a), (b), (c), 0, 0, 0)

constexpr int SEQL = 8192, NTOK = 49152;
constexpr size_t MiB = (size_t)1 << 20;
constexpr int NPAD = 3328;
constexpr size_t OFF_WIN = 0, OFF_WOUT = 13631488, OFF_WMEM = 17825792, OFF_WF = 19922944, OFF_MEMN = 20447232,
                 OFF_KMEM = 23592960, OFF_VMEMT = 25165824, OFF_TW = 26738688;
constexpr size_t OFF_MIX = 26 * MiB, OFF_AZ = 122 * MiB, OFF_CZ = 146 * MiB, OFF_DZ = 170 * MiB, OFF_GATES = 194 * MiB, OFF_X = 197 * MiB,
                 OFF_BQKV = 293 * MiB, OFF_CK = 365 * MiB, OFF_CVT = 389 * MiB;
constexpr size_t OFF_H = OFF_X, OFF_QN = 245 * MiB, OFF_KN = 269 * MiB, OFF_KT = 464 * MiB, OFF_VN = 488 * MiB;
constexpr size_t OFF_CHW = 293 * MiB, OFF_CHU = 341 * MiB, OFF_CHQK = 389 * MiB, OFF_CVEC = 437 * MiB;
constexpr size_t OFF_OF = OFF_KN, OFF_OB = OFF_VN, OFF_OUTTMP = 293 * MiB;
constexpr size_t OFF_BAR = 26771456;
constexpr size_t WS_NEED = 512 * MiB;

struct Params {
  const float* x_prompt; const float* x_sample; const float* mem_prompt; const float* mem_sample;
  const float* pre_g; const float* post_g; const float* w_in; const float* w_fnet; const float* conv_w;
  const float* a_log; const float* dt_bias; const float* gdn_g; const float* rpb; const float* mem_g;
  const float* w_mem_kv; const float* w_out;
  float* out; unsigned char* ws;
};

typedef float f32x2_t __attribute__((ext_vector_type(2)));
typedef __bf16 bf16x2_t __attribute__((ext_vector_type(2)));
DI unsigned pack2(float lo, float hi) { f32x2_t f = {lo, hi}; return __builtin_bit_cast(unsigned, __builtin_convertvector(f, bf16x2_t)); }
DI bf16_t f2bf(float x) { return (bf16_t)(pack2(x, 0.f) & 0xffffu); }
DI float bf2f(bf16_t h) { return __uint_as_float(((unsigned)h) << 16); }
DI float bflo(unsigned u) { return __uint_as_float(u << 16); }
DI float bfhi(unsigned u) { return __uint_as_float(u & 0xffff0000u); }
DI float wave_sum(float v) {
#pragma unroll
  for (int m = 32; m >= 1; m >>= 1) v += __shfl_xor(v, m, 64);
  return v;
}
DI float silu(float x) { return x / (1.f + __expf(-x)); }
DI bf16x8 pack8(const f32x4& a, const f32x4& b) {
  uint4 u; u.x = pack2(a[0], a[1]); u.y = pack2(a[2], a[3]); u.z = pack2(b[0], b[1]); u.w = pack2(b[2], b[3]);
  return __builtin_bit_cast(bf16x8, u);
}
DI bf16x8 ld8(const bf16_t* p) { return *(const bf16x8*)p; }
DI bf16x8 ld4x2(const bf16_t* lo, const bf16_t* hi) {
  uint2 a = *(const uint2*)lo, b = *(const uint2*)hi; uint4 u; u.x = a.x; u.y = a.y; u.z = b.x; u.w = b.y;
  return __builtin_bit_cast(bf16x8, u);
}
DI int ltid() { int t = threadIdx.x; asm volatile("" : "+v"(t)); return t; }
DI Params launder(Params p) { size_t z = 0; asm volatile("" : "+s"(z)); p.ws = p.ws + z; return p; }
DI const float* xrow(const Params& p, int tok) {
  return tok < 32768 ? p.x_prompt + (size_t)tok * 1024 : p.x_sample + (size_t)(tok - 32768) * 1024;
}

DI void norm_row_bf16(const float* src, bf16_t* dst, int lane) {
  float4 v[4]; float ss = 0.f;
#pragma unroll
  for (int i = 0; i < 4; ++i) { v[i] = *(const float4*)(src + i * 256 + lane * 4); ss += v[i].x * v[i].x + v[i].y * v[i].y + v[i].z * v[i].z + v[i].w * v[i].w; }
  ss = wave_sum(ss);
  const float rs = rsqrtf(ss * (1.f / 1024.f) + 1e-6f);
#pragma unroll
  for (int i = 0; i < 4; ++i) { uint2 o; o.x = pack2(v[i].x * rs, v[i].y * rs); o.y = pack2(v[i].z * rs, v[i].w * rs); *(uint2*)(dst + i * 256 + lane * 4) = o; }
}

DI void phase0(const Params& p, const int tid) {
  const int gtid = blockIdx.x * NT + tid, gsz = gridDim.x * NT;
  bf16_t* WinT = (bf16_t*)(p.ws + OFF_WIN);
  for (int idx = gtid; idx < 2 * NPAD * 128; idx += gsz) {
    const int l = idx / (NPAD * 128); const int rem = idx - l * NPAD * 128; const int k8 = rem / NPAD; const int r = rem - k8 * NPAD;
    const int src = r < 1536 ? r : (r < 3072 ? r + 16 : (r < 3088 ? 1536 + (r - 3072) : -1));
    uint4 o = make_uint4(0, 0, 0, 0);
    if (src >= 0) {
      const float* w = p.w_in + ((size_t)l * 1024 + k8 * 8) * 3088 + src;
      const float* g = p.pre_g + l * 1024 + k8 * 8;
      float v[8];
#pragma unroll
      for (int j = 0; j < 8; ++j) v[j] = w[(size_t)j * 3088] * g[j];
      o.x = pack2(v[0], v[1]); o.y = pack2(v[2], v[3]); o.z = pack2(v[4], v[5]); o.w = pack2(v[6], v[7]);
    }
    *(uint4*)(WinT + ((size_t)l * NPAD + r) * 1024 + k8 * 8) = o;
  }
  bf16_t* WoutT = (bf16_t*)(p.ws + OFF_WOUT);
  for (int idx = gtid; idx < 2 * 1024 * 128; idx += gsz) {
    const int l = idx / (1024 * 128); const int rem = idx - l * 1024 * 128; const int k8 = rem / 1024; const int r = rem - k8 * 1024;
    const float* w = p.w_out + ((size_t)l * 1024 + k8 * 8) * 1024 + r;
    float v[8];
#pragma unroll
    for (int j = 0; j < 8; ++j) v[j] = w[(size_t)j * 1024];
    uint4 o; o.x = pack2(v[0], v[1]); o.y = pack2(v[2], v[3]); o.z = pack2(v[4], v[5]); o.w = pack2(v[6], v[7]);
    *(uint4*)(WoutT + ((size_t)l * 1024 + r) * 1024 + k8 * 8) = o;
  }
  bf16_t* WmemT = (bf16_t*)(p.ws + OFF_WMEM);
  for (int idx = gtid; idx < 2 * 512 * 128; idx += gsz) {
    const int l = idx / (512 * 128); const int rem = idx - l * 512 * 128; const int k8 = rem / 512; const int r = rem - k8 * 512;
    const float* w = p.w_mem_kv + ((size_t)l * 1024 + k8 * 8) * 512 + r;
    const float* g = p.mem_g + l * 1024 + k8 * 8;
    float v[8];
#pragma unroll
    for (int j = 0; j < 8; ++j) v[j] = w[(size_t)j * 512] * g[j];
    uint4 o; o.x = pack2(v[0], v[1]); o.y = pack2(v[2], v[3]); o.z = pack2(v[4], v[5]); o.w = pack2(v[6], v[7]);
    *(uint4*)(WmemT + ((size_t)l * 512 + r) * 1024 + k8 * 8) = o;
  }
  bf16_t* WfT = (bf16_t*)(p.ws + OFF_WF);
  const float fscale = 0.00138106793f;
  for (int idx = gtid; idx < 2 * 256 * 512; idx += gsz) {
    const int l = idx >> 17; const int rem = idx & 131071; const int kk = rem >> 8; const int j = rem & 255;
    const int k2 = kk & 255, blk = k2 >> 6, cp = k2 & 63;
    const float* w = p.w_fnet + ((size_t)l * 256 + blk * 64) * 256 + j;
    float a = 0.f;
    for (int c = 0; c < 64; ++c) {
      const float turns = (float)((c * cp) & 63) * (1.f / 64.f);
      const float tr = kk < 256 ? __builtin_amdgcn_cosf(turns) : __builtin_amdgcn_sinf(turns);
      a += tr * w[(size_t)c * 256];
    }
    WfT[((size_t)l * 256 + j) * 512 + kk] = f2bf(a * fscale);
  }
  float2* tw = (float2*)(p.ws + OFF_TW);
  for (int t = gtid; t < 4096; t += gsz) { float s, c; sincospif((float)t * (1.f / 4096.f), &s, &c); tw[t] = make_float2(c, -s); }
  const int lane = tid & 63, gw = blockIdx.x * (NT / 64) + (tid >> 6), nw = gridDim.x * (NT / 64);
  bf16_t* memn = (bf16_t*)(p.ws + OFF_MEMN);
  for (int r = gw; r < 1536; r += nw) {
    const float* src = r < 1024 ? p.mem_prompt + (size_t)r * 1024 : p.mem_sample + (size_t)(r - 1024) * 1024;
    norm_row_bf16(src, memn + (size_t)r * 1024, lane);
  }
  bf16_t* xn = (bf16_t*)(p.ws + OFF_X);
  for (int t = gw; t < NTOK / 2; t += nw) {
    const float* s0 = xrow(p, 2 * t); const float* s1 = xrow(p, 2 * t + 1);
    float4 v0[4], v1[4]; float a0 = 0.f, a1 = 0.f;
#pragma unroll
    for (int i = 0; i < 4; ++i) { v0[i] = *(const float4*)(s0 + i * 256 + lane * 4); v1[i] = *(const float4*)(s1 + i * 256 + lane * 4); }
#pragma unroll
    for (int i = 0; i < 4; ++i) { a0 += v0[i].x * v0[i].x + v0[i].y * v0[i].y + v0[i].z * v0[i].z + v0[i].w * v0[i].w; a1 += v1[i].x * v1[i].x + v1[i].y * v1[i].y + v1[i].z * v1[i].z + v1[i].w * v1[i].w; }
    a0 = wave_sum(a0); a1 = wave_sum(a1);
    const float r0 = rsqrtf(a0 * (1.f / 1024.f) + 1e-6f), r1 = rsqrtf(a1 * (1.f / 1024.f) + 1e-6f);
    bf16_t* d0 = xn + (size_t)(2 * t) * 1024; bf16_t* d1 = d0 + 1024;
#pragma unroll
    for (int i = 0; i < 4; ++i) {
      uint2 o; o.x = pack2(v0[i].x * r0, v0[i].y * r0); o.y = pack2(v0[i].z * r0, v0[i].w * r0); *(uint2*)(d0 + i * 256 + lane * 4) = o;
      o.x = pack2(v1[i].x * r1, v1[i].y * r1); o.y = pack2(v1[i].z * r1, v1[i].w * r1); *(uint2*)(d1 + i * 256 + lane * 4) = o;
    }
  }
}

namespace pg8 {
#define PG8_LAS __attribute__((address_space(3)))
typedef unsigned short bf16_t;
typedef short bf16x8 __attribute__((ext_vector_type(8)));
typedef float f32x4 __attribute__((ext_vector_type(4)));
typedef unsigned u32x4 __attribute__((ext_vector_type(4)));
constexpr int BM = 256, BK = 64, HALF = 128, HTB = HALF * BK * 2  , STAGE_BYTES = 8 * HTB, NXCD = 8, WGM = 8;

__host__ __device__ __forceinline__ int lds_byte(int r, int c) { const int st = (r >> 4) * 2 + (c >> 5), rr = r & 15, cc = c & 31, ob = rr * 64 + cc * 2; return st * 1024 + (ob ^ (((ob >> 9) & 1) << 5)); }
__host__ __device__ __forceinline__ void stage_rc(int b, int& R, int& C) { const int st = b / 1024, sb = b % 1024, swz = sb ^ (((sb >> 9) & 1) << 5); R = (st >> 1) * 16 + swz / 64; C = (st & 1) * 32 + (swz % 64) / 2; }
__host__ __device__ __forceinline__ int perm32(int rho) { const int n = rho >> 4, i = rho & 15; return 8 * (i >> 2) + 4 * n + (i & 3); }

struct Unit { int pm, pn; };
struct Gemm { const bf16_t* A; const bf16_t* Bt; int M, N, K; };

struct StaticOrder {
    int nM, nN, nwg, G, c;
    __host__ __device__ void init(int M, int N, int G_, int c_) { nM = M / BM; nN = N / BM; nwg = nM * nN; G = G_; c = c_; }
    __host__ __device__ bool next(int i, Unit& u) const {
        const long L = (long)i * G + c; if (L >= nwg) return false;
        int wgid = (int)L; { const int q = nwg / NXCD, r = nwg % NXCD, xcd = wgid % NXCD, off = wgid / NXCD; wgid = (xcd < r ? xcd * (q + 1) : r * (q + 1) + (xcd - r) * q) + off; }
        const int nig = WGM * nN, gid = wgid / nig, fm = gid * WGM, gsz = (nM - fm) < WGM ? (nM - fm) : WGM;
        u.pm = fm + ((wgid % nig) % gsz); u.pn = (wgid % nig) / gsz; return true;
    }
    __device__ __forceinline__ void a_ready(const Unit&) const {}
    __device__ __forceinline__ void done(const Unit&) const {}
};
template <class Epi, class Sched, bool STAMP = false>
__device__ __forceinline__ void gemm_phase(PG8_LAS unsigned char* lds, const Gemm g, const Sched& S, const Epi& E, unsigned long long* stamps, const int tid_in) {
    const int tid = tid_in, wid = __builtin_amdgcn_readfirstlane(tid >> 6), lane = tid & 63, wr = wid >> 2, wc = wid & 3, fr = lane & 15, fq = lane >> 4;
    const int K = g.K, nt = K / BK;
    int ts_lo = 0, ts_hi = 0, nts = 0; const unsigned long long rt_entry = STAMP ? (unsigned long long)wall_clock64() : 0ull;
#define PG8_STAMP() do { if (STAMP && wid == 0 && nts < 64) { const unsigned long long _c = (unsigned long long)clock64(); \
        ts_lo = (lane == nts) ? (int)(unsigned)_c : ts_lo; ts_hi = (lane == nts) ? (int)(unsigned)(_c >> 32) : ts_hi; ++nts; } } while (0)
    PG8_STAMP();
    unsigned voffA[2], voffB[2];
#pragma unroll
    for (int i = 0; i < 2; ++i) { int R, C; stage_rc(tid * 16 + i * 8192, R, C); const int Rb = Epi::PERM ? ((R & ~31) + perm32(R & 31)) : R;
        voffA[i] = (unsigned)(R * K + C) * 2u; voffB[i] = (unsigned)(Rb * K + C) * 2u; }
    const size_t kstep = (size_t)(BK * 2);
    const size_t hstep = (size_t)HALF * K * 2;
    const size_t tstep = 2 * hstep;
    const unsigned ldsw = (unsigned)wid * 1024u;
    const int aoff = lds_byte(wr * 64 + fr, fq * 8), boff = lds_byte(wc * 32 + fr, fq * 8);
#define PG8_SA(b, h) (((b) * 2 + (h)) * HTB)
#define PG8_SB(b, h) ((4 + (b) * 2 + (h)) * HTB)
#define PG8_STAGE(bufoff, gbase, voff) do { _Pragma("unroll") for (int _i = 0; _i < 2; ++_i) \
        __builtin_amdgcn_global_load_lds((const unsigned*)((const char*)(gbase) + (voff)[_i]), (PG8_LAS unsigned*)(lds + (bufoff) + ldsw + _i * 8192), 16, 0, 0); } while (0)
#define PG8_LDA(dst, b, h) do { _Pragma("unroll") for (int m = 0; m < 4; ++m) _Pragma("unroll") for (int k = 0; k < 2; ++k) dst[m][k] = *(const PG8_LAS bf16x8*)(lds + PG8_SA(b, h) + aoff + m * 2048 + k * 1024); } while (0)
#define PG8_LDB(dst, b, h) do { _Pragma("unroll") for (int n = 0; n < 2; ++n) _Pragma("unroll") for (int k = 0; k < 2; ++k) dst[n][k] = *(const PG8_LAS bf16x8*)(lds + PG8_SB(b, h) + boff + n * 2048 + k * 1024); } while (0)
#define PG8_MMA(ai, bj, At, Bt) do { __builtin_amdgcn_s_setprio(1); _Pragma("unroll") for (int m = 0; m < 4; ++m) _Pragma("unroll") for (int n = 0; n < 2; ++n) _Pragma("unroll") for (int k = 0; k < 2; ++k) \
        acc[ai][bj][m][n] = __builtin_amdgcn_mfma_f32_16x16x32_bf16(Bt[n][k], At[m][k], acc[ai][bj][m][n], 0, 0, 0); __builtin_amdgcn_s_setprio(0); } while (0)
#define PG8_WAIT_V(n) asm volatile("s_waitcnt vmcnt(" #n ")" ::: "memory")
#define PG8_WAIT_L(n) asm volatile("s_waitcnt lgkmcnt(" #n ")" ::: "memory")
#define PG8_BAR __builtin_amdgcn_s_barrier()
#define PG8_SCHED __builtin_amdgcn_sched_barrier(0)
    Unit cur, nxt; int ui = 0;
    if (!S.next(0, cur)) return;
    f32x4 acc[2][2][4][2];
#pragma unroll
    for (int a = 0; a < 2; ++a)
#pragma unroll
        for (int b = 0; b < 2; ++b)
#pragma unroll
            for (int m = 0; m < 4; ++m)
#pragma unroll
                for (int n = 0; n < 2; ++n) acc[a][b][m][n] = (f32x4){0.f, 0.f, 0.f, 0.f};
    bf16x8 At[4][2], B0[2][2], B1[2][2];
    const char* cA = (const char*)g.A + (size_t)cur.pm * tstep; const char* cB = (const char*)g.Bt + (size_t)cur.pn * tstep;
    S.a_ready(cur);
    PG8_STAGE(PG8_SB(0, 0), cB, voffB); PG8_STAGE(PG8_SA(0, 0), cA, voffA); PG8_STAGE(PG8_SB(0, 1), cB + hstep, voffB); PG8_STAGE(PG8_SA(0, 1), cA + hstep, voffA);
    if (wr == 1) PG8_BAR;
    PG8_WAIT_V(4); PG8_BAR;
    PG8_STAGE(PG8_SB(1, 0), cB + kstep, voffB); PG8_STAGE(PG8_SA(1, 0), cA + kstep, voffA); PG8_STAGE(PG8_SB(1, 1), cB + hstep + kstep, voffB);
    PG8_WAIT_V(6); PG8_BAR;
    PG8_STAMP();
    for (;;) {
        const bool has_next = S.next(ui + 1, nxt);
        const char* nA = has_next ? (const char*)g.A + (size_t)nxt.pm * tstep : cA; const char* nB = has_next ? (const char*)g.Bt + (size_t)nxt.pn * tstep : cB;
        for (int t = 0; t < nt; t += 2) {
            const bool last = (t == nt - 2);
            const char* a1 = cA + (size_t)(t + 1) * kstep;
            const char* a2 = last ? nA : cA + (size_t)(t + 2) * kstep; const char* b2 = last ? nB : cB + (size_t)(t + 2) * kstep;
            const char* a3 = a2 + kstep; const char* b3 = b2 + kstep;
            if (last && has_next) S.a_ready(nxt);
            PG8_LDB(B0, 0, 0); PG8_SCHED; PG8_LDA(At, 0, 0); PG8_STAGE(PG8_SA(1, 1), a1 + hstep, voffA);
            PG8_WAIT_L(8); PG8_BAR; PG8_WAIT_L(0); PG8_MMA(0, 0, At, B0); PG8_BAR; PG8_SCHED;
            PG8_LDB(B1, 0, 1); PG8_STAGE(PG8_SB(0, 0), b2, voffB);
            PG8_BAR; PG8_WAIT_L(0); PG8_MMA(0, 1, At, B1); PG8_BAR;
            PG8_LDA(At, 0, 1); PG8_STAGE(PG8_SA(0, 0), a2, voffA);
            PG8_BAR; PG8_WAIT_L(0); PG8_MMA(1, 0, At, B0); PG8_BAR; PG8_SCHED;
            PG8_STAGE(PG8_SB(0, 1), b2 + hstep, voffB);
            PG8_WAIT_V(6); PG8_BAR; PG8_MMA(1, 1, At, B1); PG8_BAR;
            PG8_LDB(B0, 1, 0); PG8_SCHED; PG8_LDA(At, 1, 0); PG8_STAGE(PG8_SA(0, 1), a2 + hstep, voffA);
            PG8_WAIT_L(8); PG8_BAR; PG8_WAIT_L(0); PG8_MMA(0, 0, At, B0); PG8_BAR; PG8_SCHED;
            PG8_LDB(B1, 1, 1); PG8_STAGE(PG8_SB(1, 0), b3, voffB);
            PG8_BAR; PG8_WAIT_L(0); PG8_MMA(0, 1, At, B1); PG8_BAR;
            PG8_LDA(At, 1, 1); PG8_STAGE(PG8_SA(1, 0), a3, voffA);
            PG8_BAR; PG8_WAIT_L(0); PG8_MMA(1, 0, At, B0); PG8_BAR; PG8_SCHED;
            PG8_STAGE(PG8_SB(1, 1), b3 + hstep, voffB);
            PG8_WAIT_V(6); PG8_BAR; PG8_MMA(1, 1, At, B1); PG8_BAR;
        }
        PG8_STAMP();
        if constexpr (!Epi::AFTER_DRAIN) { E(acc, cur, wr, wc, fr, fq); S.done(cur); }
        PG8_STAMP();
        if (!has_next) break;
#pragma unroll
        for (int a = 0; a < 2; ++a)
#pragma unroll
            for (int b = 0; b < 2; ++b)
#pragma unroll
                for (int m = 0; m < 4; ++m)
#pragma unroll
                    for (int n = 0; n < 2; ++n) acc[a][b][m][n] = (f32x4){0.f, 0.f, 0.f, 0.f};
        cur = nxt; cA = nA; cB = nB; ++ui;
    }
    PG8_WAIT_V(0);
    if (wr == 0) PG8_BAR;
    PG8_BAR;
    if constexpr (Epi::AFTER_DRAIN) { E.fused(acc, cur, wr, wc, fr, fq, lds, wid, lane); S.done(cur); }
    PG8_STAMP();
    if (STAMP && wid == 0) { stamps[lane] = lane < nts ? (((unsigned long long)(unsigned)ts_hi << 32) | (unsigned)ts_lo) : 0ull;
        if (lane == 62) stamps[62] = rt_entry; if (lane == 63) stamps[63] = (unsigned long long)wall_clock64(); }
#undef PG8_STAMP
#undef PG8_SA
#undef PG8_SB
#undef PG8_STAGE
#undef PG8_LDA
#undef PG8_LDB
#undef PG8_MMA
#undef PG8_WAIT_V
#undef PG8_WAIT_L
#undef PG8_BAR
#undef PG8_SCHED
}
}

template <class F> struct EpiWrap {
  static constexpr bool PERM = false, AFTER_DRAIN = false;
  F f;
  DI void operator()(const f32x4 (&acc)[2][2][4][2], const pg8::Unit& u, int wr, int wc, int fr, int fq) const {
#pragma unroll
    for (int ai = 0; ai < 2; ++ai)
#pragma unroll
      for (int m = 0; m < 4; ++m) {
        const int row = u.pm * 256 + ai * 128 + wr * 64 + m * 16 + fr;
#pragma unroll
        for (int bj = 0; bj < 2; ++bj)
#pragma unroll
          for (int n = 0; n < 2; ++n) f(u.pn * 256 + bj * 128 + wc * 32 + n * 16 + 4 * fq, row, acc[ai][bj][m][n]);
      }
  }
};
template <class F>
DI void run_gemm_on(PG8_LAS unsigned char* lds, const bf16_t* A, const bf16_t* Bt, int M, int N, int K, const F& f, const int tid, int G, int c) {
  pg8::Gemm g; g.A = A; g.Bt = Bt; g.M = M; g.N = N; g.K = K;
  pg8::StaticOrder S; S.init(M, N, G, c);
  EpiWrap<F> E{f};
  pg8::gemm_phase<EpiWrap<F>, pg8::StaticOrder, false>(lds, g, S, E, nullptr, tid);
  __syncthreads();
}
template <class F>
DI void run_gemm(PG8_LAS unsigned char* lds, const bf16_t* A, const bf16_t* Bt, int M, int N, int K, const F& f, const int tid) {
  pg8::Gemm g; g.A = A; g.Bt = Bt; g.M = M; g.N = N; g.K = K;
  pg8::StaticOrder S; S.init(M, N, (int)gridDim.x, (int)blockIdx.x);
  EpiWrap<F> E{f};
  pg8::gemm_phase<EpiWrap<F>, pg8::StaticOrder, false>(lds, g, S, E, nullptr, tid);
  __syncthreads();
}

struct InProjEpi {
  unsigned char* ws;
  DI void operator()(int m, int n, const f32x4& v) const {
    if (m < 3072) {
      const int blk = m >> 8, c = m & 255;
      if (blk == 8) {
        bf16_t* cvt = (bf16_t*)(ws + OFF_CVT);
        const int seq = n >> 13, l = n & 8191;
        bf16_t* d = cvt + ((size_t)(seq * 256 + c)) * 8192 + l;
#pragma unroll
        for (int e = 0; e < 4; ++e) d[(size_t)e * 8192] = f2bf(v[e]);
      } else {
        bf16_t* d;
        if (blk >= 2 && blk <= 4) d = (bf16_t*)(ws + OFF_BQKV) + (size_t)n * 768 + (blk - 2) * 256 + c;
        else if (blk == 0 || blk == 5 || blk == 6 || blk == 10) d = (bf16_t*)(ws + OFF_MIX) + (size_t)n * 1024 + (blk == 0 ? 0 : blk == 5 ? 256 : blk == 6 ? 512 : 768) + c;
        else {
          size_t off = blk == 1 ? OFF_AZ : blk == 7 ? OFF_CK : blk == 9 ? OFF_CZ : OFF_DZ;
          d = (bf16_t*)(ws + off) + (size_t)n * 256 + c;
        }
        uint2 o; o.x = pack2(v[0], v[1]); o.y = pack2(v[2], v[3]); *(uint2*)d = o;
      }
    } else if (m < 3088) {
      float* g = (float*)(ws + OFF_GATES) + (size_t)n * 16 + (m - 3072);
      *(float4*)g = make_float4(v[0], v[1], v[2], v[3]);
    }
  }
};
struct MemKvEpi {
  unsigned char* ws; int l;
  DI void operator()(int m, int n, const f32x4& v) const {
    const int seq = n >> 8, key = n & 255;
    if (m < 256) {
      const int head = m >> 6, dim = m & 63;
      bf16_t* d = (bf16_t*)(ws + OFF_KMEM) + ((size_t)((l * 6 + seq) * 4 + head) * 256 + key) * 64 + dim;
      uint2 o; o.x = pack2(v[0], v[1]); o.y = pack2(v[2], v[3]); *(uint2*)d = o;
    } else {
      const int c = m - 256, head = c >> 6, dim = c & 63;
      bf16_t* d = (bf16_t*)(ws + OFF_VMEMT) + ((size_t)((l * 6 + seq) * 4 + head) * 64 + dim) * 256 + key;
#pragma unroll
      for (int e = 0; e < 4; ++e) d[e * 256] = f2bf(v[e]);
    }
  }
};
struct FnetEpi {
  unsigned char* ws;
  DI void operator()(int m, int n, const f32x4& v) const {
    const uint2 z = *(const uint2*)((const bf16_t*)(ws + OFF_AZ) + (size_t)n * 256 + m);
    uint2 o; o.x = pack2(v[0] * silu(bflo(z.x)), v[1] * silu(bfhi(z.x))); o.y = pack2(v[2] * silu(bflo(z.y)), v[3] * silu(bfhi(z.y)));
    *(uint2*)((bf16_t*)(ws + OFF_MIX) + (size_t)n * 1024 + m) = o;
  }
};
struct OutEpi {
  bf16_t* dst;
  DI void operator()(int m, int n, const f32x4& v) const { uint2 o; o.x = pack2(v[0], v[1]); o.y = pack2(v[2], v[3]); *(uint2*)(dst + (size_t)n * 1024 + m) = o; }
};

DI int fft_pos(int k) {
  return ((k & 1) << 12) | (((k >> 1) & 3) << 10) | (((k >> 3) & 3) << 8) | (((k >> 5) & 3) << 6) | (((k >> 7) & 3) << 4) | (((k >> 9) & 3) << 2) | ((k >> 11) & 3);
}
DI void fft_task(const Params& p, int task, float2* z, const int tid) {
  const int seq = task >> 7, cp = task & 127;
  const unsigned* au = (const unsigned*)(p.ws + OFF_MIX) + (size_t)seq * 8192 * 512 + cp;
  const float2* tw = (const float2*)(p.ws + OFF_TW);
  for (int i = tid; i < 8192; i += NT) { const unsigned u = au[(size_t)i * 512]; z[i] = make_float2(bflo(u), bfhi(u)); }
  __syncthreads();
  for (int b = tid; b < 4096; b += NT) {
    const float2 a = z[b], c = z[b + 4096], w = tw[b];
    z[b] = make_float2(a.x + c.x, a.y + c.y);
    const float dx = a.x - c.x, dy = a.y - c.y;
    z[b + 4096] = make_float2(dx * w.x - dy * w.y, dx * w.y + dy * w.x);
  }
  __syncthreads();
#pragma unroll 1
  for (int s4 = 0; s4 < 6; ++s4) {
    const int lq = 10 - 2 * s4, q = 1 << lq;
    for (int b = tid; b < 2048; b += NT) {
      const int j = b & (q - 1), i0 = ((b >> lq) << (lq + 2)) + j;
      const float2 a0 = z[i0], a1 = z[i0 + q], a2 = z[i0 + 2 * q], a3 = z[i0 + 3 * q];
      const float2 w1 = tw[j << (1 + 2 * s4)];
      const float2 w2 = make_float2(w1.x * w1.x - w1.y * w1.y, 2.f * w1.x * w1.y);
      const float2 w3 = make_float2(w2.x * w1.x - w2.y * w1.y, w2.x * w1.y + w2.y * w1.x);
      const float t0x = a0.x + a2.x, t0y = a0.y + a2.y, t1x = a0.x - a2.x, t1y = a0.y - a2.y;
      const float t2x = a1.x + a3.x, t2y = a1.y + a3.y, t3x = a1.y - a3.y, t3y = -(a1.x - a3.x);
      z[i0] = make_float2(t0x + t2x, t0y + t2y);
      const float y1x = t1x + t3x, y1y = t1y + t3y, y2x = t0x - t2x, y2y = t0y - t2y, y3x = t1x - t3x, y3y = t1y - t3y;
      z[i0 + q] = make_float2(y1x * w1.x - y1y * w1.y, y1x * w1.y + y1y * w1.x);
      z[i0 + 2 * q] = make_float2(y2x * w2.x - y2y * w2.y, y2x * w2.y + y2y * w2.x);
      z[i0 + 3 * q] = make_float2(y3x * w3.x - y3y * w3.y, y3x * w3.y + y3y * w3.x);
    }
    __syncthreads();
  }
  unsigned* H = (unsigned*)(p.ws + OFF_H) + (size_t)seq * 8192 * 256;
  for (int k = tid; k < 8192; k += NT) {
    const float2 zk = z[fft_pos(k)], zn = z[fft_pos((8192 - k) & 8191)];
    H[(size_t)k * 256 + cp] = pack2(0.5f * (zk.x + zn.x), 0.5f * (zk.y + zn.y));
    H[(size_t)k * 256 + 128 + cp] = pack2(0.5f * (zk.y - zn.y), -0.5f * (zk.x - zn.x));
  }
  __syncthreads();
}

template <bool NA>
DI void attn_core(const Params& p, int layer, int h, int tok0, int r, int c0, int rs, int wsx, const bf16_t* sK, const bf16_t* sVT, const float* sBias, int kb, int pitch, int vstride, int lane) {
  const int fr = lane & 15, fq = lane >> 4;
  bf16_t* Q = (bf16_t*)(p.ws + OFF_MIX) + (NA ? 512 : 768);
  const bf16_t* Z = (const bf16_t*)(p.ws + (NA ? OFF_CZ : OFF_DZ));
  const bf16_t* qp = Q + (size_t)(tok0 + fr) * 1024 + h * 64 + fq * 8;
  bf16x8 qf[2]; qf[0] = ld8(qp); qf[1] = ld8(qp + 32);
  f32x4 s[16];
#pragma unroll
  for (int kt = 0; kt < 16; ++kt) {
    const bf16_t* kp = sK + (kb + (kt >> 1) * pitch + (kt & 1) * 16 + fr) * 72 + fq * 8;
    f32x4 a = (f32x4){0.f, 0.f, 0.f, 0.f};
    a = MFMA16(ld8(kp), qf[0], a);
    a = MFMA16(ld8(kp + 32), qf[1], a);
    s[kt] = a;
  }
  float mx = -1e30f;
  if (NA) {
    const int c = c0 + fr, cs = min(max(c - 8, 0), 48);
#pragma unroll
    for (int kt = 0; kt < 16; ++kt) {
      const int kr = rs + (kt >> 1);
      const float* rb = sBias + (kr - r + 7) * 31;
#pragma unroll
      for (int e = 0; e < 4; ++e) {
        const int kc = wsx + (kt & 1) * 16 + 4 * fq + e;
        const bool valid = kc >= cs && kc < cs + 16;
        const float bias = rb[min(max(kc - c + 15, 0), 30)];
        const float v = valid ? s[kt][e] * 0.125f + bias : -1e30f;
        s[kt][e] = v; mx = fmaxf(mx, v);
      }
    }
  } else {
#pragma unroll
    for (int kt = 0; kt < 16; ++kt)
#pragma unroll
      for (int e = 0; e < 4; ++e) { const float v = s[kt][e] * 0.125f; s[kt][e] = v; mx = fmaxf(mx, v); }
  }
  mx = fmaxf(mx, __shfl_xor(mx, 16, 64)); mx = fmaxf(mx, __shfl_xor(mx, 32, 64));
  float sum = 0.f;
#pragma unroll
  for (int kt = 0; kt < 16; ++kt)
#pragma unroll
    for (int e = 0; e < 4; ++e) { const float pv = __expf(s[kt][e] - mx); s[kt][e] = pv; sum += pv; }
  sum += __shfl_xor(sum, 16, 64); sum += __shfl_xor(sum, 32, 64);
  const float inv = 1.f / sum;
  f32x4 o[4];
#pragma unroll
  for (int mt = 0; mt < 4; ++mt) o[mt] = (f32x4){0.f, 0.f, 0.f, 0.f};
#pragma unroll
  for (int u = 0; u < 8; ++u) {
    const bf16x8 pb = pack8(s[2 * u], s[2 * u + 1]);
#pragma unroll
    for (int mt = 0; mt < 4; ++mt) {
      const bf16_t* vp = sVT + (16 * mt + fr) * vstride + kb + u * pitch + 4 * fq;
      o[mt] = MFMA16(ld4x2(vp, vp + 16), pb, o[mt]);
    }
  }
  const size_t orow = (size_t)(tok0 + fr) * 256 + h * 64 + 4 * fq, qrow = (size_t)(tok0 + fr) * 1024 + h * 64 + 4 * fq;
#pragma unroll
  for (int mt = 0; mt < 4; ++mt) {
    const uint2 z = *(const uint2*)(Z + orow + 16 * mt);
    uint2 w; w.x = pack2(o[mt][0] * inv * silu(bflo(z.x)), o[mt][1] * inv * silu(bfhi(z.x)));
    w.y = pack2(o[mt][2] * inv * silu(bflo(z.y)), o[mt][3] * inv * silu(bfhi(z.y)));
    *(uint2*)(Q + qrow + 16 * mt) = w;
  }
}
DI void na_block(const Params& p, int layer, int bt, char* smem, const int tid) {
  const int half = bt & 1, rg = (bt >> 1) & 31, h = (bt >> 6) & 3, seq = bt >> 8;
  const int r0 = rg * 4, rsmin = min(max(r0 - 4, 0), 120), nrows = min(11, 128 - rsmin), colbase = half ? 24 : 0;
  bf16_t* sK = (bf16_t*)smem; bf16_t* sVT = sK + 440 * 72; float* sBias = (float*)(sVT + 64 * 456);
  if (tid < 465) sBias[tid] = p.rpb[(size_t)(layer * 4 + h) * 465 + tid];
  const bf16_t* CK = (const bf16_t*)(p.ws + OFF_CK) + (size_t)(seq * 8192 + rsmin * 64 + colbase) * 256 + h * 64;
  const bf16_t* CVT = (const bf16_t*)(p.ws + OFF_CVT) + (size_t)(seq * 4 + h) * 64 * 8192 + rsmin * 64 + colbase;
  {
    const int nk = nrows * 40 * 8, per_dim = nrows * 5, nv = 64 * per_dim;
    uint4 rk[7], rv[7]; int dk[7], dv[7];
#pragma unroll
    for (int i = 0; i < 7; ++i) {
      const int idx = tid + NT * i;
      const int key = idx >> 3, ch = idx & 7, ri = key / 40, cj = key - ri * 40;
      dk[i] = idx < nk ? key * 72 + ch * 8 : -1;
      rk[i] = idx < nk ? *(const uint4*)(CK + (size_t)(ri * 64 + cj) * 256 + ch * 8) : make_uint4(0, 0, 0, 0);
      const int dim = idx / per_dim, rem = idx - dim * per_dim, r2 = rem / 5, c5 = rem - r2 * 5;
      dv[i] = idx < nv ? dim * 456 + r2 * 40 + c5 * 8 : -1;
      rv[i] = idx < nv ? *(const uint4*)(CVT + (size_t)dim * 8192 + r2 * 64 + c5 * 8) : make_uint4(0, 0, 0, 0);
    }
#pragma unroll
    for (int i = 0; i < 7; ++i) { if (dk[i] >= 0) *(uint4*)(sK + dk[i]) = rk[i]; if (dv[i] >= 0) *(uint4*)(sVT + dv[i]) = rv[i]; }
  }
  __syncthreads();
  {
    const int wave = tid >> 6, lane = tid & 63;
    const int r = r0 + (wave >> 1), c0 = 32 * half + 16 * (wave & 1);
    const int rs = min(max(r - 4, 0), 120), wsx = min(max(c0 - 8, 0), 32);
    attn_core<true>(p, layer, h, seq * 8192 + r * 64 + c0, r, c0, rs, wsx, sK, sVT, sBias, (rs - rsmin) * 40 + (wsx - colbase), 40, 456, lane);
  }
  __syncthreads();
}
DI void mem_block(const Params& p, int layer, int bt, char* smem, const int tid) {
  const int g = bt & 31, h = (bt >> 5) & 3, seq = bt >> 7;
  bf16_t* sK = (bf16_t*)smem; bf16_t* sVT = sK + 256 * 72;
  const bf16_t* Kg = (const bf16_t*)(p.ws + OFF_KMEM) + (size_t)((layer * 6 + seq) * 4 + h) * 256 * 64;
  const bf16_t* Vg = (const bf16_t*)(p.ws + OFF_VMEMT) + (size_t)((layer * 6 + seq) * 4 + h) * 64 * 256;
  {
    uint4 rk[4], rv[4];
#pragma unroll
    for (int i = 0; i < 4; ++i) { const int idx = tid + NT * i; rk[i] = *(const uint4*)(Kg + (size_t)idx * 8); rv[i] = *(const uint4*)(Vg + (size_t)idx * 8); }
#pragma unroll
    for (int i = 0; i < 4; ++i) { const int idx = tid + NT * i; *(uint4*)(sK + (idx >> 3) * 72 + (idx & 7) * 8) = rk[i]; *(uint4*)(sVT + (idx >> 5) * 264 + (idx & 31) * 8) = rv[i]; }
  }
  __syncthreads();
  {
    const int wave = tid >> 6, lane = tid & 63;
#pragma unroll 1
    for (int i = 0; i < 2; ++i) { int kb0 = 0; asm volatile("" : "+v"(kb0));
      attn_core<false>(p, layer, h, seq * 8192 + (g * 16 + wave * 2 + i) * 16, 0, 0, 0, 0, sK, sVT, nullptr, kb0, 32, 264, lane); }
  }
  __syncthreads();
}

DI void gdn_prep_tok8(const Params& p, int layer, int task, int lane) {
  const int tok0 = task * 8, seq = tok0 >> 13, l0 = tok0 & 8191;
  const bf16_t* X = (const bf16_t*)(p.ws + OFF_BQKV);
  const float* cw = p.conv_w + (size_t)layer * 5 * 768;
  unsigned kp[4][4];
#pragma unroll
  for (int i = 0; i < 3; ++i) {
    const int c = i * 256 + lane * 4;
    uint2 x[12];
#pragma unroll
    for (int jj = 0; jj < 12; ++jj) {
      const int ll = l0 + jj - 2;
      x[jj] = (ll >= 0 && ll < 8192) ? *(const uint2*)(X + (size_t)(tok0 + jj - 2) * 768 + c) : make_uint2(0u, 0u);
    }
    float4 w[5];
#pragma unroll
    for (int j = 0; j < 5; ++j) w[j] = *(const float4*)(cw + j * 768 + c);
    bf16_t* dst = (bf16_t*)(p.ws + (i == 0 ? OFF_QN : i == 1 ? OFF_KN : OFF_VN)) + (size_t)tok0 * 256 + lane * 4;
#pragma unroll
    for (int t = 0; t < 8; ++t) {
      float a0 = 0.f, a1 = 0.f, a2 = 0.f, a3 = 0.f;
#pragma unroll
      for (int j = 0; j < 5; ++j) { const uint2 xv = x[t + j]; a0 += w[j].x * bflo(xv.x); a1 += w[j].y * bfhi(xv.x); a2 += w[j].z * bflo(xv.y); a3 += w[j].w * bfhi(xv.y); }
      a0 = silu(a0); a1 = silu(a1); a2 = silu(a2); a3 = silu(a3);
      if (i < 2) {
        float ss = a0 * a0 + a1 * a1 + a2 * a2 + a3 * a3;
        ss += __shfl_xor(ss, 1, 64); ss += __shfl_xor(ss, 2, 64); ss += __shfl_xor(ss, 4, 64); ss += __shfl_xor(ss, 8, 64);
        const float rs = rsqrtf(ss + 1e-6f) * (i == 0 ? 0.125f : 1.f);
        a0 *= rs; a1 *= rs; a2 *= rs; a3 *= rs;
      }
      uint2 o; o.x = pack2(a0, a1); o.y = pack2(a2, a3);
      *(uint2*)(dst + (size_t)t * 256) = o;
      if (i == 1) {
        if (t & 1) { kp[0][t >> 1] |= (unsigned)f2bf(a0) << 16; kp[1][t >> 1] |= (unsigned)f2bf(a1) << 16; kp[2][t >> 1] |= (unsigned)f2bf(a2) << 16; kp[3][t >> 1] |= (unsigned)f2bf(a3) << 16; }
        else { kp[0][t >> 1] = f2bf(a0); kp[1][t >> 1] = f2bf(a1); kp[2][t >> 1] = f2bf(a2); kp[3][t >> 1] = f2bf(a3); }
      }
    }
  }
  bf16_t* kT = (bf16_t*)(p.ws + OFF_KT) + ((size_t)seq * 256 + lane * 4) * 8192 + l0;
#pragma unroll
  for (int e = 0; e < 4; ++e) *(uint4*)(kT + (size_t)e * 8192) = make_uint4(kp[e][0], kp[e][1], kp[e][2], kp[e][3]);
#pragma unroll
  for (int i2 = 0; i2 < 2; ++i2) {
    const int idx = lane + 64 * i2, gi = idx & 15;
    float* g = (float*)(p.ws + OFF_GATES) + (size_t)tok0 * 16 + idx;
    const float x = *g;
    float r;
    if (gi < 8) {
      const float y = x + p.dt_bias[layer * 8 + gi];
      const float sp = fmaxf(y, 0.f) + __logf(1.f + __expf(-fabsf(y)));
      r = -__expf(p.a_log[layer * 8 + gi]) * sp;
    } else r = 1.f / (1.f + __expf(-x));
    *g = r;
  }
}

DI void chunk_task(const Params& p, int bt, char* smem, const int tid) {
  const int n = bt & 127, head = (bt >> 7) & 3, seq = bt >> 9;
  const int lane = tid & 63, wave = tid >> 6, fr = lane & 15, fq = lane >> 4;
  float* sL = (float*)smem;
  float* sg = (float*)(smem + 32768);
  float* sbeta = sg + 128; float* sG = sbeta + 128;
  const float* gb = (const float*)(p.ws + OFF_GATES);
  const bf16_t* qn = (const bf16_t*)(p.ws + OFF_QN); const bf16_t* kn = (const bf16_t*)(p.ws + OFF_KN); const bf16_t* vn = (const bf16_t*)(p.ws + OFF_VN);
  const int tokbase = seq * 8192;
  if (tid < 128) {
    const int d = tid >> 6, r = tid & 63; const int pos = d ? 8191 - 64 * n - r : 64 * n + r;
    sg[tid] = gb[(size_t)(tokbase + pos) * 16 + d * 4 + head]; sbeta[tid] = gb[(size_t)(tokbase + pos) * 16 + 8 + d * 4 + head];
  }
  __syncthreads();
  if (tid < 128) {
    float a = sg[tid];
#pragma unroll
    for (int off = 1; off < 64; off <<= 1) { const float t = __shfl_up(a, off, 64); if (lane >= off) a += t; }
    sG[tid] = a;
  }
  __syncthreads();
  {
    const int d = wave >> 1;
    const int ct = ((seq * 4 + head) * 2 + d) * 128 + n;
    if ((wave & 1) == 0) {
      float* cv = (float*)(p.ws + OFF_CVEC) + (size_t)ct * 256;
      const float G = sG[d * 64 + lane], Gl = sG[d * 64 + 63];
      cv[lane] = __expf(G); cv[64 + lane] = __expf(Gl - G); if (lane == 0) cv[128] = __expf(Gl);
    }
    bf16_t* chqk = (bf16_t*)(p.ws + OFF_CHQK) + (size_t)ct * 4096;
    const int hoff = head * 64 + fq * 8;
    bf16x8 kB[4][2];
#pragma unroll
    for (int nt = 0; nt < 4; ++nt) {
      const int rB = 16 * nt + fr; const int posB = d ? 8191 - 64 * n - rB : 64 * n + rB;
      const size_t ob = (size_t)(tokbase + posB) * 256 + hoff;
      kB[nt][0] = ld8(kn + ob); kB[nt][1] = ld8(kn + ob + 32);
    }
    bf16x8 kA[2][2], qA[2][2];
#pragma unroll
    for (int si = 0; si < 2; ++si) {
      const int rA = 16 * (2 * (wave & 1) + si) + fr; const int posA = d ? 8191 - 64 * n - rA : 64 * n + rA;
      const size_t oa = (size_t)(tokbase + posA) * 256 + hoff;
      kA[si][0] = ld8(kn + oa); kA[si][1] = ld8(kn + oa + 32); qA[si][0] = ld8(qn + oa); qA[si][1] = ld8(qn + oa + 32);
    }
#pragma unroll
    for (int si = 0; si < 2; ++si) {
      const int strip = 2 * (wave & 1) + si;
#pragma unroll
      for (int nt = 0; nt < 4; ++nt) {
        f32x4 kk = (f32x4){0.f, 0.f, 0.f, 0.f}, qk = (f32x4){0.f, 0.f, 0.f, 0.f};
        kk = MFMA16(kA[si][0], kB[nt][0], kk); kk = MFMA16(kA[si][1], kB[nt][1], kk);
        qk = MFMA16(qA[si][0], kB[nt][0], qk); qk = MFMA16(qA[si][1], kB[nt][1], qk);
        const int sc = 16 * nt + fr;
#pragma unroll
        for (int e = 0; e < 4; ++e) {
          const int r = 16 * strip + 4 * fq + e;
          const float dec = sc <= r ? __expf(sG[d * 64 + r] - sG[d * 64 + sc]) : 0.f;
          sL[d * 4096 + r * 64 + sc] = sc < r ? sbeta[d * 64 + r] * kk[e] * dec : 0.f;
          chqk[r * 64 + sc] = f2bf(qk[e] * dec);
        }
      }
    }
  }
  __syncthreads();
  {
    const int wvu = __builtin_amdgcn_readfirstlane(wave);
    const int d = wvu >> 1, half = wvu & 1;
    const int ct = ((seq * 4 + head) * 2 + d) * 128 + n;
    const bf16_t* src = (half ? kn : vn) + (size_t)(tokbase + (d ? 8191 - 64 * n : 64 * n)) * 256 + head * 64 + lane;
    const int rstep = d ? -256 : 256;
    float sol[64];
#pragma unroll
    for (int r = 0; r < 64; ++r) sol[r] = bf2f(src[r * rstep]);
#pragma unroll
    for (int r4 = 0; r4 < 16; ++r4) {
      const float4 b4 = *(const float4*)(sbeta + d * 64 + 4 * r4); const float4 g4 = *(const float4*)(sG + d * 64 + 4 * r4);
      sol[4 * r4 + 0] *= half ? b4.x * __expf(g4.x) : b4.x; sol[4 * r4 + 1] *= half ? b4.y * __expf(g4.y) : b4.y;
      sol[4 * r4 + 2] *= half ? b4.z * __expf(g4.z) : b4.z; sol[4 * r4 + 3] *= half ? b4.w * __expf(g4.w) : b4.w;
    }
    const float* Ld = sL + d * 4096;
#pragma unroll
    for (int b = 0; b < 4; ++b) {
#pragma unroll
      for (int j4 = 0; j4 < 4 * b; ++j4) {
        float4 lv[16];
#pragma unroll
        for (int q = 0; q < 16; ++q) lv[q] = *(const float4*)(Ld + (16 * b + q) * 64 + 4 * j4);
#pragma unroll
        for (int q = 0; q < 16; ++q) {
          float a = sol[16 * b + q];
          a -= lv[q].x * sol[4 * j4 + 0]; a -= lv[q].y * sol[4 * j4 + 1]; a -= lv[q].z * sol[4 * j4 + 2]; a -= lv[q].w * sol[4 * j4 + 3];
          sol[16 * b + q] = a;
        }
      }
#pragma unroll
      for (int g4 = 0; g4 < 4; ++g4) {
        float4 lv[16];
#pragma unroll
        for (int q = 4 * g4 + 1; q < 16; ++q) lv[q] = *(const float4*)(Ld + (16 * b + q) * 64 + 16 * b + 4 * g4);
        sol[16 * b + 4 * g4 + 1] -= lv[4 * g4 + 1].x * sol[16 * b + 4 * g4];
        sol[16 * b + 4 * g4 + 2] -= lv[4 * g4 + 2].x * sol[16 * b + 4 * g4] + lv[4 * g4 + 2].y * sol[16 * b + 4 * g4 + 1];
        sol[16 * b + 4 * g4 + 3] -= lv[4 * g4 + 3].x * sol[16 * b + 4 * g4] + lv[4 * g4 + 3].y * sol[16 * b + 4 * g4 + 1] + lv[4 * g4 + 3].z * sol[16 * b + 4 * g4 + 2];
#pragma unroll
        for (int q = 4 * g4 + 4; q < 16; ++q) {
          float a = sol[16 * b + q];
          a -= lv[q].x * sol[16 * b + 4 * g4 + 0]; a -= lv[q].y * sol[16 * b + 4 * g4 + 1]; a -= lv[q].z * sol[16 * b + 4 * g4 + 2]; a -= lv[q].w * sol[16 * b + 4 * g4 + 3];
          sol[16 * b + q] = a;
        }
      }
    }
    if (!half) {
      bf16_t* chu = (bf16_t*)(p.ws + OFF_CHU) + (size_t)ct * 4096 + lane * 64;
#pragma unroll
      for (int r8 = 0; r8 < 8; ++r8) {
        uint4 o; o.x = pack2(sol[r8 * 8 + 0], sol[r8 * 8 + 1]); o.y = pack2(sol[r8 * 8 + 2], sol[r8 * 8 + 3]);
        o.z = pack2(sol[r8 * 8 + 4], sol[r8 * 8 + 5]); o.w = pack2(sol[r8 * 8 + 6], sol[r8 * 8 + 7]);
        *(uint4*)(chu + r8 * 8) = o;
      }
    } else {
      bf16_t* chw = (bf16_t*)(p.ws + OFF_CHW) + (size_t)ct * 4096 + lane;
#pragma unroll
      for (int r = 0; r < 64; ++r) chw[r * 64] = f2bf(sol[r]);
    }
  }
  __syncthreads();
}

DI uint4 rev8(uint4 v) {
  uint4 r;
  r.x = (v.w >> 16) | (v.w << 16); r.y = (v.z >> 16) | (v.z << 16); r.z = (v.y >> 16) | (v.y << 16); r.w = (v.x >> 16) | (v.x << 16);
  return r;
}
DI void scan_task(const Params& p, int task, char* smem, const int tid) {
  const int d = task & 1, head = (task >> 1) & 3, seq = task >> 3;
  const bool loader = tid >= 256;
  const int lt = tid & 255, lane = tid & 63, wave = lt >> 6, fr = lane & 15, fq = lane >> 4;
  const int row0 = lt >> 3, c8 = (lt & 7) * 8, rc8 = (7 - (lt & 7)) * 8;
  constexpr int BUFB = 49152;
  const int ctb = ((seq * 4 + head) * 2 + d) * 128;
  const bf16_t* chw = (const bf16_t*)(p.ws + OFF_CHW); const bf16_t* chu = (const bf16_t*)(p.ws + OFF_CHU); const bf16_t* chqk = (const bf16_t*)(p.ws + OFF_CHQK);
  const float* cvec = (const float*)(p.ws + OFF_CVEC);
  const bf16_t* qn = (const bf16_t*)(p.ws + OFF_QN) + (size_t)seq * 8192 * 256 + head * 64;
  const bf16_t* kT = (const bf16_t*)(p.ws + OFF_KT) + (size_t)(seq * 256 + head * 64) * 8192;
  bf16_t* O = (bf16_t*)(p.ws + (d ? OFF_OB : OFF_OF)) + (size_t)seq * 8192 * 256 + head * 64 + 32 * (wave & 1) + fr;
#define SCAN_STAGE(n_, buf_) do { \
    const size_t cb = (size_t)(ctb + (n_)) * 4096 + row0 * 64 + c8; \
    const uint4 rw0 = *(const uint4*)(chw + cb), rw1 = *(const uint4*)(chw + cb + 2048); \
    const uint4 rqk0 = *(const uint4*)(chqk + cb), rqk1 = *(const uint4*)(chqk + cb + 2048); \
    const uint4 ru0 = *(const uint4*)(chu + cb), ru1 = *(const uint4*)(chu + cb + 2048); \
    const int pos0 = d ? 8191 - 64 * (n_) - row0 : 64 * (n_) + row0, pos1 = d ? pos0 - 32 : pos0 + 32; \
    const uint4 rq0 = *(const uint4*)(qn + (size_t)pos0 * 256 + c8), rq1 = *(const uint4*)(qn + (size_t)pos1 * 256 + c8); \
    const int lbase = d ? 8191 - 64 * (n_) - 63 : 64 * (n_); \
    const uint4 rkt0 = *(const uint4*)(kT + (size_t)row0 * 8192 + lbase + c8), rkt1 = *(const uint4*)(kT + (size_t)(row0 + 32) * 8192 + lbase + c8); \
    const float rv = cvec[(size_t)(ctb + (n_)) * 256 + (lt < 129 ? lt : 128)]; \
    bf16_t* sW_ = (bf16_t*)(smem + (buf_) * BUFB); bf16_t* sQK_ = sW_ + 64 * 72; bf16_t* sQ_ = sQK_ + 64 * 72; bf16_t* sKT_ = sQ_ + 64 * 72; bf16_t* sU_ = sKT_ + 64 * 72; \
    float* sV_ = (float*)(smem + (buf_) * BUFB + 5 * 64 * 72 * 2); \
    *(uint4*)(sW_ + row0 * 72 + c8) = rw0; *(uint4*)(sW_ + (row0 + 32) * 72 + c8) = rw1; \
    *(uint4*)(sQK_ + row0 * 72 + c8) = rqk0; *(uint4*)(sQK_ + (row0 + 32) * 72 + c8) = rqk1; \
    *(uint4*)(sU_ + row0 * 72 + c8) = ru0; *(uint4*)(sU_ + (row0 + 32) * 72 + c8) = ru1; \
    *(uint4*)(sQ_ + row0 * 72 + c8) = rq0; *(uint4*)(sQ_ + (row0 + 32) * 72 + c8) = rq1; \
    if (d) { *(uint4*)(sKT_ + row0 * 72 + rc8) = rev8(rkt0); *(uint4*)(sKT_ + (row0 + 32) * 72 + rc8) = rev8(rkt1); } \
    else { *(uint4*)(sKT_ + row0 * 72 + c8) = rkt0; *(uint4*)(sKT_ + (row0 + 32) * 72 + c8) = rkt1; } \
    if (lt < 129) sV_[lt] = rv; } while (0)
#define SCAN_BAR() do { asm volatile("s_waitcnt lgkmcnt(0)" ::: "memory"); __builtin_amdgcn_s_barrier(); asm volatile("" ::: "memory"); } while (0)
  f32x4 S[4][2];
#pragma unroll
  for (int mt = 0; mt < 4; ++mt) { S[mt][0] = (f32x4){0.f, 0.f, 0.f, 0.f}; S[mt][1] = (f32x4){0.f, 0.f, 0.f, 0.f}; }
#define SCAN_LDF(f_, base_, h2_) do { _Pragma("unroll") for (int m2 = 0; m2 < 2; ++m2) { const bf16_t* p_ = (base_) + (16 * (2 * (h2_) + m2) + fr) * 72 + 4 * fq; \
    f_[m2][0] = ld4x2(p_, p_ + 16); f_[m2][1] = ld4x2(p_ + 32, p_ + 48); } } while (0)
#define SCAN_SB() __builtin_amdgcn_sched_barrier(0)
#define SCAN_COMPUTE(n_, buf_) do { \
    const bf16_t* sW = (const bf16_t*)(smem + (buf_) * BUFB); const bf16_t* sQK = sW + 64 * 72; const bf16_t* sQ = sQK + 64 * 72; const bf16_t* sKT = sQ + 64 * 72; const bf16_t* sU = sKT + 64 * 72; \
    const float* sV = (const float*)(smem + (buf_) * BUFB + 5 * 64 * 72 * 2); \
    bf16x8 fA[2][2], fB[2][2]; \
    SCAN_LDF(fA, sW, 0); SCAN_SB(); \
    bf16x8 Sb[2][2]; \
    _Pragma("unroll") for (int nt = 0; nt < 2; ++nt) { Sb[0][nt] = pack8(S[0][nt], S[1][nt]); Sb[1][nt] = pack8(S[2][nt], S[3][nt]); } \
    f32x4 v[4][2], o[4][2]; \
      \
    SCAN_LDF(fB, sW, 1); \
    _Pragma("unroll") for (int m2 = 0; m2 < 2; ++m2) _Pragma("unroll") for (int nt = 0; nt < 2; ++nt) { \
      v[m2][nt] = MFMA16(fA[m2][0], Sb[0][nt], ((f32x4){0.f, 0.f, 0.f, 0.f})); v[m2][nt] = MFMA16(fA[m2][1], Sb[1][nt], v[m2][nt]); } \
    SCAN_SB(); \
    SCAN_LDF(fA, sQ, 0); \
    _Pragma("unroll") for (int m2 = 0; m2 < 2; ++m2) _Pragma("unroll") for (int nt = 0; nt < 2; ++nt) { \
      v[2 + m2][nt] = MFMA16(fB[m2][0], Sb[0][nt], ((f32x4){0.f, 0.f, 0.f, 0.f})); v[2 + m2][nt] = MFMA16(fB[m2][1], Sb[1][nt], v[2 + m2][nt]); } \
    SCAN_SB(); \
    SCAN_LDF(fB, sQ, 1); \
    _Pragma("unroll") for (int m2 = 0; m2 < 2; ++m2) _Pragma("unroll") for (int nt = 0; nt < 2; ++nt) { \
      o[m2][nt] = MFMA16(fA[m2][0], Sb[0][nt], ((f32x4){0.f, 0.f, 0.f, 0.f})); o[m2][nt] = MFMA16(fA[m2][1], Sb[1][nt], o[m2][nt]); } \
    SCAN_SB(); \
    SCAN_LDF(fA, sKT, 0); \
    _Pragma("unroll") for (int m2 = 0; m2 < 2; ++m2) _Pragma("unroll") for (int nt = 0; nt < 2; ++nt) { \
      o[2 + m2][nt] = MFMA16(fB[m2][0], Sb[0][nt], ((f32x4){0.f, 0.f, 0.f, 0.f})); o[2 + m2][nt] = MFMA16(fB[m2][1], Sb[1][nt], o[2 + m2][nt]); } \
    SCAN_SB(); \
    bf16x8 Vb[2][2], Vkb[2][2]; \
    {   \
      _Pragma("unroll") for (int mt = 0; mt < 4; ++mt) { \
        const float4 eg = *(const float4*)(sV + 16 * mt + 4 * fq); \
        _Pragma("unroll") for (int nt = 0; nt < 2; ++nt) { \
          const uint2 u = *(const uint2*)(sU + (32 * wave + 16 * nt + fr) * 72 + 16 * mt + 4 * fq); \
          v[mt][nt][0] = bflo(u.x) - v[mt][nt][0]; v[mt][nt][1] = bfhi(u.x) - v[mt][nt][1]; v[mt][nt][2] = bflo(u.y) - v[mt][nt][2]; v[mt][nt][3] = bfhi(u.y) - v[mt][nt][3]; \
          o[mt][nt][0] *= eg.x; o[mt][nt][1] *= eg.y; o[mt][nt][2] *= eg.z; o[mt][nt][3] *= eg.w; } \
      } \
      _Pragma("unroll") for (int nt = 0; nt < 2; ++nt) { \
        Vb[0][nt] = pack8(v[0][nt], v[1][nt]); Vb[1][nt] = pack8(v[2][nt], v[3][nt]); } \
      _Pragma("unroll") for (int mt = 0; mt < 4; ++mt) { \
        const float4 ek = *(const float4*)(sV + 64 + 16 * mt + 4 * fq); \
        _Pragma("unroll") for (int nt = 0; nt < 2; ++nt) { v[mt][nt][0] *= ek.x; v[mt][nt][1] *= ek.y; v[mt][nt][2] *= ek.z; v[mt][nt][3] *= ek.w; } } \
      _Pragma("unroll") for (int nt = 0; nt < 2; ++nt) { \
        Vkb[0][nt] = pack8(v[0][nt], v[1][nt]); Vkb[1][nt] = pack8(v[2][nt], v[3][nt]); } \
    } \
    const float gl = sV[128]; \
    SCAN_SB(); \
    SCAN_LDF(fB, sKT, 1); \
    _Pragma("unroll") for (int m2 = 0; m2 < 2; ++m2) _Pragma("unroll") for (int nt = 0; nt < 2; ++nt) { \
      f32x4 a; a[0] = S[m2][nt][0] * gl; a[1] = S[m2][nt][1] * gl; a[2] = S[m2][nt][2] * gl; a[3] = S[m2][nt][3] * gl; \
      a = MFMA16(fA[m2][0], Vkb[0][nt], a); S[m2][nt] = MFMA16(fA[m2][1], Vkb[1][nt], a); } \
    SCAN_SB(); \
    SCAN_LDF(fA, sQK, 0); \
    _Pragma("unroll") for (int m2 = 0; m2 < 2; ++m2) _Pragma("unroll") for (int nt = 0; nt < 2; ++nt) { \
      f32x4 a; a[0] = S[2 + m2][nt][0] * gl; a[1] = S[2 + m2][nt][1] * gl; a[2] = S[2 + m2][nt][2] * gl; a[3] = S[2 + m2][nt][3] * gl; \
      a = MFMA16(fB[m2][0], Vkb[0][nt], a); S[2 + m2][nt] = MFMA16(fB[m2][1], Vkb[1][nt], a); } \
    SCAN_SB(); \
    SCAN_LDF(fB, sQK, 1); \
    _Pragma("unroll") for (int m2 = 0; m2 < 2; ++m2) _Pragma("unroll") for (int nt = 0; nt < 2; ++nt) { \
      o[m2][nt] = MFMA16(fA[m2][0], Vb[0][nt], o[m2][nt]); o[m2][nt] = MFMA16(fA[m2][1], Vb[1][nt], o[m2][nt]); } \
    SCAN_SB(); \
    _Pragma("unroll") for (int m2 = 0; m2 < 2; ++m2) _Pragma("unroll") for (int nt = 0; nt < 2; ++nt) { \
      o[2 + m2][nt] = MFMA16(fB[m2][0], Vb[0][nt], o[2 + m2][nt]); o[2 + m2][nt] = MFMA16(fB[m2][1], Vb[1][nt], o[2 + m2][nt]); } \
    _Pragma("unroll") for (int mt = 0; mt < 4; ++mt) _Pragma("unroll") for (int e = 0; e < 4; ++e) { \
      const int r_ = 16 * mt + 4 * fq + e; const int pos = d ? 8191 - 64 * (n_) - r_ : 64 * (n_) + r_; \
      O[(size_t)pos * 256] = f2bf(o[mt][0][e]); O[(size_t)pos * 256 + 16] = f2bf(o[mt][1][e]); \
    } } while (0)
  __syncthreads();
  if (loader) SCAN_STAGE(0, 0);
  SCAN_BAR();
#pragma unroll 1
  for (int n = 0; n < 128; ++n) {
    if (loader) { if (n + 1 < 128) SCAN_STAGE(n + 1, ((n + 1) & 1)); }
    else if (wave < 2) SCAN_COMPUTE(n, (n & 1));
    SCAN_BAR();
  }
  asm volatile("s_waitcnt vmcnt(0)" ::: "memory");
  __syncthreads();
#undef SCAN_STAGE
#undef SCAN_BAR
#undef SCAN_COMPUTE
#undef SCAN_LDF
#undef SCAN_SB
}

DI void gdn_finish_tok4(const Params& p, int layer, int tok0, int lane) {
  const float4 g = *(const float4*)(p.gdn_g + layer * 64 + (lane & 15) * 4);
  uint2 a[4], b[4], z[4];
#pragma unroll
  for (int t = 0; t < 4; ++t) {
    const size_t ro = (size_t)(tok0 + t) * 256 + lane * 4;
    a[t] = *(const uint2*)((const bf16_t*)(p.ws + OFF_OF) + ro); b[t] = *(const uint2*)((const bf16_t*)(p.ws + OFF_OB) + ro);
    z[t] = *(const uint2*)((const bf16_t*)(p.ws + OFF_MIX) + (size_t)(tok0 + t) * 1024 + 256 + lane * 4);
  }
#pragma unroll
  for (int t = 0; t < 4; ++t) {
    const float o0 = bflo(a[t].x) + bflo(b[t].x), o1 = bfhi(a[t].x) + bfhi(b[t].x), o2 = bflo(a[t].y) + bflo(b[t].y), o3 = bfhi(a[t].y) + bfhi(b[t].y);
    float ss = o0 * o0 + o1 * o1 + o2 * o2 + o3 * o3;
    ss += __shfl_xor(ss, 1, 64); ss += __shfl_xor(ss, 2, 64); ss += __shfl_xor(ss, 4, 64); ss += __shfl_xor(ss, 8, 64);
    const float rs = rsqrtf(ss * (1.f / 64.f) + 1e-6f);
    uint2 w; w.x = pack2(o0 * rs * g.x * silu(bflo(z[t].x)), o1 * rs * g.y * silu(bfhi(z[t].x)));
    w.y = pack2(o2 * rs * g.z * silu(bflo(z[t].y)), o3 * rs * g.w * silu(bfhi(z[t].y)));
    *(uint2*)((bf16_t*)(p.ws + OFF_MIX) + (size_t)(tok0 + t) * 1024 + 256 + lane * 4) = w;
  }
}

DI void post_token2(const Params& p, int layer, int tok0, int lane) {
  const float* pg = p.post_g + layer * 1024;
  uint2 ob[2][4]; float4 xr[2][4], g[4];
#pragma unroll
  for (int t = 0; t < 2; ++t) {
    const bf16_t* o = (const bf16_t*)(p.ws + OFF_OUTTMP) + (size_t)(tok0 + t) * 1024;
    const float* xp = layer == 0 ? xrow(p, tok0 + t) : p.out + (size_t)(tok0 + t) * 1024;
#pragma unroll
    for (int i = 0; i < 4; ++i) { ob[t][i] = *(const uint2*)(o + i * 256 + lane * 4); xr[t][i] = *(const float4*)(xp + i * 256 + lane * 4); }
  }
#pragma unroll
  for (int i = 0; i < 4; ++i) g[i] = *(const float4*)(pg + i * 256 + lane * 4);
#pragma unroll
  for (int t = 0; t < 2; ++t) {
    float4 v[4]; float ss = 0.f;
#pragma unroll
    for (int i = 0; i < 4; ++i) { const uint2 u = ob[t][i]; v[i] = make_float4(bflo(u.x), bfhi(u.x), bflo(u.y), bfhi(u.y));
      ss += v[i].x * v[i].x + v[i].y * v[i].y + v[i].z * v[i].z + v[i].w * v[i].w; }
    ss = wave_sum(ss);
    const float rs = rsqrtf(ss * (1.f / 1024.f) + 1e-6f);
    float ss2 = 0.f;
#pragma unroll
    for (int i = 0; i < 4; ++i) {
      const float4 x = xr[t][i];
      v[i].x = x.x + v[i].x * rs * g[i].x; v[i].y = x.y + v[i].y * rs * g[i].y; v[i].z = x.z + v[i].z * rs * g[i].z; v[i].w = x.w + v[i].w * rs * g[i].w;
      ss2 += v[i].x * v[i].x + v[i].y * v[i].y + v[i].z * v[i].z + v[i].w * v[i].w;
      *(float4*)(p.out + (size_t)(tok0 + t) * 1024 + i * 256 + lane * 4) = v[i];
    }
    if (layer == 0) {
      ss2 = wave_sum(ss2);
      const float rs2 = rsqrtf(ss2 * (1.f / 1024.f) + 1e-6f);
      bf16_t* dst = (bf16_t*)(p.ws + OFF_X) + (size_t)(tok0 + t) * 1024;
#pragma unroll
      for (int i = 0; i < 4; ++i) { uint2 w; w.x = pack2(v[i].x * rs2, v[i].y * rs2); w.y = pack2(v[i].z * rs2, v[i].w * rs2); *(uint2*)(dst + i * 256 + lane * 4) = w; }
    }
  }
}

#define XB_TMO      128
#define XB_XCNT(j)  (256  + 64 * (j))
#define XB_XSUB(j)  (1280 + 64 * (j))
#define XB_XGEN(j)  (2304 + 64 * (j))
#define XB_TOP      3328
#define XB_TOPGEN   3392
#define XCD_BAR_WORDS 3456
#define XB_SPIN_CAP (1u << 18)
#define XLAS __attribute__((address_space(3)))

__device__ __forceinline__ unsigned xb_ld(unsigned* p)              { return __hip_atomic_load(p, __ATOMIC_RELAXED, __HIP_MEMORY_SCOPE_AGENT); }
__device__ __forceinline__ unsigned xb_add(unsigned* p, unsigned v) { return __hip_atomic_fetch_add(p, v, __ATOMIC_RELAXED, __HIP_MEMORY_SCOPE_AGENT); }
__device__ __forceinline__ unsigned xb_xcc_id() { return (unsigned)__builtin_amdgcn_s_getreg((3 << 11) | 20) & 0xFu; }
#define XB_SPIN(cond, bar) do { unsigned _sp = 0; while (cond) { __builtin_amdgcn_s_sleep(1); \
    if ((++_sp & 255u) == 0u) { if (xb_ld(&(bar)[XB_TMO])) break; if (_sp > XB_SPIN_CAP) { atomicAdd(&(bar)[XB_TMO], 1u); break; } } } } while (0)

struct XcdBarrier {
    unsigned* bar; unsigned x;
    volatile XLAS unsigned* st;
};

__device__ __forceinline__ XcdBarrier xcd_barrier_post(unsigned* bar, volatile XLAS unsigned* st) {
    XcdBarrier b; b.bar = bar; b.x = xb_xcc_id(); b.st = st;
    if (threadIdx.x == 0) (void)xb_add(&bar[XB_XCNT(b.x)], 1u);
    return b;
}
__device__ __forceinline__ void xcd_barrier_complete(unsigned* bar, unsigned x, unsigned& nloc, unsigned& nx) {
    const unsigned G = gridDim.x * gridDim.y * gridDim.z;
    unsigned sum, cnt, mine, sp = 0u;
    for (;;) {
        sum = 0u; cnt = 0u; mine = 0u;
#pragma unroll
        for (unsigned j = 0; j < 16; ++j) { const unsigned c = xb_ld(&bar[XB_XCNT(j)]); sum += c; cnt += (c > 0u) ? 1u : 0u; mine = (j == x) ? c : mine; }
        if (sum == G) break;
        __builtin_amdgcn_s_sleep(1);
        if ((++sp & 255u) == 0u) { if (xb_ld(&bar[XB_TMO])) break; if (sp > XB_SPIN_CAP) { atomicAdd(&bar[XB_TMO], 1u); break; } }
    }
    nloc = mine > 0u ? mine : 1u; nx = cnt > 0u ? cnt : 1u;
}

__device__ __forceinline__ void xcd_barrier(const XcdBarrier& b) {
    asm volatile("s_waitcnt vmcnt(0)" ::: "memory");
    __syncthreads();
    if (threadIdx.x == 0) {
        unsigned* bar = b.bar;
        __builtin_amdgcn_s_waitcnt(0);
        unsigned nloc = b.st[0], nx = b.st[1];
        if (nloc == 0u) { xcd_barrier_complete(bar, b.x, nloc, nx); b.st[0] = nloc; b.st[1] = nx; }
        const unsigned old = xb_add(&bar[XB_XSUB(b.x)], 1u);
        const unsigned gen = old / nloc;
        if (old + 1u == (gen + 1u) * nloc) {
            __builtin_amdgcn_fence(__ATOMIC_RELEASE, "agent");
            asm volatile("s_waitcnt vmcnt(0)" ::: "memory");
            const unsigned og = xb_add(&bar[XB_TOP], 1u);
            const unsigned tg = og / nx;
            if (og + 1u == (tg + 1u) * nx) xb_add(&bar[XB_TOPGEN], 1u);
            else XB_SPIN(xb_ld(&bar[XB_TOPGEN]) == tg, bar);
            __builtin_amdgcn_fence(__ATOMIC_ACQUIRE, "agent");
            xb_add(&bar[XB_XGEN(b.x)], 1u);
            asm volatile("s_waitcnt vmcnt(0)" ::: "memory");
        } else {
            XB_SPIN(xb_ld(&bar[XB_XGEN(b.x)]) == gen, bar);
            __builtin_amdgcn_fence(__ATOMIC_ACQUIRE, "agent");
            asm volatile("s_waitcnt vmcnt(0)" ::: "memory");
        }
    }
    __syncthreads();
}

constexpr int LDS_BYTES = 131072;
__global__ void __launch_bounds__(NT, 2) fwd_megakernel(Params p0) {
  cg::grid_group grid = cg::this_grid();
  extern __shared__ __attribute__((aligned(16))) unsigned char shm[];
  char* smem = (char*)shm;
  PG8_LAS unsigned char* lds = (PG8_LAS unsigned char*)shm;
  const int nb = gridDim.x, bid = blockIdx.x, nw = gridDim.x * (NT / 64);
  __shared__ __attribute__((aligned(16))) unsigned xb_st[4];
  if (threadIdx.x < 4) xb_st[threadIdx.x] = 0u;
  __syncthreads();
  const XcdBarrier xbar = xcd_barrier_post((unsigned*)(p0.ws + OFF_BAR), (volatile XLAS unsigned*)xb_st);
#define GSYNC() xcd_barrier(xbar)
#define PH_BEGIN const Params p = launder(p0); const int tid = ltid(); const int lane = tid & 63; const int gw = bid * (NT / 64) + (tid >> 6); (void)lane; (void)gw;
  { PH_BEGIN phase0(p, tid); }
  grid.sync();
#pragma unroll 1
  for (int layer = 0; layer < 2; ++layer) {
    {
      PH_BEGIN
      InProjEpi epi{p.ws};
      run_gemm(lds, (const bf16_t*)(p.ws + OFF_X), (const bf16_t*)(p.ws + OFF_WIN) + (size_t)layer * NPAD * 1024, NTOK, NPAD, 1024, epi, tid);
    }
    if (layer == 0 && bid >= 192 && bid < 216) {
      PH_BEGIN
      const int l2 = (bid - 192) / 12, c = (bid - 192) - 12 * l2;
      MemKvEpi me{p.ws, l2};
      run_gemm_on(lds, (const bf16_t*)(p.ws + OFF_MEMN), (const bf16_t*)(p.ws + OFF_WMEM) + (size_t)l2 * 512 * 1024, 1536, 512, 1024, me, tid, 12, c);
    }
    GSYNC();
    { PH_BEGIN
#pragma unroll 1
      for (int t = bid; t < 1536; t += nb) na_block(p, layer, t, smem, tid); }
    { PH_BEGIN
#pragma unroll 1
      for (int t = gw; t < NTOK / 8; t += nw) gdn_prep_tok8(p, layer, t, lane); }
    GSYNC();
    { PH_BEGIN
      const int half = tid >> 8;
#pragma unroll 1
      for (int t = bid; t < 1536; t += nb) chunk_task(p, 2 * t + half, smem + half * 36864, tid & 255); }
    GSYNC();
    if (bid < 48) { PH_BEGIN scan_task(p, bid, smem, tid); }
    else { PH_BEGIN
#pragma unroll 1
      for (int t = bid - 48; t < 768; t += nb - 48) fft_task(p, t, (float2*)smem, tid);
#pragma unroll 1
      for (int t = bid - 48; t < 768; t += nb - 48) mem_block(p, layer, t, smem, tid); }
    GSYNC();
    { PH_BEGIN
#pragma unroll 1
      for (int t = gw; t < NTOK / 4; t += nw) gdn_finish_tok4(p, layer, 4 * t, lane); }
    {
      PH_BEGIN
      FnetEpi fe{p.ws};
      run_gemm(lds, (const bf16_t*)(p.ws + OFF_H), (const bf16_t*)(p.ws + OFF_WF) + (size_t)layer * 256 * 512, NTOK, 256, 512, fe, tid);
    }
    GSYNC();
    {
      PH_BEGIN
      OutEpi oe{(bf16_t*)(p.ws + OFF_OUTTMP)};
      run_gemm(lds, (const bf16_t*)(p.ws + OFF_MIX), (const bf16_t*)(p.ws + OFF_WOUT) + (size_t)layer * 1024 * 1024, NTOK, 1024, 1024, oe, tid);
    }
    GSYNC();
    { PH_BEGIN
#pragma unroll 1
      for (int t = gw; t < NTOK / 2; t += nw) post_token2(p, layer, 2 * t, lane); }
    if (layer == 0) GSYNC();
  }
}

extern "C" void kernel_launch(void* const* d_in, const int* in_sizes, int n_in, void* d_out, int out_size, void* d_ws, size_t ws_size, hipStream_t stream) {
  static int grid_blocks = 0;
  if (!grid_blocks) {
    int dev = 0, cus = 0, per_cu = 0;
    (void)hipGetDevice(&dev);
    (void)hipDeviceGetAttribute(&cus, hipDeviceAttributeMultiprocessorCount, dev);
    if (hipFuncSetAttribute((const void*)fwd_megakernel, hipFuncAttributeMaxDynamicSharedMemorySize, LDS_BYTES) != hipSuccess) fprintf(stderr, "hipFuncSetAttribute failed\n");
    (void)hipOccupancyMaxActiveBlocksPerMultiprocessor(&per_cu, fwd_megakernel, NT, LDS_BYTES);
    if (per_cu > 1) per_cu = 1;
    grid_blocks = cus * per_cu;
    if (grid_blocks <= 0) { fprintf(stderr, "occupancy query returned %d x %d\n", cus, per_cu); grid_blocks = -1; }
  }
  if (grid_blocks < 0) return;
  if (ws_size < WS_NEED || n_in != 16) { fprintf(stderr, "kernel_launch: need %zu bytes of workspace, got %zu (n_in %d)\n", (size_t)WS_NEED, ws_size, n_in); return; }
  Params p{};
  p.x_prompt = (const float*)d_in[0]; p.x_sample = (const float*)d_in[1]; p.mem_prompt = (const float*)d_in[2]; p.mem_sample = (const float*)d_in[3];
  p.pre_g = (const float*)d_in[4]; p.post_g = (const float*)d_in[5]; p.w_in = (const float*)d_in[6]; p.w_fnet = (const float*)d_in[7];
  p.conv_w = (const float*)d_in[8]; p.a_log = (const float*)d_in[9]; p.dt_bias = (const float*)d_in[10]; p.gdn_g = (const float*)d_in[11];
  p.rpb = (const float*)d_in[12]; p.mem_g = (const float*)d_in[13]; p.w_mem_kv = (const float*)d_in[14]; p.w_out = (const float*)d_in[15];
  p.out = (float*)d_out; p.ws = (unsigned char*)d_ws;
  if (hipMemsetAsync((unsigned char*)d_ws + OFF_BAR, 0, XCD_BAR_WORDS * sizeof(unsigned), stream) != hipSuccess) { fprintf(stderr, "memset failed\n"); return; }
  void* args[] = {&p};
  hipError_t e = hipLaunchCooperativeKernel((void*)fwd_megakernel, dim3(grid_blocks), dim3(NT), args, LDS_BYTES, stream);
  if (e != hipSuccess) fprintf(stderr, "cooperative launch failed: %s (grid %d)\n", hipGetErrorString(e), grid_blocks);
}
```

```cpp
#include <hip/hip_runtime.h>
#include <hip/hip_cooperative_groups.h>
#include <cstdio>
namespace cg = cooperative_groups;

typedef unsigned short bf16_t;
typedef short bf16x8 __attribute__((ext_vector_type(8)));
typedef float f32x4 __attribute__((ext_vector_type(4)));

#define NT 512
#define DI __device__ __forceinline__
#define MFMA16(a, b, c) __builtin_amdgcn_mfma_f32_16x16x32_bf16((a), (b), (c), 0, 0, 0)

constexpr int SEQL = 8192, NTOK = 49152;
constexpr size_t MiB = (size_t)1 << 20;
constexpr int NPAD = 3328;
constexpr size_t OFF_WIN = 0, OFF_WOUT = 13631488, OFF_WMEM = 17825792, OFF_WF = 19922944, OFF_MEMN = 20447232,
                 OFF_KMEM = 23592960, OFF_VMEMT = 25165824, OFF_TW = 26738688;
constexpr size_t OFF_MIX = 26 * MiB, OFF_AZ = 122 * MiB, OFF_CZ = 146 * MiB, OFF_DZ = 170 * MiB, OFF_GATES = 194 * MiB, OFF_X = 197 * MiB,
                 OFF_BQKV = 293 * MiB, OFF_CK = 365 * MiB, OFF_CVT = 389 * MiB;
constexpr size_t OFF_H = OFF_X, OFF_QN = 245 * MiB, OFF_KN = 269 * MiB, OFF_KT = 464 * MiB, OFF_VN = 488 * MiB;
constexpr size_t OFF_CHW = 293 * MiB, OFF_CHU = 341 * MiB, OFF_CHQK = 389 * MiB, OFF_CVEC = 437 * MiB;
constexpr size_t OFF_OF = OFF_KN, OFF_OB = OFF_VN, OFF_OUTTMP = 293 * MiB;
constexpr size_t OFF_BAR = 26771456;
constexpr size_t WS_NEED = 512 * MiB;

struct Params {
  const float* x_prompt; const float* x_sample; const float* mem_prompt; const float* mem_sample;
  const float* pre_g; const float* post_g; const float* w_in; const float* w_fnet; const float* conv_w;
  const float* a_log; const float* dt_bias; const float* gdn_g; const float* rpb; const float* mem_g;
  const float* w_mem_kv; const float* w_out;
  float* out; unsigned char* ws;
};

typedef float f32x2_t __attribute__((ext_vector_type(2)));
typedef __bf16 bf16x2_t __attribute__((ext_vector_type(2)));
DI unsigned pack2(float lo, float hi) { f32x2_t f = {lo, hi}; return __builtin_bit_cast(unsigned, __builtin_convertvector(f, bf16x2_t)); }
DI bf16_t f2bf(float x) { return (bf16_t)(pack2(x, 0.f) & 0xffffu); }
DI float bf2f(bf16_t h) { return __uint_as_float(((unsigned)h) << 16); }
DI float bflo(unsigned u) { return __uint_as_float(u << 16); }
DI float bfhi(unsigned u) { return __uint_as_float(u & 0xffff0000u); }
DI float wave_sum(float v) {
#pragma unroll
  for (int m = 32; m >= 1; m >>= 1) v += __shfl_xor(v, m, 64);
  return v;
}
DI float silu(float x) { return x * __builtin_amdgcn_rcpf(1.f + __expf(-x)); }
DI bf16x8 pack8(const f32x4& a, const f32x4& b) {
  uint4 u; u.x = pack2(a[0], a[1]); u.y = pack2(a[2], a[3]); u.z = pack2(b[0], b[1]); u.w = pack2(b[2], b[3]);
  return __builtin_bit_cast(bf16x8, u);
}
DI bf16x8 ld8(const bf16_t* p) { return *(const bf16x8*)p; }
DI bf16x8 ld4x2(const bf16_t* lo, const bf16_t* hi) {
  uint2 a = *(const uint2*)lo, b = *(const uint2*)hi; uint4 u; u.x = a.x; u.y = a.y; u.z = b.x; u.w = b.y;
  return __builtin_bit_cast(bf16x8, u);
}
DI int ltid() { int t = threadIdx.x; asm volatile("" : "+v"(t)); return t; }
DI Params launder(Params p) { size_t z = 0; asm volatile("" : "+s"(z)); p.ws = p.ws + z; return p; }
DI const float* xrow(const Params& p, int tok) {
  return tok < 32768 ? p.x_prompt + (size_t)tok * 1024 : p.x_sample + (size_t)(tok - 32768) * 1024;
}

DI void norm_row_bf16(const float* src, bf16_t* dst, int lane) {
  float4 v[4]; float ss = 0.f;
#pragma unroll
  for (int i = 0; i < 4; ++i) { v[i] = *(const float4*)(src + i * 256 + lane * 4); ss += v[i].x * v[i].x + v[i].y * v[i].y + v[i].z * v[i].z + v[i].w * v[i].w; }
  ss = wave_sum(ss);
  const float rs = rsqrtf(ss * (1.f / 1024.f) + 1e-6f);
#pragma unroll
  for (int i = 0; i < 4; ++i) { uint2 o; o.x = pack2(v[i].x * rs, v[i].y * rs); o.y = pack2(v[i].z * rs, v[i].w * rs); *(uint2*)(dst + i * 256 + lane * 4) = o; }
}

DI void phase0(const Params& p, const int tid) {
  const int gtid = blockIdx.x * NT + tid, gsz = gridDim.x * NT;
  bf16_t* WinT = (bf16_t*)(p.ws + OFF_WIN);
  for (int idx = gtid; idx < 2 * NPAD * 128; idx += gsz) {
    const int l = idx / (NPAD * 128); const int rem = idx - l * NPAD * 128; const int k8 = rem / NPAD; const int r = rem - k8 * NPAD;
    const int src = r < 1536 ? r : (r < 3072 ? r + 16 : (r < 3088 ? 1536 + (r - 3072) : -1));
    uint4 o = make_uint4(0, 0, 0, 0);
    if (src >= 0) {
      const float* w = p.w_in + ((size_t)l * 1024 + k8 * 8) * 3088 + src;
      const float* g = p.pre_g + l * 1024 + k8 * 8;
      float v[8];
#pragma unroll
      for (int j = 0; j < 8; ++j) v[j] = w[(size_t)j * 3088] * g[j];
      o.x = pack2(v[0], v[1]); o.y = pack2(v[2], v[3]); o.z = pack2(v[4], v[5]); o.w = pack2(v[6], v[7]);
    }
    *(uint4*)(WinT + ((size_t)l * NPAD + r) * 1024 + k8 * 8) = o;
  }
  bf16_t* WoutT = (bf16_t*)(p.ws + OFF_WOUT);
  for (int idx = gtid; idx < 2 * 1024 * 128; idx += gsz) {
    const int l = idx / (1024 * 128); const int rem = idx - l * 1024 * 128; const int k8 = rem / 1024; const int r = rem - k8 * 1024;
    const float* w = p.w_out + ((size_t)l * 1024 + k8 * 8) * 1024 + r;
    float v[8];
#pragma unroll
    for (int j = 0; j < 8; ++j) v[j] = w[(size_t)j * 1024];
    uint4 o; o.x = pack2(v[0], v[1]); o.y = pack2(v[2], v[3]); o.z = pack2(v[4], v[5]); o.w = pack2(v[6], v[7]);
    *(uint4*)(WoutT + ((size_t)l * 1024 + r) * 1024 + k8 * 8) = o;
  }
  bf16_t* WmemT = (bf16_t*)(p.ws + OFF_WMEM);
  for (int idx = gtid; idx < 2 * 512 * 128; idx += gsz) {
    const int l = idx / (512 * 128); const int rem = idx - l * 512 * 128; const int k8 = rem / 512; const int r = rem - k8 * 512;
    const float* w = p.w_mem_kv + ((size_t)l * 1024 + k8 * 8) * 512 + r;
    const float* g = p.mem_g + l * 1024 + k8 * 8;
    float v[8];
#pragma unroll
    for (int j = 0; j < 8; ++j) v[j] = w[(size_t)j * 512] * g[j];
    uint4 o; o.x = pack2(v[0], v[1]); o.y = pack2(v[2], v[3]); o.z = pack2(v[4], v[5]); o.w = pack2(v[6], v[7]);
    *(uint4*)(WmemT + ((size_t)l * 512 + r) * 1024 + k8 * 8) = o;
  }
  bf16_t* WfT = (bf16_t*)(p.ws + OFF_WF);
  const float fscale = 0.00138106793f;
  for (int idx = gtid; idx < 2 * 256 * 512; idx += gsz) {
    const int l = idx >> 17; const int rem = idx & 131071; const int kk = rem >> 8; const int j = rem & 255;
    const int k2 = kk & 255, blk = k2 >> 6, cp = k2 & 63;
    const float* w = p.w_fnet + ((size_t)l * 256 + blk * 64) * 256 + j;
    float a = 0.f;
    for (int c = 0; c < 64; ++c) {
      const float turns = (float)((c * cp) & 63) * (1.f / 64.f);
      const float tr = kk < 256 ? __builtin_amdgcn_cosf(turns) : __builtin_amdgcn_sinf(turns);
      a += tr * w[(size_t)c * 256];
    }
    WfT[((size_t)l * 256 + j) * 512 + kk] = f2bf(a * fscale);
  }
  float2* tw = (float2*)(p.ws + OFF_TW);
  for (int t = gtid; t < 4096; t += gsz) { float s, c; sincospif((float)t * (1.f / 4096.f), &s, &c); tw[t] = make_float2(c, -s); }
  const int lane = tid & 63, gw = blockIdx.x * (NT / 64) + (tid >> 6), nw = gridDim.x * (NT / 64);
  bf16_t* memn = (bf16_t*)(p.ws + OFF_MEMN);
  for (int r = gw; r < 1536; r += nw) {
    const float* src = r < 1024 ? p.mem_prompt + (size_t)r * 1024 : p.mem_sample + (size_t)(r - 1024) * 1024;
    norm_row_bf16(src, memn + (size_t)r * 1024, lane);
  }
  bf16_t* xn = (bf16_t*)(p.ws + OFF_X);
  for (int t = gw; t < NTOK / 2; t += nw) {
    const float* s0 = xrow(p, 2 * t); const float* s1 = xrow(p, 2 * t + 1);
    float4 v0[4], v1[4]; float a0 = 0.f, a1 = 0.f;
#pragma unroll
    for (int i = 0; i < 4; ++i) { v0[i] = *(const float4*)(s0 + i * 256 + lane * 4); v1[i] = *(const float4*)(s1 + i * 256 + lane * 4); }
#pragma unroll
    for (int i = 0; i < 4; ++i) { a0 += v0[i].x * v0[i].x + v0[i].y * v0[i].y + v0[i].z * v0[i].z + v0[i].w * v0[i].w; a1 += v1[i].x * v1[i].x + v1[i].y * v1[i].y + v1[i].z * v1[i].z + v1[i].w * v1[i].w; }
    a0 = wave_sum(a0); a1 = wave_sum(a1);
    const float r0 = rsqrtf(a0 * (1.f / 1024.f) + 1e-6f), r1 = rsqrtf(a1 * (1.f / 1024.f) + 1e-6f);
    bf16_t* d0 = xn + (size_t)(2 * t) * 1024; bf16_t* d1 = d0 + 1024;
#pragma unroll
    for (int i = 0; i < 4; ++i) {
      uint2 o; o.x = pack2(v0[i].x * r0, v0[i].y * r0); o.y = pack2(v0[i].z * r0, v0[i].w * r0); *(uint2*)(d0 + i * 256 + lane * 4) = o;
      o.x = pack2(v1[i].x * r1, v1[i].y * r1); o.y = pack2(v1[i].z * r1, v1[i].w * r1); *(uint2*)(d1 + i * 256 + lane * 4) = o;
    }
  }
}

namespace pg8 {
#define PG8_LAS __attribute__((address_space(3)))
typedef unsigned short bf16_t;
typedef short bf16x8 __attribute__((ext_vector_type(8)));
typedef float f32x4 __attribute__((ext_vector_type(4)));
typedef unsigned u32x4 __attribute__((ext_vector_type(4)));
constexpr int BM = 256, BK = 64, HALF = 128, HTB = HALF * BK * 2  , STAGE_BYTES = 8 * HTB, NXCD = 8, WGM = 8;

__host__ __device__ __forceinline__ int lds_byte(int r, int c) { const int st = (r >> 4) * 2 + (c >> 5), rr = r & 15, cc = c & 31, ob = rr * 64 + cc * 2; return st * 1024 + (ob ^ (((ob >> 9) & 1) << 5)); }
__host__ __device__ __forceinline__ void stage_rc(int b, int& R, int& C) { const int st = b / 1024, sb = b % 1024, swz = sb ^ (((sb >> 9) & 1) << 5); R = (st >> 1) * 16 + swz / 64; C = (st & 1) * 32 + (swz % 64) / 2; }
__host__ __device__ __forceinline__ int perm32(int rho) { const int n = rho >> 4, i = rho & 15; return 8 * (i >> 2) + 4 * n + (i & 3); }

struct Unit { int pm, pn; };
struct Gemm { const bf16_t* A; const bf16_t* Bt; int M, N, K; };

struct StaticOrder {
    int nM, nN, nwg, G, c;
    __host__ __device__ void init(int M, int N, int G_, int c_) { nM = M / BM; nN = N / BM; nwg = nM * nN; G = G_; c = c_; }
    __host__ __device__ bool next(int i, Unit& u) const {
        const long L = (long)i * G + c; if (L >= nwg) return false;
        int wgid = (int)L; { const int q = nwg / NXCD, r = nwg % NXCD, xcd = wgid % NXCD, off = wgid / NXCD; wgid = (xcd < r ? xcd * (q + 1) : r * (q + 1) + (xcd - r) * q) + off; }
        const int nig = WGM * nN, gid = wgid / nig, fm = gid * WGM, gsz = (nM - fm) < WGM ? (nM - fm) : WGM;
        u.pm = fm + ((wgid % nig) % gsz); u.pn = (wgid % nig) / gsz; return true;
    }
    __device__ __forceinline__ void a_ready(const Unit&) const {}
    __device__ __forceinline__ void done(const Unit&) const {}
};
template <class Epi, class Sched, bool STAMP = false>
__device__ __forceinline__ void gemm_phase(PG8_LAS unsigned char* lds, const Gemm g, const Sched& S, const Epi& E, unsigned long long* stamps, const int tid_in) {
    const int tid = tid_in, wid = __builtin_amdgcn_readfirstlane(tid >> 6), lane = tid & 63, wr = wid >> 2, wc = wid & 3, fr = lane & 15, fq = lane >> 4;
    const int K = g.K, nt = K / BK;
    int ts_lo = 0, ts_hi = 0, nts = 0; const unsigned long long rt_entry = STAMP ? (unsigned long long)wall_clock64() : 0ull;
#define PG8_STAMP() do { if (STAMP && wid == 0 && nts < 64) { const unsigned long long _c = (unsigned long long)clock64(); \
        ts_lo = (lane == nts) ? (int)(unsigned)_c : ts_lo; ts_hi = (lane == nts) ? (int)(unsigned)(_c >> 32) : ts_hi; ++nts; } } while (0)
    PG8_STAMP();
    unsigned voffA[2], voffB[2];
#pragma unroll
    for (int i = 0; i < 2; ++i) { int R, C; stage_rc(tid * 16 + i * 8192, R, C); const int Rb = Epi::PERM ? ((R & ~31) + perm32(R & 31)) : R;
        voffA[i] = (unsigned)(R * K + C) * 2u; voffB[i] = (unsigned)(Rb * K + C) * 2u; }
    const size_t kstep = (size_t)(BK * 2);
    const size_t hstep = (size_t)HALF * K * 2;
    const size_t tstep = 2 * hstep;
    const unsigned ldsw = (unsigned)wid * 1024u;
    const int aoff = lds_byte(wr * 64 + fr, fq * 8), boff = lds_byte(wc * 32 + fr, fq * 8);
#define PG8_SA(b, h) (((b) * 2 + (h)) * HTB)
#define PG8_SB(b, h) ((4 + (b) * 2 + (h)) * HTB)
#define PG8_STAGE(bufoff, gbase, voff) do { _Pragma("unroll") for (int _i = 0; _i < 2; ++_i) \
        __builtin_amdgcn_global_load_lds((const unsigned*)((const char*)(gbase) + (voff)[_i]), (PG8_LAS unsigned*)(lds + (bufoff) + ldsw + _i * 8192), 16, 0, 0); } while (0)
#define PG8_LDA(dst, b, h) do { _Pragma("unroll") for (int m = 0; m < 4; ++m) _Pragma("unroll") for (int k = 0; k < 2; ++k) dst[m][k] = *(const PG8_LAS bf16x8*)(lds + PG8_SA(b, h) + aoff + m * 2048 + k * 1024); } while (0)
#define PG8_LDB(dst, b, h) do { _Pragma("unroll") for (int n = 0; n < 2; ++n) _Pragma("unroll") for (int k = 0; k < 2; ++k) dst[n][k] = *(const PG8_LAS bf16x8*)(lds + PG8_SB(b, h) + boff + n * 2048 + k * 1024); } while (0)
#define PG8_MMA(ai, bj, At, Bt) do { __builtin_amdgcn_s_setprio(1); _Pragma("unroll") for (int m = 0; m < 4; ++m) _Pragma("unroll") for (int n = 0; n < 2; ++n) _Pragma("unroll") for (int k = 0; k < 2; ++k) \
        acc[ai][bj][m][n] = __builtin_amdgcn_mfma_f32_16x16x32_bf16(Bt[n][k], At[m][k], acc[ai][bj][m][n], 0, 0, 0); __builtin_amdgcn_s_setprio(0); } while (0)
#define PG8_WAIT_V(n) asm volatile("s_waitcnt vmcnt(" #n ")" ::: "memory")
#define PG8_WAIT_L(n) asm volatile("s_waitcnt lgkmcnt(" #n ")" ::: "memory")
#define PG8_BAR __builtin_amdgcn_s_barrier()
#define PG8_SCHED __builtin_amdgcn_sched_barrier(0)
    Unit cur, nxt; int ui = 0;
    if (!S.next(0, cur)) return;
    f32x4 acc[2][2][4][2];
#pragma unroll
    for (int a = 0; a < 2; ++a)
#pragma unroll
        for (int b = 0; b < 2; ++b)
#pragma unroll
            for (int m = 0; m < 4; ++m)
#pragma unroll
                for (int n = 0; n < 2; ++n) acc[a][b][m][n] = (f32x4){0.f, 0.f, 0.f, 0.f};
    bf16x8 At[4][2], B0[2][2], B1[2][2];
    const char* cA = (const char*)g.A + (size_t)cur.pm * tstep; const char* cB = (const char*)g.Bt + (size_t)cur.pn * tstep;
    S.a_ready(cur);
    PG8_STAGE(PG8_SB(0, 0), cB, voffB); PG8_STAGE(PG8_SA(0, 0), cA, voffA); PG8_STAGE(PG8_SB(0, 1), cB + hstep, voffB); PG8_STAGE(PG8_SA(0, 1), cA + hstep, voffA);
    if (wr == 1) PG8_BAR;
    PG8_WAIT_V(4); PG8_BAR;
    PG8_STAGE(PG8_SB(1, 0), cB + kstep, voffB); PG8_STAGE(PG8_SA(1, 0), cA + kstep, voffA); PG8_STAGE(PG8_SB(1, 1), cB + hstep + kstep, voffB);
    PG8_WAIT_V(6); PG8_BAR;
    PG8_STAMP();
    for (;;) {
        const bool has_next = S.next(ui + 1, nxt);
        const char* nA = has_next ? (const char*)g.A + (size_t)nxt.pm * tstep : cA; const char* nB = has_next ? (const char*)g.Bt + (size_t)nxt.pn * tstep : cB;
        for (int t = 0; t < nt; t += 2) {
            const bool last = (t == nt - 2);
            const char* a1 = cA + (size_t)(t + 1) * kstep;
            const char* a2 = last ? nA : cA + (size_t)(t + 2) * kstep; const char* b2 = last ? nB : cB + (size_t)(t + 2) * kstep;
            const char* a3 = a2 + kstep; const char* b3 = b2 + kstep;
            if (last && has_next) S.a_ready(nxt);
            PG8_LDB(B0, 0, 0); PG8_SCHED; PG8_LDA(At, 0, 0); PG8_STAGE(PG8_SA(1, 1), a1 + hstep, voffA);
            PG8_WAIT_L(8); PG8_BAR; PG8_WAIT_L(0); PG8_MMA(0, 0, At, B0); PG8_BAR; PG8_SCHED;
            PG8_LDB(B1, 0, 1); PG8_STAGE(PG8_SB(0, 0), b2, voffB);
            PG8_BAR; PG8_WAIT_L(0); PG8_MMA(0, 1, At, B1); PG8_BAR;
            PG8_LDA(At, 0, 1); PG8_STAGE(PG8_SA(0, 0), a2, voffA);
            PG8_BAR; PG8_WAIT_L(0); PG8_MMA(1, 0, At, B0); PG8_BAR; PG8_SCHED;
            PG8_STAGE(PG8_SB(0, 1), b2 + hstep, voffB);
            PG8_WAIT_V(6); PG8_BAR; PG8_MMA(1, 1, At, B1); PG8_BAR;
            PG8_LDB(B0, 1, 0); PG8_SCHED; PG8_LDA(At, 1, 0); PG8_STAGE(PG8_SA(0, 1), a2 + hstep, voffA);
            PG8_WAIT_L(8); PG8_BAR; PG8_WAIT_L(0); PG8_MMA(0, 0, At, B0); PG8_BAR; PG8_SCHED;
            PG8_LDB(B1, 1, 1); PG8_STAGE(PG8_SB(1, 0), b3, voffB);
            PG8_BAR; PG8_WAIT_L(0); PG8_MMA(0, 1, At, B1); PG8_BAR;
            PG8_LDA(At, 1, 1); PG8_STAGE(PG8_SA(1, 0), a3, voffA);
            PG8_BAR; PG8_WAIT_L(0); PG8_MMA(1, 0, At, B0); PG8_BAR; PG8_SCHED;
            PG8_STAGE(PG8_SB(1, 1), b3 + hstep, voffB);
            PG8_WAIT_V(6); PG8_BAR; PG8_MMA(1, 1, At, B1); PG8_BAR;
        }
        PG8_STAMP();
        if constexpr (!Epi::AFTER_DRAIN) { E(acc, cur, wr, wc, fr, fq); S.done(cur); }
        PG8_STAMP();
        if (!has_next) break;
#pragma unroll
        for (int a = 0; a < 2; ++a)
#pragma unroll
            for (int b = 0; b < 2; ++b)
#pragma unroll
                for (int m = 0; m < 4; ++m)
#pragma unroll
                    for (int n = 0; n < 2; ++n) acc[a][b][m][n] = (f32x4){0.f, 0.f, 0.f, 0.f};
        cur = nxt; cA = nA; cB = nB; ++ui;
    }
    PG8_WAIT_V(0);
    if (wr == 0) PG8_BAR;
    PG8_BAR;
    if constexpr (Epi::AFTER_DRAIN) { E.fused(acc, cur, wr, wc, fr, fq, lds, wid, lane); S.done(cur); }
    PG8_STAMP();
    if (STAMP && wid == 0) { stamps[lane] = lane < nts ? (((unsigned long long)(unsigned)ts_hi << 32) | (unsigned)ts_lo) : 0ull;
        if (lane == 62) stamps[62] = rt_entry; if (lane == 63) stamps[63] = (unsigned long long)wall_clock64(); }
#undef PG8_STAMP
#undef PG8_SA
#undef PG8_SB
#undef PG8_STAGE
#undef PG8_LDA
#undef PG8_LDB
#undef PG8_MMA
#undef PG8_WAIT_V
#undef PG8_WAIT_L
#undef PG8_BAR
#undef PG8_SCHED
}
}

template <class F> struct EpiWrap {
  static constexpr bool PERM = false, AFTER_DRAIN = false;
  F f;
  DI void operator()(const f32x4 (&acc)[2][2][4][2], const pg8::Unit& u, int wr, int wc, int fr, int fq) const {
#pragma unroll
    for (int ai = 0; ai < 2; ++ai)
#pragma unroll
      for (int m = 0; m < 4; ++m) {
        const int row = u.pm * 256 + ai * 128 + wr * 64 + m * 16 + fr;
#pragma unroll
        for (int bj = 0; bj < 2; ++bj)
#pragma unroll
          for (int n = 0; n < 2; ++n) f(u.pn * 256 + bj * 128 + wc * 32 + n * 16 + 4 * fq, row, acc[ai][bj][m][n]);
      }
  }
};
template <class F>
DI void run_gemm_on(PG8_LAS unsigned char* lds, const bf16_t* A, const bf16_t* Bt, int M, int N, int K, const F& f, const int tid, int G, int c) {
  pg8::Gemm g; g.A = A; g.Bt = Bt; g.M = M; g.N = N; g.K = K;
  pg8::StaticOrder S; S.init(M, N, G, c);
  EpiWrap<F> E{f};
  pg8::gemm_phase<EpiWrap<F>, pg8::StaticOrder, false>(lds, g, S, E, nullptr, tid);
  __syncthreads();
}
template <class F>
DI void run_gemm(PG8_LAS unsigned char* lds, const bf16_t* A, const bf16_t* Bt, int M, int N, int K, const F& f, const int tid) {
  pg8::Gemm g; g.A = A; g.Bt = Bt; g.M = M; g.N = N; g.K = K;
  pg8::StaticOrder S; S.init(M, N, (int)gridDim.x, (int)blockIdx.x);
  EpiWrap<F> E{f};
  pg8::gemm_phase<EpiWrap<F>, pg8::StaticOrder, false>(lds, g, S, E, nullptr, tid);
  __syncthreads();
}

struct InProjEpi {
  unsigned char* ws;
  DI void operator()(int m, int n, const f32x4& v) const {
    if (m < 3072) {
      const int blk = m >> 8, c = m & 255;
      if (blk == 8) {
        bf16_t* cvt = (bf16_t*)(ws + OFF_CVT);
        const int seq = n >> 13, l = n & 8191;
        bf16_t* d = cvt + ((size_t)(seq * 256 + c)) * 8192 + l;
#pragma unroll
        for (int e = 0; e < 4; ++e) d[(size_t)e * 8192] = f2bf(v[e]);
      } else {
        bf16_t* d;
        if (blk >= 2 && blk <= 4) d = (bf16_t*)(ws + OFF_BQKV) + (size_t)n * 768 + (blk - 2) * 256 + c;
        else if (blk == 0 || blk == 5 || blk == 6 || blk == 10) d = (bf16_t*)(ws + OFF_MIX) + (size_t)n * 1024 + (blk == 0 ? 0 : blk == 5 ? 256 : blk == 6 ? 512 : 768) + c;
        else {
          size_t off = blk == 1 ? OFF_AZ : blk == 7 ? OFF_CK : blk == 9 ? OFF_CZ : OFF_DZ;
          d = (bf16_t*)(ws + off) + (size_t)n * 256 + c;
        }
        uint2 o; o.x = pack2(v[0], v[1]); o.y = pack2(v[2], v[3]); *(uint2*)d = o;
      }
    } else if (m < 3088) {
      float* g = (float*)(ws + OFF_GATES) + (size_t)n * 16 + (m - 3072);
      *(float4*)g = make_float4(v[0], v[1], v[2], v[3]);
    }
  }
};
struct MemKvEpi {
  unsigned char* ws; int l;
  DI void operator()(int m, int n, const f32x4& v) const {
    const int seq = n >> 8, key = n & 255;
    if (m < 256) {
      const int head = m >> 6, dim = m & 63;
      bf16_t* d = (bf16_t*)(ws + OFF_KMEM) + ((size_t)((l * 6 + seq) * 4 + head) * 256 + key) * 64 + dim;
      uint2 o; o.x = pack2(v[0], v[1]); o.y = pack2(v[2], v[3]); *(uint2*)d = o;
    } else {
      const int c = m - 256, head = c >> 6, dim = c & 63;
      bf16_t* d = (bf16_t*)(ws + OFF_VMEMT) + ((size_t)((l * 6 + seq) * 4 + head) * 64 + dim) * 256 + key;
#pragma unroll
      for (int e = 0; e < 4; ++e) d[e * 256] = f2bf(v[e]);
    }
  }
};
struct FnetEpi {
  unsigned char* ws;
  DI void operator()(int m, int n, const f32x4& v) const {
    const uint2 z = *(const uint2*)((const bf16_t*)(ws + OFF_AZ) + (size_t)n * 256 + m);
    uint2 o; o.x = pack2(v[0] * silu(bflo(z.x)), v[1] * silu(bfhi(z.x))); o.y = pack2(v[2] * silu(bflo(z.y)), v[3] * silu(bfhi(z.y)));
    *(uint2*)((bf16_t*)(ws + OFF_MIX) + (size_t)n * 1024 + m) = o;
  }
};
struct OutEpi {
  bf16_t* dst;
  DI void operator()(int m, int n, const f32x4& v) const { uint2 o; o.x = pack2(v[0], v[1]); o.y = pack2(v[2], v[3]); *(uint2*)(dst + (size_t)n * 1024 + m) = o; }
};

DI int fft_pos(int k) {
  return ((k & 1) << 12) | (((k >> 1) & 3) << 10) | (((k >> 3) & 3) << 8) | (((k >> 5) & 3) << 6) | (((k >> 7) & 3) << 4) | (((k >> 9) & 3) << 2) | ((k >> 11) & 3);
}
DI void fft_task(const Params& p, int task, float2* z, const int tid) {
  const int seq = task >> 7, cp = task & 127;
  const unsigned* au = (const unsigned*)(p.ws + OFF_MIX) + (size_t)seq * 8192 * 512 + cp;
  const float2* tw = (const float2*)(p.ws + OFF_TW);
  for (int i = tid; i < 8192; i += NT) { const unsigned u = au[(size_t)i * 512]; z[i] = make_float2(bflo(u), bfhi(u)); }
  __syncthreads();
  for (int b = tid; b < 4096; b += NT) {
    const float2 a = z[b], c = z[b + 4096], w = tw[b];
    z[b] = make_float2(a.x + c.x, a.y + c.y);
    const float dx = a.x - c.x, dy = a.y - c.y;
    z[b + 4096] = make_float2(dx * w.x - dy * w.y, dx * w.y + dy * w.x);
  }
  __syncthreads();
#pragma unroll 1
  for (int s4 = 0; s4 < 6; ++s4) {
    const int lq = 10 - 2 * s4, q = 1 << lq;
    for (int b = tid; b < 2048; b += NT) {
      const int j = b & (q - 1), i0 = ((b >> lq) << (lq + 2)) + j;
      const float2 a0 = z[i0], a1 = z[i0 + q], a2 = z[i0 + 2 * q], a3 = z[i0 + 3 * q];
      const float2 w1 = tw[j << (1 + 2 * s4)];
      const float2 w2 = make_float2(w1.x * w1.x - w1.y * w1.y, 2.f * w1.x * w1.y);
      const float2 w3 = make_float2(w2.x * w1.x - w2.y * w1.y, w2.x * w1.y + w2.y * w1.x);
      const float t0x = a0.x + a2.x, t0y = a0.y + a2.y, t1x = a0.x - a2.x, t1y = a0.y - a2.y;
      const float t2x = a1.x + a3.x, t2y = a1.y + a3.y, t3x = a1.y - a3.y, t3y = -(a1.x - a3.x);
      z[i0] = make_float2(t0x + t2x, t0y + t2y);
      const float y1x = t1x + t3x, y1y = t1y + t3y, y2x = t0x - t2x, y2y = t0y - t2y, y3x = t1x - t3x, y3y = t1y - t3y;
      z[i0 + q] = make_float2(y1x * w1.x - y1y * w1.y, y1x * w1.y + y1y * w1.x);
      z[i0 + 2 * q] = make_float2(y2x * w2.x - y2y * w2.y, y2x * w2.y + y2y * w2.x);
      z[i0 + 3 * q] = make_float2(y3x * w3.x - y3y * w3.y, y3x * w3.y + y3y * w3.x);
    }
    __syncthreads();
  }
  unsigned* H = (unsigned*)(p.ws + OFF_H) + (size_t)seq * 8192 * 256;
  for (int k = tid; k < 8192; k += NT) {
    const float2 zk = z[fft_pos(k)], zn = z[fft_pos((8192 - k) & 8191)];
    H[(size_t)k * 256 + cp] = pack2(0.5f * (zk.x + zn.x), 0.5f * (zk.y + zn.y));
    H[(size_t)k * 256 + 128 + cp] = pack2(0.5f * (zk.y - zn.y), -0.5f * (zk.x - zn.x));
  }
  __syncthreads();
}

template <bool NA>
DI void attn_core(const Params& p, int layer, int h, int tok0, int r, int c0, int rs, int wsx, const bf16_t* sK, const bf16_t* sVT, const float* sBias, int kb, int pitch, int vstride, int lane) {
  const int fr = lane & 15, fq = lane >> 4;
  bf16_t* Q = (bf16_t*)(p.ws + OFF_MIX) + (NA ? 512 : 768);
  const bf16_t* Z = (const bf16_t*)(p.ws + (NA ? OFF_CZ : OFF_DZ));
  const bf16_t* qp = Q + (size_t)(tok0 + fr) * 1024 + h * 64 + fq * 8;
  bf16x8 qf[2]; qf[0] = ld8(qp); qf[1] = ld8(qp + 32);
  f32x4 s[16];
#pragma unroll
  for (int kt = 0; kt < 16; ++kt) {
    const bf16_t* kp = sK + (kb + (kt >> 1) * pitch + (kt & 1) * 16 + fr) * 72 + fq * 8;
    f32x4 a = (f32x4){0.f, 0.f, 0.f, 0.f};
    a = MFMA16(ld8(kp), qf[0], a);
    a = MFMA16(ld8(kp + 32), qf[1], a);
    s[kt] = a;
  }
  float mx = -1e30f;
  if (NA) {
    const int c = c0 + fr, cs = min(max(c - 8, 0), 48);
#pragma unroll
    for (int kt = 0; kt < 16; ++kt) {
      const int kr = rs + (kt >> 1);
      const float* rb = sBias + (kr - r + 7) * 31;
#pragma unroll
      for (int e = 0; e < 4; ++e) {
        const int kc = wsx + (kt & 1) * 16 + 4 * fq + e;
        const bool valid = kc >= cs && kc < cs + 16;
        const float bias = rb[min(max(kc - c + 15, 0), 30)];
        const float v = valid ? s[kt][e] * 0.125f + bias : -1e30f;
        s[kt][e] = v; mx = fmaxf(mx, v);
      }
    }
  } else {
#pragma unroll
    for (int kt = 0; kt < 16; ++kt)
#pragma unroll
      for (int e = 0; e < 4; ++e) { const float v = s[kt][e] * 0.125f; s[kt][e] = v; mx = fmaxf(mx, v); }
  }
  mx = fmaxf(mx, __shfl_xor(mx, 16, 64)); mx = fmaxf(mx, __shfl_xor(mx, 32, 64));
  float sum = 0.f;
#pragma unroll
  for (int kt = 0; kt < 16; ++kt)
#pragma unroll
    for (int e = 0; e < 4; ++e) { const float pv = __expf(s[kt][e] - mx); s[kt][e] = pv; sum += pv; }
  sum += __shfl_xor(sum, 16, 64); sum += __shfl_xor(sum, 32, 64);
  const float inv = 1.f / sum;
  f32x4 o[4];
#pragma unroll
  for (int mt = 0; mt < 4; ++mt) o[mt] = (f32x4){0.f, 0.f, 0.f, 0.f};
#pragma unroll
  for (int u = 0; u < 8; ++u) {
    const bf16x8 pb = pack8(s[2 * u], s[2 * u + 1]);
#pragma unroll
    for (int mt = 0; mt < 4; ++mt) {
      const bf16_t* vp = sVT + (16 * mt + fr) * vstride + kb + u * pitch + 4 * fq;
      o[mt] = MFMA16(ld4x2(vp, vp + 16), pb, o[mt]);
    }
  }
  const size_t orow = (size_t)(tok0 + fr) * 256 + h * 64 + 4 * fq, qrow = (size_t)(tok0 + fr) * 1024 + h * 64 + 4 * fq;
#pragma unroll
  for (int mt = 0; mt < 4; ++mt) {
    const uint2 z = *(const uint2*)(Z + orow + 16 * mt);
    uint2 w; w.x = pack2(o[mt][0] * inv * silu(bflo(z.x)), o[mt][1] * inv * silu(bfhi(z.x)));
    w.y = pack2(o[mt][2] * inv * silu(bflo(z.y)), o[mt][3] * inv * silu(bfhi(z.y)));
    *(uint2*)(Q + qrow + 16 * mt) = w;
  }
}
DI void na_block(const Params& p, int layer, int bt, char* smem, const int tid) {
  const int half = bt & 1, rg = (bt >> 1) & 31, h = (bt >> 6) & 3, seq = bt >> 8;
  const int r0 = rg * 4, rsmin = min(max(r0 - 4, 0), 120), nrows = min(11, 128 - rsmin), colbase = half ? 24 : 0;
  bf16_t* sK = (bf16_t*)smem; bf16_t* sVT = sK + 440 * 72; float* sBias = (float*)(sVT + 64 * 456);
  if (tid < 465) sBias[tid] = p.rpb[(size_t)(layer * 4 + h) * 465 + tid];
  const bf16_t* CK = (const bf16_t*)(p.ws + OFF_CK) + (size_t)(seq * 8192 + rsmin * 64 + colbase) * 256 + h * 64;
  const bf16_t* CVT = (const bf16_t*)(p.ws + OFF_CVT) + (size_t)(seq * 4 + h) * 64 * 8192 + rsmin * 64 + colbase;
  {
    const int nk = nrows * 40 * 8, per_dim = nrows * 5, nv = 64 * per_dim;
    uint4 rk[7], rv[7]; int dk[7], dv[7];
#pragma unroll
    for (int i = 0; i < 7; ++i) {
      const int idx = tid + NT * i;
      const int key = idx >> 3, ch = idx & 7, ri = key / 40, cj = key - ri * 40;
      dk[i] = idx < nk ? key * 72 + ch * 8 : -1;
      rk[i] = idx < nk ? *(const uint4*)(CK + (size_t)(ri * 64 + cj) * 256 + ch * 8) : make_uint4(0, 0, 0, 0);
      const int dim = idx / per_dim, rem = idx - dim * per_dim, r2 = rem / 5, c5 = rem - r2 * 5;
      dv[i] = idx < nv ? dim * 456 + r2 * 40 + c5 * 8 : -1;
      rv[i] = idx < nv ? *(const uint4*)(CVT + (size_t)dim * 8192 + r2 * 64 + c5 * 8) : make_uint4(0, 0, 0, 0);
    }
#pragma unroll
    for (int i = 0; i < 7; ++i) { if (dk[i] >= 0) *(uint4*)(sK + dk[i]) = rk[i]; if (dv[i] >= 0) *(uint4*)(sVT + dv[i]) = rv[i]; }
  }
  __syncthreads();
  {
    const int wave = tid >> 6, lane = tid & 63;
    const int r = r0 + (wave >> 1), c0 = 32 * half + 16 * (wave & 1);
    const int rs = min(max(r - 4, 0), 120), wsx = min(max(c0 - 8, 0), 32);
    attn_core<true>(p, layer, h, seq * 8192 + r * 64 + c0, r, c0, rs, wsx, sK, sVT, sBias, (rs - rsmin) * 40 + (wsx - colbase), 40, 456, lane);
  }
  __syncthreads();
}
DI void mem_block(const Params& p, int layer, int bt, char* smem, const int tid) {
  const int g = bt & 31, h = (bt >> 5) & 3, seq = bt >> 7;
  bf16_t* sK = (bf16_t*)smem; bf16_t* sVT = sK + 256 * 72;
  const bf16_t* Kg = (const bf16_t*)(p.ws + OFF_KMEM) + (size_t)((layer * 6 + seq) * 4 + h) * 256 * 64;
  const bf16_t* Vg = (const bf16_t*)(p.ws + OFF_VMEMT) + (size_t)((layer * 6 + seq) * 4 + h) * 64 * 256;
  {
    uint4 rk[4], rv[4];
#pragma unroll
    for (int i = 0; i < 4; ++i) { const int idx = tid + NT * i; rk[i] = *(const uint4*)(Kg + (size_t)idx * 8); rv[i] = *(const uint4*)(Vg + (size_t)idx * 8); }
#pragma unroll
    for (int i = 0; i < 4; ++i) { const int idx = tid + NT * i; *(uint4*)(sK + (idx >> 3) * 72 + (idx & 7) * 8) = rk[i]; *(uint4*)(sVT + (idx >> 5) * 264 + (idx & 31) * 8) = rv[i]; }
  }
  __syncthreads();
  {
    const int wave = tid >> 6, lane = tid & 63;
#pragma unroll 1
    for (int i = 0; i < 2; ++i) { int kb0 = 0; asm volatile("" : "+v"(kb0));
      attn_core<false>(p, layer, h, seq * 8192 + (g * 16 + wave * 2 + i) * 16, 0, 0, 0, 0, sK, sVT, nullptr, kb0, 32, 264, lane); }
  }
  __syncthreads();
}

DI void gdn_prep_tok8(const Params& p, int layer, int task, int lane) {
  const int tok0 = task * 8, seq = tok0 >> 13, l0 = tok0 & 8191;
  const bf16_t* X = (const bf16_t*)(p.ws + OFF_BQKV);
  const float* cw = p.conv_w + (size_t)layer * 5 * 768;
  unsigned kp[4][4];
#pragma unroll
  for (int i = 0; i < 3; ++i) {
    const int c = i * 256 + lane * 4;
    uint2 x[12];
#pragma unroll
    for (int jj = 0; jj < 12; ++jj) {
      const int ll = l0 + jj - 2;
      x[jj] = (ll >= 0 && ll < 8192) ? *(const uint2*)(X + (size_t)(tok0 + jj - 2) * 768 + c) : make_uint2(0u, 0u);
    }
    float4 w[5];
#pragma unroll
    for (int j = 0; j < 5; ++j) w[j] = *(const float4*)(cw + j * 768 + c);
    bf16_t* dst = (bf16_t*)(p.ws + (i == 0 ? OFF_QN : i == 1 ? OFF_KN : OFF_VN)) + (size_t)tok0 * 256 + lane * 4;
#pragma unroll
    for (int t = 0; t < 8; ++t) {
      float a0 = 0.f, a1 = 0.f, a2 = 0.f, a3 = 0.f;
#pragma unroll
      for (int j = 0; j < 5; ++j) { const uint2 xv = x[t + j]; a0 += w[j].x * bflo(xv.x); a1 += w[j].y * bfhi(xv.x); a2 += w[j].z * bflo(xv.y); a3 += w[j].w * bfhi(xv.y); }
      a0 = silu(a0); a1 = silu(a1); a2 = silu(a2); a3 = silu(a3);
      if (i < 2) {
        float ss = a0 * a0 + a1 * a1 + a2 * a2 + a3 * a3;
        ss += __shfl_xor(ss, 1, 64); ss += __shfl_xor(ss, 2, 64); ss += __shfl_xor(ss, 4, 64); ss += __shfl_xor(ss, 8, 64);
        const float rs = rsqrtf(ss + 1e-6f) * (i == 0 ? 0.125f : 1.f);
        a0 *= rs; a1 *= rs; a2 *= rs; a3 *= rs;
      }
      uint2 o; o.x = pack2(a0, a1); o.y = pack2(a2, a3);
      *(uint2*)(dst + (size_t)t * 256) = o;
      if (i == 1) {
        if (t & 1) { kp[0][t >> 1] |= (unsigned)f2bf(a0) << 16; kp[1][t >> 1] |= (unsigned)f2bf(a1) << 16; kp[2][t >> 1] |= (unsigned)f2bf(a2) << 16; kp[3][t >> 1] |= (unsigned)f2bf(a3) << 16; }
        else { kp[0][t >> 1] = f2bf(a0); kp[1][t >> 1] = f2bf(a1); kp[2][t >> 1] = f2bf(a2); kp[3][t >> 1] = f2bf(a3); }
      }
    }
  }
  bf16_t* kT = (bf16_t*)(p.ws + OFF_KT) + ((size_t)seq * 256 + lane * 4) * 8192 + l0;
#pragma unroll
  for (int e = 0; e < 4; ++e) *(uint4*)(kT + (size_t)e * 8192) = make_uint4(kp[e][0], kp[e][1], kp[e][2], kp[e][3]);
#pragma unroll
  for (int i2 = 0; i2 < 2; ++i2) {
    const int idx = lane + 64 * i2, gi = idx & 15;
    float* g = (float*)(p.ws + OFF_GATES) + (size_t)tok0 * 16 + idx;
    const float x = *g;
    float r;
    if (gi < 8) {
      const float y = x + p.dt_bias[layer * 8 + gi];
      const float sp = fmaxf(y, 0.f) + __logf(1.f + __expf(-fabsf(y)));
      r = -__expf(p.a_log[layer * 8 + gi]) * sp;
    } else r = __builtin_amdgcn_rcpf(1.f + __expf(-x));
    *g = r;
  }
}

DI void chunk_task(const Params& p, int bt, char* smem, const int tid) {
  const int n = bt & 127, head = (bt >> 7) & 3, seq = bt >> 9;
  const int lane = tid & 63, wave = tid >> 6, fr = lane & 15, fq = lane >> 4;
  float* sL = (float*)smem;
  float* sg = (float*)(smem + 32768);
  float* sbeta = sg + 128; float* sG = sbeta + 128;
  const float* gb = (const float*)(p.ws + OFF_GATES);
  const bf16_t* qn = (const bf16_t*)(p.ws + OFF_QN); const bf16_t* kn = (const bf16_t*)(p.ws + OFF_KN); const bf16_t* vn = (const bf16_t*)(p.ws + OFF_VN);
  const int tokbase = seq * 8192;
  if (tid < 128) {
    const int d = tid >> 6, r = tid & 63; const int pos = d ? 8191 - 64 * n - r : 64 * n + r;
    sg[tid] = gb[(size_t)(tokbase + pos) * 16 + d * 4 + head]; sbeta[tid] = gb[(size_t)(tokbase + pos) * 16 + 8 + d * 4 + head];
  }
  __syncthreads();
  if (tid < 128) {
    float a = sg[tid];
#pragma unroll
    for (int off = 1; off < 64; off <<= 1) { const float t = __shfl_up(a, off, 64); if (lane >= off) a += t; }
    sG[tid] = a;
  }
  __syncthreads();
  {
    const int d = wave >> 1;
    const int ct = ((seq * 4 + head) * 2 + d) * 128 + n;
    if ((wave & 1) == 0) {
      float* cv = (float*)(p.ws + OFF_CVEC) + (size_t)ct * 256;
      const float G = sG[d * 64 + lane], Gl = sG[d * 64 + 63];
      cv[lane] = __expf(G); cv[64 + lane] = __expf(Gl - G); if (lane == 0) cv[128] = __expf(Gl);
    }
    bf16_t* chqk = (bf16_t*)(p.ws + OFF_CHQK) + (size_t)ct * 4096;
    const int hoff = head * 64 + fq * 8;
    bf16x8 kB[4][2];
#pragma unroll
    for (int nt = 0; nt < 4; ++nt) {
      const int rB = 16 * nt + fr; const int posB = d ? 8191 - 64 * n - rB : 64 * n + rB;
      const size_t ob = (size_t)(tokbase + posB) * 256 + hoff;
      kB[nt][0] = ld8(kn + ob); kB[nt][1] = ld8(kn + ob + 32);
    }
    bf16x8 kA[2][2], qA[2][2];
#pragma unroll
    for (int si = 0; si < 2; ++si) {
      const int rA = 16 * (2 * (wave & 1) + si) + fr; const int posA = d ? 8191 - 64 * n - rA : 64 * n + rA;
      const size_t oa = (size_t)(tokbase + posA) * 256 + hoff;
      kA[si][0] = ld8(kn + oa); kA[si][1] = ld8(kn + oa + 32); qA[si][0] = ld8(qn + oa); qA[si][1] = ld8(qn + oa + 32);
    }
#pragma unroll
    for (int si = 0; si < 2; ++si) {
      const int strip = 2 * (wave & 1) + si;
#pragma unroll
      for (int nt = 0; nt < 4; ++nt) {
        f32x4 kk = (f32x4){0.f, 0.f, 0.f, 0.f}, qk = (f32x4){0.f, 0.f, 0.f, 0.f};
        kk = MFMA16(kA[si][0], kB[nt][0], kk); kk = MFMA16(kA[si][1], kB[nt][1], kk);
        qk = MFMA16(qA[si][0], kB[nt][0], qk); qk = MFMA16(qA[si][1], kB[nt][1], qk);
        const int sc = 16 * nt + fr;
#pragma unroll
        for (int e = 0; e < 4; ++e) {
          const int r = 16 * strip + 4 * fq + e;
          const float dec = sc <= r ? __expf(sG[d * 64 + r] - sG[d * 64 + sc]) : 0.f;
          sL[d * 4096 + r * 64 + sc] = sc < r ? sbeta[d * 64 + r] * kk[e] * dec : 0.f;
          chqk[r * 64 + sc] = f2bf(qk[e] * dec);
        }
      }
    }
  }
  __syncthreads();
  {
    const int wvu = __builtin_amdgcn_readfirstlane(wave);
    const int d = wvu >> 1, half = wvu & 1;
    const int ct = ((seq * 4 + head) * 2 + d) * 128 + n;
    const bf16_t* src = (half ? kn : vn) + (size_t)(tokbase + (d ? 8191 - 64 * n : 64 * n)) * 256 + head * 64 + lane;
    const int rstep = d ? -256 : 256;
    float sol[64];
#pragma unroll
    for (int r = 0; r < 64; ++r) sol[r] = bf2f(src[r * rstep]);
#pragma unroll
    for (int r4 = 0; r4 < 16; ++r4) {
      const float4 b4 = *(const float4*)(sbeta + d * 64 + 4 * r4); const float4 g4 = *(const float4*)(sG + d * 64 + 4 * r4);
      sol[4 * r4 + 0] *= half ? b4.x * __expf(g4.x) : b4.x; sol[4 * r4 + 1] *= half ? b4.y * __expf(g4.y) : b4.y;
      sol[4 * r4 + 2] *= half ? b4.z * __expf(g4.z) : b4.z; sol[4 * r4 + 3] *= half ? b4.w * __expf(g4.w) : b4.w;
    }
    const float* Ld = sL + d * 4096;
#pragma unroll
    for (int b = 0; b < 4; ++b) {
#pragma unroll
      for (int j4 = 0; j4 < 4 * b; ++j4) {
        float4 lv[16];
#pragma unroll
        for (int q = 0; q < 16; ++q) lv[q] = *(const float4*)(Ld + (16 * b + q) * 64 + 4 * j4);
#pragma unroll
        for (int q = 0; q < 16; ++q) {
          float a = sol[16 * b + q];
          a -= lv[q].x * sol[4 * j4 + 0]; a -= lv[q].y * sol[4 * j4 + 1]; a -= lv[q].z * sol[4 * j4 + 2]; a -= lv[q].w * sol[4 * j4 + 3];
          sol[16 * b + q] = a;
        }
      }
#pragma unroll
      for (int g4 = 0; g4 < 4; ++g4) {
        float4 lv[16];
#pragma unroll
        for (int q = 4 * g4 + 1; q < 16; ++q) lv[q] = *(const float4*)(Ld + (16 * b + q) * 64 + 16 * b + 4 * g4);
        sol[16 * b + 4 * g4 + 1] -= lv[4 * g4 + 1].x * sol[16 * b + 4 * g4];
        sol[16 * b + 4 * g4 + 2] -= lv[4 * g4 + 2].x * sol[16 * b + 4 * g4] + lv[4 * g4 + 2].y * sol[16 * b + 4 * g4 + 1];
        sol[16 * b + 4 * g4 + 3] -= lv[4 * g4 + 3].x * sol[16 * b + 4 * g4] + lv[4 * g4 + 3].y * sol[16 * b + 4 * g4 + 1] + lv[4 * g4 + 3].z * sol[16 * b + 4 * g4 + 2];
#pragma unroll
        for (int q = 4 * g4 + 4; q < 16; ++q) {
          float a = sol[16 * b + q];
          a -= lv[q].x * sol[16 * b + 4 * g4 + 0]; a -= lv[q].y * sol[16 * b + 4 * g4 + 1]; a -= lv[q].z * sol[16 * b + 4 * g4 + 2]; a -= lv[q].w * sol[16 * b + 4 * g4 + 3];
          sol[16 * b + q] = a;
        }
      }
    }
    if (!half) {
      bf16_t* chu = (bf16_t*)(p.ws + OFF_CHU) + (size_t)ct * 4096 + lane * 64;
#pragma unroll
      for (int r8 = 0; r8 < 8; ++r8) {
        uint4 o; o.x = pack2(sol[r8 * 8 + 0], sol[r8 * 8 + 1]); o.y = pack2(sol[r8 * 8 + 2], sol[r8 * 8 + 3]);
        o.z = pack2(sol[r8 * 8 + 4], sol[r8 * 8 + 5]); o.w = pack2(sol[r8 * 8 + 6], sol[r8 * 8 + 7]);
        *(uint4*)(chu + r8 * 8) = o;
      }
    } else {
      bf16_t* chw = (bf16_t*)(p.ws + OFF_CHW) + (size_t)ct * 4096 + lane;
#pragma unroll
      for (int r = 0; r < 64; ++r) chw[r * 64] = f2bf(sol[r]);
    }
  }
  __syncthreads();
}

DI uint4 rev8(uint4 v) {
  uint4 r;
  r.x = (v.w >> 16) | (v.w << 16); r.y = (v.z >> 16) | (v.z << 16); r.z = (v.y >> 16) | (v.y << 16); r.w = (v.x >> 16) | (v.x << 16);
  return r;
}
DI void scan_task(const Params& p, int task, char* smem, const int tid) {
  const int d = task & 1, head = (task >> 1) & 3, seq = task >> 3;
  const bool loader = tid >= 256;
  const int lt = tid & 255, lane = tid & 63, wave = lt >> 6, fr = lane & 15, fq = lane >> 4;
  const int row0 = lt >> 3, c8 = (lt & 7) * 8, rc8 = (7 - (lt & 7)) * 8;
  constexpr int BUFB = 49152;
  const int ctb = ((seq * 4 + head) * 2 + d) * 128;
  const bf16_t* chw = (const bf16_t*)(p.ws + OFF_CHW); const bf16_t* chu = (const bf16_t*)(p.ws + OFF_CHU); const bf16_t* chqk = (const bf16_t*)(p.ws + OFF_CHQK);
  const float* cvec = (const float*)(p.ws + OFF_CVEC);
  const bf16_t* qn = (const bf16_t*)(p.ws + OFF_QN) + (size_t)seq * 8192 * 256 + head * 64;
  const bf16_t* kT = (const bf16_t*)(p.ws + OFF_KT) + (size_t)(seq * 256 + head * 64) * 8192;
  bf16_t* O = (bf16_t*)(p.ws + (d ? OFF_OB : OFF_OF)) + (size_t)seq * 8192 * 256 + head * 64 + 32 * (wave & 1) + fr;
#define SCAN_STAGE(n_, buf_) do { \
    const size_t cb = (size_t)(ctb + (n_)) * 4096 + row0 * 64 + c8; \
    const uint4 rw0 = *(const uint4*)(chw + cb), rw1 = *(const uint4*)(chw + cb + 2048); \
    const uint4 rqk0 = *(const uint4*)(chqk + cb), rqk1 = *(const uint4*)(chqk + cb + 2048); \
    const uint4 ru0 = *(const uint4*)(chu + cb), ru1 = *(const uint4*)(chu + cb + 2048); \
    const int pos0 = d ? 8191 - 64 * (n_) - row0 : 64 * (n_) + row0, pos1 = d ? pos0 - 32 : pos0 + 32; \
    const uint4 rq0 = *(const uint4*)(qn + (size_t)pos0 * 256 + c8), rq1 = *(const uint4*)(qn + (size_t)pos1 * 256 + c8); \
    const int lbase = d ? 8191 - 64 * (n_) - 63 : 64 * (n_); \
    const uint4 rkt0 = *(const uint4*)(kT + (size_t)row0 * 8192 + lbase + c8), rkt1 = *(const uint4*)(kT + (size_t)(row0 + 32) * 8192 + lbase + c8); \
    const float rv = cvec[(size_t)(ctb + (n_)) * 256 + (lt < 129 ? lt : 128)]; \
    bf16_t* sW_ = (bf16_t*)(smem + (buf_) * BUFB); bf16_t* sQK_ = sW_ + 64 * 72; bf16_t* sQ_ = sQK_ + 64 * 72; bf16_t* sKT_ = sQ_ + 64 * 72; bf16_t* sU_ = sKT_ + 64 * 72; \
    float* sV_ = (float*)(smem + (buf_) * BUFB + 5 * 64 * 72 * 2); \
    *(uint4*)(sW_ + row0 * 72 + c8) = rw0; *(uint4*)(sW_ + (row0 + 32) * 72 + c8) = rw1; \
    *(uint4*)(sQK_ + row0 * 72 + c8) = rqk0; *(uint4*)(sQK_ + (row0 + 32) * 72 + c8) = rqk1; \
    *(uint4*)(sU_ + row0 * 72 + c8) = ru0; *(uint4*)(sU_ + (row0 + 32) * 72 + c8) = ru1; \
    *(uint4*)(sQ_ + row0 * 72 + c8) = rq0; *(uint4*)(sQ_ + (row0 + 32) * 72 + c8) = rq1; \
    if (d) { *(uint4*)(sKT_ + row0 * 72 + rc8) = rev8(rkt0); *(uint4*)(sKT_ + (row0 + 32) * 72 + rc8) = rev8(rkt1); } \
    else { *(uint4*)(sKT_ + row0 * 72 + c8) = rkt0; *(uint4*)(sKT_ + (row0 + 32) * 72 + c8) = rkt1; } \
    if (lt < 129) sV_[lt] = rv; } while (0)
#define SCAN_BAR() do { asm volatile("s_waitcnt lgkmcnt(0)" ::: "memory"); __builtin_amdgcn_s_barrier(); asm volatile("" ::: "memory"); } while (0)
  f32x4 S[4][2];
#pragma unroll
  for (int mt = 0; mt < 4; ++mt) { S[mt][0] = (f32x4){0.f, 0.f, 0.f, 0.f}; S[mt][1] = (f32x4){0.f, 0.f, 0.f, 0.f}; }
#define SCAN_LDF(f_, base_, h2_) do { _Pragma("unroll") for (int m2 = 0; m2 < 2; ++m2) { const bf16_t* p_ = (base_) + (16 * (2 * (h2_) + m2) + fr) * 72 + 4 * fq; \
    f_[m2][0] = ld4x2(p_, p_ + 16); f_[m2][1] = ld4x2(p_ + 32, p_ + 48); } } while (0)
#define SCAN_SB() __builtin_amdgcn_sched_barrier(0)
#define SCAN_COMPUTE(n_, buf_) do { \
    const bf16_t* sW = (const bf16_t*)(smem + (buf_) * BUFB); const bf16_t* sQK = sW + 64 * 72; const bf16_t* sQ = sQK + 64 * 72; const bf16_t* sKT = sQ + 64 * 72; const bf16_t* sU = sKT + 64 * 72; \
    const float* sV = (const float*)(smem + (buf_) * BUFB + 5 * 64 * 72 * 2); \
    bf16x8 fA[2][2], fB[2][2]; \
    SCAN_LDF(fA, sW, 0); SCAN_SB(); \
    bf16x8 Sb[2][2]; \
    _Pragma("unroll") for (int nt = 0; nt < 2; ++nt) { Sb[0][nt] = pack8(S[0][nt], S[1][nt]); Sb[1][nt] = pack8(S[2][nt], S[3][nt]); } \
    f32x4 v[4][2], o[4][2]; \
      \
    SCAN_LDF(fB, sW, 1); \
    _Pragma("unroll") for (int m2 = 0; m2 < 2; ++m2) _Pragma("unroll") for (int nt = 0; nt < 2; ++nt) { \
      v[m2][nt] = MFMA16(fA[m2][0], Sb[0][nt], ((f32x4){0.f, 0.f, 0.f, 0.f})); v[m2][nt] = MFMA16(fA[m2][1], Sb[1][nt], v[m2][nt]); } \
    SCAN_SB(); \
    SCAN_LDF(fA, sQ, 0); \
    _Pragma("unroll") for (int m2 = 0; m2 < 2; ++m2) _Pragma("unroll") for (int nt = 0; nt < 2; ++nt) { \
      v[2 + m2][nt] = MFMA16(fB[m2][0], Sb[0][nt], ((f32x4){0.f, 0.f, 0.f, 0.f})); v[2 + m2][nt] = MFMA16(fB[m2][1], Sb[1][nt], v[2 + m2][nt]); } \
    SCAN_SB(); \
    SCAN_LDF(fB, sQ, 1); \
    _Pragma("unroll") for (int m2 = 0; m2 < 2; ++m2) _Pragma("unroll") for (int nt = 0; nt < 2; ++nt) { \
      o[m2][nt] = MFMA16(fA[m2][0], Sb[0][nt], ((f32x4){0.f, 0.f, 0.f, 0.f})); o[m2][nt] = MFMA16(fA[m2][1], Sb[1][nt], o[m2][nt]); } \
    SCAN_SB(); \
    SCAN_LDF(fA, sKT, 0); \
    _Pragma("unroll") for (int m2 = 0; m2 < 2; ++m2) _Pragma("unroll") for (int nt = 0; nt < 2; ++nt) { \
      o[2 + m2][nt] = MFMA16(fB[m2][0], Sb[0][nt], ((f32x4){0.f, 0.f, 0.f, 0.f})); o[2 + m2][nt] = MFMA16(fB[m2][1], Sb[1][nt], o[2 + m2][nt]); } \
    SCAN_SB(); \
    bf16x8 Vb[2][2], Vkb[2][2]; \
    {   \
      _Pragma("unroll") for (int mt = 0; mt < 4; ++mt) { \
        const float4 eg = *(const float4*)(sV + 16 * mt + 4 * fq); \
        _Pragma("unroll") for (int nt = 0; nt < 2; ++nt) { \
          const uint2 u = *(const uint2*)(sU + (32 * wave + 16 * nt + fr) * 72 + 16 * mt + 4 * fq); \
          v[mt][nt][0] = bflo(u.x) - v[mt][nt][0]; v[mt][nt][1] = bfhi(u.x) - v[mt][nt][1]; v[mt][nt][2] = bflo(u.y) - v[mt][nt][2]; v[mt][nt][3] = bfhi(u.y) - v[mt][nt][3]; \
          o[mt][nt][0] *= eg.x; o[mt][nt][1] *= eg.y; o[mt][nt][2] *= eg.z; o[mt][nt][3] *= eg.w; } \
      } \
      _Pragma("unroll") for (int nt = 0; nt < 2; ++nt) { \
        Vb[0][nt] = pack8(v[0][nt], v[1][nt]); Vb[1][nt] = pack8(v[2][nt], v[3][nt]); } \
      _Pragma("unroll") for (int mt = 0; mt < 4; ++mt) { \
        const float4 ek = *(const float4*)(sV + 64 + 16 * mt + 4 * fq); \
        _Pragma("unroll") for (int nt = 0; nt < 2; ++nt) { v[mt][nt][0] *= ek.x; v[mt][nt][1] *= ek.y; v[mt][nt][2] *= ek.z; v[mt][nt][3] *= ek.w; } } \
      _Pragma("unroll") for (int nt = 0; nt < 2; ++nt) { \
        Vkb[0][nt] = pack8(v[0][nt], v[1][nt]); Vkb[1][nt] = pack8(v[2][nt], v[3][nt]); } \
    } \
    const float gl = sV[128]; \
    SCAN_SB(); \
    SCAN_LDF(fB, sKT, 1); \
    _Pragma("unroll") for (int m2 = 0; m2 < 2; ++m2) _Pragma("unroll") for (int nt = 0; nt < 2; ++nt) { \
      f32x4 a; a[0] = S[m2][nt][0] * gl; a[1] = S[m2][nt][1] * gl; a[2] = S[m2][nt][2] * gl; a[3] = S[m2][nt][3] * gl; \
      a = MFMA16(fA[m2][0], Vkb[0][nt], a); S[m2][nt] = MFMA16(fA[m2][1], Vkb[1][nt], a); } \
    SCAN_SB(); \
    SCAN_LDF(fA, sQK, 0); \
    _Pragma("unroll") for (int m2 = 0; m2 < 2; ++m2) _Pragma("unroll") for (int nt = 0; nt < 2; ++nt) { \
      f32x4 a; a[0] = S[2 + m2][nt][0] * gl; a[1] = S[2 + m2][nt][1] * gl; a[2] = S[2 + m2][nt][2] * gl; a[3] = S[2 + m2][nt][3] * gl; \
      a = MFMA16(fB[m2][0], Vkb[0][nt], a); S[2 + m2][nt] = MFMA16(fB[m2][1], Vkb[1][nt], a); } \
    SCAN_SB(); \
    SCAN_LDF(fB, sQK, 1); \
    _Pragma("unroll") for (int m2 = 0; m2 < 2; ++m2) _Pragma("unroll") for (int nt = 0; nt < 2; ++nt) { \
      o[m2][nt] = MFMA16(fA[m2][0], Vb[0][nt], o[m2][nt]); o[m2][nt] = MFMA16(fA[m2][1], Vb[1][nt], o[m2][nt]); } \
    SCAN_SB(); \
    _Pragma("unroll") for (int m2 = 0; m2 < 2; ++m2) _Pragma("unroll") for (int nt = 0; nt < 2; ++nt) { \
      o[2 + m2][nt] = MFMA16(fB[m2][0], Vb[0][nt], o[2 + m2][nt]); o[2 + m2][nt] = MFMA16(fB[m2][1], Vb[1][nt], o[2 + m2][nt]); } \
    _Pragma("unroll") for (int mt = 0; mt < 4; ++mt) _Pragma("unroll") for (int e = 0; e < 4; ++e) { \
      const int r_ = 16 * mt + 4 * fq + e; const int pos = d ? 8191 - 64 * (n_) - r_ : 64 * (n_) + r_; \
      O[(size_t)pos * 256] = f2bf(o[mt][0][e]); O[(size_t)pos * 256 + 16] = f2bf(o[mt][1][e]); \
    } } while (0)
  __syncthreads();
  if (loader) SCAN_STAGE(0, 0);
  SCAN_BAR();
#pragma unroll 1
  for (int n = 0; n < 128; ++n) {
    if (loader) { if (n + 1 < 128) SCAN_STAGE(n + 1, ((n + 1) & 1)); }
    else if (wave < 2) SCAN_COMPUTE(n, (n & 1));
    SCAN_BAR();
  }
  asm volatile("s_waitcnt vmcnt(0)" ::: "memory");
  __syncthreads();
#undef SCAN_STAGE
#undef SCAN_BAR
#undef SCAN_COMPUTE
#undef SCAN_LDF
#undef SCAN_SB
}

DI void gdn_finish_tok4(const Params& p, int layer, int tok0, int lane) {
  const float4 g = *(const float4*)(p.gdn_g + layer * 64 + (lane & 15) * 4);
  uint2 a[4], b[4], z[4];
#pragma unroll
  for (int t = 0; t < 4; ++t) {
    const size_t ro = (size_t)(tok0 + t) * 256 + lane * 4;
    a[t] = *(const uint2*)((const bf16_t*)(p.ws + OFF_OF) + ro); b[t] = *(const uint2*)((const bf16_t*)(p.ws + OFF_OB) + ro);
    z[t] = *(const uint2*)((const bf16_t*)(p.ws + OFF_MIX) + (size_t)(tok0 + t) * 1024 + 256 + lane * 4);
  }
#pragma unroll
  for (int t = 0; t < 4; ++t) {
    const float o0 = bflo(a[t].x) + bflo(b[t].x), o1 = bfhi(a[t].x) + bfhi(b[t].x), o2 = bflo(a[t].y) + bflo(b[t].y), o3 = bfhi(a[t].y) + bfhi(b[t].y);
    float ss = o0 * o0 + o1 * o1 + o2 * o2 + o3 * o3;
    ss += __shfl_xor(ss, 1, 64); ss += __shfl_xor(ss, 2, 64); ss += __shfl_xor(ss, 4, 64); ss += __shfl_xor(ss, 8, 64);
    const float rs = rsqrtf(ss * (1.f / 64.f) + 1e-6f);
    uint2 w; w.x = pack2(o0 * rs * g.x * silu(bflo(z[t].x)), o1 * rs * g.y * silu(bfhi(z[t].x)));
    w.y = pack2(o2 * rs * g.z * silu(bflo(z[t].y)), o3 * rs * g.w * silu(bfhi(z[t].y)));
    *(uint2*)((bf16_t*)(p.ws + OFF_MIX) + (size_t)(tok0 + t) * 1024 + 256 + lane * 4) = w;
  }
}

DI void post_token2(const Params& p, int layer, int tok0, int lane) {
  const float* pg = p.post_g + layer * 1024;
  uint2 ob[2][4]; float4 xr[2][4], g[4];
#pragma unroll
  for (int t = 0; t < 2; ++t) {
    const bf16_t* o = (const bf16_t*)(p.ws + OFF_OUTTMP) + (size_t)(tok0 + t) * 1024;
    const float* xp = layer == 0 ? xrow(p, tok0 + t) : p.out + (size_t)(tok0 + t) * 1024;
#pragma unroll
    for (int i = 0; i < 4; ++i) { ob[t][i] = *(const uint2*)(o + i * 256 + lane * 4); xr[t][i] = *(const float4*)(xp + i * 256 + lane * 4); }
  }
#pragma unroll
  for (int i = 0; i < 4; ++i) g[i] = *(const float4*)(pg + i * 256 + lane * 4);
#pragma unroll
  for (int t = 0; t < 2; ++t) {
    float4 v[4]; float ss = 0.f;
#pragma unroll
    for (int i = 0; i < 4; ++i) { const uint2 u = ob[t][i]; v[i] = make_float4(bflo(u.x), bfhi(u.x), bflo(u.y), bfhi(u.y));
      ss += v[i].x * v[i].x + v[i].y * v[i].y + v[i].z * v[i].z + v[i].w * v[i].w; }
    ss = wave_sum(ss);
    const float rs = rsqrtf(ss * (1.f / 1024.f) + 1e-6f);
    float ss2 = 0.f;
#pragma unroll
    for (int i = 0; i < 4; ++i) {
      const float4 x = xr[t][i];
      v[i].x = x.x + v[i].x * rs * g[i].x; v[i].y = x.y + v[i].y * rs * g[i].y; v[i].z = x.z + v[i].z * rs * g[i].z; v[i].w = x.w + v[i].w * rs * g[i].w;
      ss2 += v[i].x * v[i].x + v[i].y * v[i].y + v[i].z * v[i].z + v[i].w * v[i].w;
      *(float4*)(p.out + (size_t)(tok0 + t) * 1024 + i * 256 + lane * 4) = v[i];
    }
    if (layer == 0) {
      ss2 = wave_sum(ss2);
      const float rs2 = rsqrtf(ss2 * (1.f / 1024.f) + 1e-6f);
      bf16_t* dst = (bf16_t*)(p.ws + OFF_X) + (size_t)(tok0 + t) * 1024;
#pragma unroll
      for (int i = 0; i < 4; ++i) { uint2 w; w.x = pack2(v[i].x * rs2, v[i].y * rs2); w.y = pack2(v[i].z * rs2, v[i].w * rs2); *(uint2*)(dst + i * 256 + lane * 4) = w; }
    }
  }
}

#define XB_TMO      128
#define XB_XCNT(j)  (256  + 64 * (j))
#define XB_XSUB(j)  (1280 + 64 * (j))
#define XB_XGEN(j)  (2304 + 64 * (j))
#define XB_TOP      3328
#define XB_TOPGEN   3392
#define XCD_BAR_WORDS 3456
#define XB_SPIN_CAP (1u << 18)
#define XLAS __attribute__((address_space(3)))

__device__ __forceinline__ unsigned xb_ld(unsigned* p)              { return __hip_atomic_load(p, __ATOMIC_RELAXED, __HIP_MEMORY_SCOPE_AGENT); }
__device__ __forceinline__ unsigned xb_add(unsigned* p, unsigned v) { return __hip_atomic_fetch_add(p, v, __ATOMIC_RELAXED, __HIP_MEMORY_SCOPE_AGENT); }
__device__ __forceinline__ unsigned xb_xcc_id() { return (unsigned)__builtin_amdgcn_s_getreg((3 << 11) | 20) & 0xFu; }
#define XB_SPIN(cond, bar) do { unsigned _sp = 0; while (cond) { __builtin_amdgcn_s_sleep(1); \
    if ((++_sp & 255u) == 0u) { if (xb_ld(&(bar)[XB_TMO])) break; if (_sp > XB_SPIN_CAP) { atomicAdd(&(bar)[XB_TMO], 1u); break; } } } } while (0)

struct XcdBarrier {
    unsigned* bar; unsigned x;
    volatile XLAS unsigned* st;
};

__device__ __forceinline__ XcdBarrier xcd_barrier_post(unsigned* bar, volatile XLAS unsigned* st) {
    XcdBarrier b; b.bar = bar; b.x = xb_xcc_id(); b.st = st;
    if (threadIdx.x == 0) (void)xb_add(&bar[XB_XCNT(b.x)], 1u);
    return b;
}
__device__ __forceinline__ void xcd_barrier_complete(unsigned* bar, unsigned x, unsigned& nloc, unsigned& nx) {
    const unsigned G = gridDim.x * gridDim.y * gridDim.z;
    unsigned sum, cnt, mine, sp = 0u;
    for (;;) {
        sum = 0u; cnt = 0u; mine = 0u;
#pragma unroll
        for (unsigned j = 0; j < 16; ++j) { const unsigned c = xb_ld(&bar[XB_XCNT(j)]); sum += c; cnt += (c > 0u) ? 1u : 0u; mine = (j == x) ? c : mine; }
        if (sum == G) break;
        __builtin_amdgcn_s_sleep(1);
        if ((++sp & 255u) == 0u) { if (xb_ld(&bar[XB_TMO])) break; if (sp > XB_SPIN_CAP) { atomicAdd(&bar[XB_TMO], 1u); break; } }
    }
    nloc = mine > 0u ? mine : 1u; nx = cnt > 0u ? cnt : 1u;
}

__device__ __forceinline__ void xcd_barrier(const XcdBarrier& b) {
    asm volatile("s_waitcnt vmcnt(0)" ::: "memory");
    __syncthreads();
    if (threadIdx.x == 0) {
        unsigned* bar = b.bar;
        __builtin_amdgcn_s_waitcnt(0);
        unsigned nloc = b.st[0], nx = b.st[1];
        if (nloc == 0u) { xcd_barrier_complete(bar, b.x, nloc, nx); b.st[0] = nloc; b.st[1] = nx; }
        const unsigned old = xb_add(&bar[XB_XSUB(b.x)], 1u);
        const unsigned gen = old / nloc;
        if (old + 1u == (gen + 1u) * nloc) {
            __builtin_amdgcn_fence(__ATOMIC_RELEASE, "agent");
            asm volatile("s_waitcnt vmcnt(0)" ::: "memory");
            const unsigned og = xb_add(&bar[XB_TOP], 1u);
            const unsigned tg = og / nx;
            if (og + 1u == (tg + 1u) * nx) xb_add(&bar[XB_TOPGEN], 1u);
            else XB_SPIN(xb_ld(&bar[XB_TOPGEN]) == tg, bar);
            __builtin_amdgcn_fence(__ATOMIC_ACQUIRE, "agent");
            xb_add(&bar[XB_XGEN(b.x)], 1u);
            asm volatile("s_waitcnt vmcnt(0)" ::: "memory");
        } else {
            XB_SPIN(xb_ld(&bar[XB_XGEN(b.x)]) == gen, bar);
            __builtin_amdgcn_fence(__ATOMIC_ACQUIRE, "agent");
            asm volatile("s_waitcnt vmcnt(0)" ::: "memory");
        }
    }
    __syncthreads();
}

constexpr int LDS_BYTES = 131072;
__global__ void __launch_bounds__(NT, 2) fwd_megakernel(Params p0) {
  cg::grid_group grid = cg::this_grid();
  extern __shared__ __attribute__((aligned(16))) unsigned char shm[];
  char* smem = (char*)shm;
  PG8_LAS unsigned char* lds = (PG8_LAS unsigned char*)shm;
  const int nb = gridDim.x, bid = blockIdx.x, nw = gridDim.x * (NT / 64);
  __shared__ __attribute__((aligned(16))) unsigned xb_st[4];
  if (threadIdx.x < 4) xb_st[threadIdx.x] = 0u;
  __syncthreads();
  const XcdBarrier xbar = xcd_barrier_post((unsigned*)(p0.ws + OFF_BAR), (volatile XLAS unsigned*)xb_st);
#define GSYNC() xcd_barrier(xbar)
#define PH_BEGIN const Params p = launder(p0); const int tid = ltid(); const int lane = tid & 63; const int gw = bid * (NT / 64) + (tid >> 6); (void)lane; (void)gw;
  { PH_BEGIN phase0(p, tid); }
  grid.sync();
#pragma unroll 1
  for (int layer = 0; layer < 2; ++layer) {
    {
      PH_BEGIN
      InProjEpi epi{p.ws};
      run_gemm(lds, (const bf16_t*)(p.ws + OFF_X), (const bf16_t*)(p.ws + OFF_WIN) + (size_t)layer * NPAD * 1024, NTOK, NPAD, 1024, epi, tid);
    }
    if (layer == 0 && bid >= 192 && bid < 216) {
      PH_BEGIN
      const int l2 = (bid - 192) / 12, c = (bid - 192) - 12 * l2;
      MemKvEpi me{p.ws, l2};
      run_gemm_on(lds, (const bf16_t*)(p.ws + OFF_MEMN), (const bf16_t*)(p.ws + OFF_WMEM) + (size_t)l2 * 512 * 1024, 1536, 512, 1024, me, tid, 12, c);
    }
    GSYNC();
    { PH_BEGIN
#pragma unroll 1
      for (int t = bid; t < 1536; t += nb) na_block(p, layer, t, smem, tid); }
    { PH_BEGIN
#pragma unroll 1
      for (int t = gw; t < NTOK / 8; t += nw) gdn_prep_tok8(p, layer, t, lane); }
    GSYNC();
    { PH_BEGIN
      const int half = tid >> 8;
#pragma unroll 1
      for (int t = bid; t < 1536; t += nb) chunk_task(p, 2 * t + half, smem + half * 36864, tid & 255); }
    GSYNC();
    if (bid < 48) { PH_BEGIN scan_task(p, bid, smem, tid); }
    else { PH_BEGIN
#pragma unroll 1
      for (int t = bid - 48; t < 768; t += nb - 48) fft_task(p, t, (float2*)smem, tid);
#pragma unroll 1
      for (int t = bid - 48; t < 768; t += nb - 48) mem_block(p, layer, t, smem, tid); }
    GSYNC();
    { PH_BEGIN
#pragma unroll 1
      for (int t = gw; t < NTOK / 4; t += nw) gdn_finish_tok4(p, layer, 4 * t, lane); }
    {
      PH_BEGIN
      FnetEpi fe{p.ws};
      run_gemm(lds, (const bf16_t*)(p.ws + OFF_H), (const bf16_t*)(p.ws + OFF_WF) + (size_t)layer * 256 * 512, NTOK, 256, 512, fe, tid);
    }
    GSYNC();
    {
      PH_BEGIN
      OutEpi oe{(bf16_t*)(p.ws + OFF_OUTTMP)};
      run_gemm(lds, (const bf16_t*)(p.ws + OFF_MIX), (const bf16_t*)(p.ws + OFF_WOUT) + (size_t)layer * 1024 * 1024, NTOK, 1024, 1024, oe, tid);
    }
    GSYNC();
    { PH_BEGIN
#pragma unroll 1
      for (int t = gw; t < NTOK / 2; t += nw) post_token2(p, layer, 2 * t, lane); }
    if (layer == 0) GSYNC();
  }
}

extern "C" void kernel_launch(void* const* d_in, const int* in_sizes, int n_in, void* d_out, int out_size, void* d_ws, size_t ws_size, hipStream_t stream) {
  static int grid_blocks = 0;
  if (!grid_blocks) {
    int dev = 0, cus = 0, per_cu = 0;
    (void)hipGetDevice(&dev);
    (void)hipDeviceGetAttribute(&cus, hipDeviceAttributeMultiprocessorCount, dev);
    if (hipFuncSetAttribute((const void*)fwd_megakernel, hipFuncAttributeMaxDynamicSharedMemorySize, LDS_BYTES) != hipSuccess) fprintf(stderr, "hipFuncSetAttribute failed\n");
    (void)hipOccupancyMaxActiveBlocksPerMultiprocessor(&per_cu, fwd_megakernel, NT, LDS_BYTES);
    if (per_cu > 1) per_cu = 1;
    grid_blocks = cus * per_cu;
    if (grid_blocks <= 0) { fprintf(stderr, "occupancy query returned %d x %d\n", cus, per_cu); grid_blocks = -1; }
  }
  if (grid_blocks < 0) return;
  if (ws_size < WS_NEED || n_in != 16) { fprintf(stderr, "kernel_launch: need %zu bytes of workspace, got %zu (n_in %d)\n", (size_t)WS_NEED, ws_size, n_in); return; }
  Params p{};
  p.x_prompt = (const float*)d_in[0]; p.x_sample = (const float*)d_in[1]; p.mem_prompt = (const float*)d_in[2]; p.mem_sample = (const float*)d_in[3];
  p.pre_g = (const float*)d_in[4]; p.post_g = (const float*)d_in[5]; p.w_in = (const float*)d_in[6]; p.w_fnet = (const float*)d_in[7];
  p.conv_w = (const float*)d_in[8]; p.a_log = (const float*)d_in[9]; p.dt_bias = (const float*)d_in[10]; p.gdn_g = (const float*)d_in[11];
  p.rpb = (const float*)d_in[12]; p.mem_g = (const float*)d_in[13]; p.w_mem_kv = (const float*)d_in[14]; p.w_out = (const float*)d_in[15];
  p.out = (float*)d_out; p.ws = (unsigned char*)d_ws;
  if (hipMemsetAsync((unsigned char*)d_ws + OFF_BAR, 0, XCD_BAR_WORDS * sizeof(unsigned), stream) != hipSuccess) { fprintf(stderr, "memset failed\n"); return; }
  void* args[] = {&p};
  hipError_t e = hipLaunchCooperativeKernel((void*)fwd_megakernel, dim3(grid_blocks), dim3(NT), args, LDS_BYTES, stream);
  if (e != hipSuccess) fprintf(stderr, "cooperative launch failed: %s (grid %d)\n", hipGetErrorString(e), grid_blocks);
}
```

```cpp
#include <hip/hip_runtime.h>
#include <hip/hip_cooperative_groups.h>
#include <cstdio>
namespace cg = cooperative_groups;

typedef unsigned short bf16_t;
typedef short bf16x8 __attribute__((ext_vector_type(8)));
typedef float f32x4 __attribute__((ext_vector_type(4)));

#define NT 512
#define DI __device__ __forceinline__
#define MFMA16(a, b, c) __builtin_amdgcn_mfma_f32_16x16x32_bf16((a), (b), (c), 0, 0, 0)

constexpr int SEQL = 8192, NTOK = 49152;
constexpr size_t MiB = (size_t)1 << 20;
constexpr int NPAD = 3328;
constexpr size_t OFF_WIN = 0, OFF_WOUT = 13631488, OFF_WMEM = 17825792, OFF_WF = 19922944, OFF_MEMN = 20447232,
                 OFF_KMEM = 23592960, OFF_VMEMT = 25165824, OFF_TW = 26738688;
constexpr size_t OFF_MIX = 26 * MiB, OFF_AZ = 122 * MiB, OFF_CZ = 146 * MiB, OFF_DZ = 170 * MiB, OFF_GATES = 194 * MiB, OFF_X = 197 * MiB,
                 OFF_BQKV = 293 * MiB, OFF_CK = 365 * MiB, OFF_CVT = 389 * MiB;
constexpr size_t OFF_H = OFF_X, OFF_QN = 245 * MiB, OFF_KN = 269 * MiB, OFF_KT = 464 * MiB, OFF_VN = 488 * MiB;
constexpr size_t OFF_CHW = 293 * MiB, OFF_CHU = 341 * MiB, OFF_CHQK = 389 * MiB, OFF_CVEC = 437 * MiB;
constexpr size_t OFF_OF = OFF_KN, OFF_OB = OFF_VN, OFF_OUTTMP = 293 * MiB;
constexpr size_t OFF_BAR = 26771456;
constexpr size_t WS_NEED = 512 * MiB;

struct Params {
  const float* x_prompt; const float* x_sample; const float* mem_prompt; const float* mem_sample;
  const float* pre_g; const float* post_g; const float* w_in; const float* w_fnet; const float* conv_w;
  const float* a_log; const float* dt_bias; const float* gdn_g; const float* rpb; const float* mem_g;
  const float* w_mem_kv; const float* w_out;
  float* out; unsigned char* ws;
};

typedef float f32x2_t __attribute__((ext_vector_type(2)));
typedef __bf16 bf16x2_t __attribute__((ext_vector_type(2)));
DI unsigned pack2(float lo, float hi) { f32x2_t f = {lo, hi}; return __builtin_bit_cast(unsigned, __builtin_convertvector(f, bf16x2_t)); }
DI bf16_t f2bf(float x) { return (bf16_t)(pack2(x, 0.f) & 0xffffu); }
DI float bf2f(bf16_t h) { return __uint_as_float(((unsigned)h) << 16); }
DI float bflo(unsigned u) { return __uint_as_float(u << 16); }
DI float bfhi(unsigned u) { return __uint_as_float(u & 0xffff0000u); }
DI float wave_sum(float v) {
#pragma unroll
  for (int m = 32; m >= 1; m >>= 1) v += __shfl_xor(v, m, 64);
  return v;
}
DI float silu(float x) { return x * __builtin_amdgcn_rcpf(1.f + __expf(-x)); }
DI bf16x8 pack8(const f32x4& a, const f32x4& b) {
  uint4 u; u.x = pack2(a[0], a[1]); u.y = pack2(a[2], a[3]); u.z = pack2(b[0], b[1]); u.w = pack2(b[2], b[3]);
  return __builtin_bit_cast(bf16x8, u);
}
DI bf16x8 ld8(const bf16_t* p) { return *(const bf16x8*)p; }
DI bf16x8 ld4x2(const bf16_t* lo, const bf16_t* hi) {
  uint2 a = *(const uint2*)lo, b = *(const uint2*)hi; uint4 u; u.x = a.x; u.y = a.y; u.z = b.x; u.w = b.y;
  return __builtin_bit_cast(bf16x8, u);
}
DI int ltid() { int t = threadIdx.x; asm volatile("" : "+v"(t)); return t; }
DI Params launder(Params p) { size_t z = 0; asm volatile("" : "+s"(z)); p.ws = p.ws + z; return p; }
DI const float* xrow(const Params& p, int tok) {
  return tok < 32768 ? p.x_prompt + (size_t)tok * 1024 : p.x_sample + (size_t)(tok - 32768) * 1024;
}

DI void norm_row_bf16(const float* src, bf16_t* dst, int lane) {
  float4 v[4]; float ss = 0.f;
#pragma unroll
  for (int i = 0; i < 4; ++i) { v[i] = *(const float4*)(src + i * 256 + lane * 4); ss += v[i].x * v[i].x + v[i].y * v[i].y + v[i].z * v[i].z + v[i].w * v[i].w; }
  ss = wave_sum(ss);
  const float rs = rsqrtf(ss * (1.f / 1024.f) + 1e-6f);
#pragma unroll
  for (int i = 0; i < 4; ++i) { uint2 o; o.x = pack2(v[i].x * rs, v[i].y * rs); o.y = pack2(v[i].z * rs, v[i].w * rs); *(uint2*)(dst + i * 256 + lane * 4) = o; }
}

DI void phase0(const Params& p, const int tid) {
  const int gtid = blockIdx.x * NT + tid, gsz = gridDim.x * NT;
  bf16_t* WinT = (bf16_t*)(p.ws + OFF_WIN);
  for (int idx = gtid; idx < 2 * NPAD * 128; idx += gsz) {
    const int l = idx / (NPAD * 128); const int rem = idx - l * NPAD * 128; const int k8 = rem / NPAD; const int r = rem - k8 * NPAD;
    const int src = r < 1536 ? r : (r < 3072 ? r + 16 : (r < 3088 ? 1536 + (r - 3072) : -1));
    uint4 o = make_uint4(0, 0, 0, 0);
    if (src >= 0) {
      const float* w = p.w_in + ((size_t)l * 1024 + k8 * 8) * 3088 + src;
      const float* g = p.pre_g + l * 1024 + k8 * 8;
      float v[8];
#pragma unroll
      for (int j = 0; j < 8; ++j) v[j] = w[(size_t)j * 3088] * g[j];
      o.x = pack2(v[0], v[1]); o.y = pack2(v[2], v[3]); o.z = pack2(v[4], v[5]); o.w = pack2(v[6], v[7]);
    }
    *(uint4*)(WinT + ((size_t)l * NPAD + r) * 1024 + k8 * 8) = o;
  }
  bf16_t* WoutT = (bf16_t*)(p.ws + OFF_WOUT);
  for (int idx = gtid; idx < 2 * 1024 * 128; idx += gsz) {
    const int l = idx / (1024 * 128); const int rem = idx - l * 1024 * 128; const int k8 = rem / 1024; const int r = rem - k8 * 1024;
    const float* w = p.w_out + ((size_t)l * 1024 + k8 * 8) * 1024 + r;
    float v[8];
#pragma unroll
    for (int j = 0; j < 8; ++j) v[j] = w[(size_t)j * 1024];
    uint4 o; o.x = pack2(v[0], v[1]); o.y = pack2(v[2], v[3]); o.z = pack2(v[4], v[5]); o.w = pack2(v[6], v[7]);
    *(uint4*)(WoutT + ((size_t)l * 1024 + r) * 1024 + k8 * 8) = o;
  }
  bf16_t* WmemT = (bf16_t*)(p.ws + OFF_WMEM);
  for (int idx = gtid; idx < 2 * 512 * 128; idx += gsz) {
    const int l = idx / (512 * 128); const int rem = idx - l * 512 * 128; const int k8 = rem / 512; const int r = rem - k8 * 512;
    const float* w = p.w_mem_kv + ((size_t)l * 1024 + k8 * 8) * 512 + r;
    const float* g = p.mem_g + l * 1024 + k8 * 8;
    float v[8];
#pragma unroll
    for (int j = 0; j < 8; ++j) v[j] = w[(size_t)j * 512] * g[j];
    uint4 o; o.x = pack2(v[0], v[1]); o.y = pack2(v[2], v[3]); o.z = pack2(v[4], v[5]); o.w = pack2(v[6], v[7]);
    *(uint4*)(WmemT + ((size_t)l * 512 + r) * 1024 + k8 * 8) = o;
  }
  bf16_t* WfT = (bf16_t*)(p.ws + OFF_WF);
  const float fscale = 0.00138106793f;
  for (int idx = gtid; idx < 2 * 256 * 512; idx += gsz) {
    const int l = idx >> 17; const int rem = idx & 131071; const int kk = rem >> 8; const int j = rem & 255;
    const int k2 = kk & 255, blk = k2 >> 6, cp = k2 & 63;
    const float* w = p.w_fnet + ((size_t)l * 256 + blk * 64) * 256 + j;
    float a = 0.f;
    for (int c = 0; c < 64; ++c) {
      const float turns = (float)((c * cp) & 63) * (1.f / 64.f);
      const float tr = kk < 256 ? __builtin_amdgcn_cosf(turns) : __builtin_amdgcn_sinf(turns);
      a += tr * w[(size_t)c * 256];
    }
    WfT[((size_t)l * 256 + j) * 512 + kk] = f2bf(a * fscale);
  }
  float2* tw = (float2*)(p.ws + OFF_TW);
  for (int t = gtid; t < 4096; t += gsz) { float s, c; sincospif((float)t * (1.f / 4096.f), &s, &c); tw[t] = make_float2(c, -s); }
  const int lane = tid & 63, gw = blockIdx.x * (NT / 64) + (tid >> 6), nw = gridDim.x * (NT / 64);
  bf16_t* memn = (bf16_t*)(p.ws + OFF_MEMN);
  for (int r = gw; r < 1536; r += nw) {
    const float* src = r < 1024 ? p.mem_prompt + (size_t)r * 1024 : p.mem_sample + (size_t)(r - 1024) * 1024;
    norm_row_bf16(src, memn + (size_t)r * 1024, lane);
  }
  bf16_t* xn = (bf16_t*)(p.ws + OFF_X);
  for (int t = gw; t < NTOK / 2; t += nw) {
    const float* s0 = xrow(p, 2 * t); const float* s1 = xrow(p, 2 * t + 1);
    float4 v0[4], v1[4]; float a0 = 0.f, a1 = 0.f;
#pragma unroll
    for (int i = 0; i < 4; ++i) { v0[i] = *(const float4*)(s0 + i * 256 + lane * 4); v1[i] = *(const float4*)(s1 + i * 256 + lane * 4); }
#pragma unroll
    for (int i = 0; i < 4; ++i) { a0 += v0[i].x * v0[i].x + v0[i].y * v0[i].y + v0[i].z * v0[i].z + v0[i].w * v0[i].w; a1 += v1[i].x * v1[i].x + v1[i].y * v1[i].y + v1[i].z * v1[i].z + v1[i].w * v1[i].w; }
    a0 = wave_sum(a0); a1 = wave_sum(a1);
    const float r0 = rsqrtf(a0 * (1.f / 1024.f) + 1e-6f), r1 = rsqrtf(a1 * (1.f / 1024.f) + 1e-6f);
    bf16_t* d0 = xn + (size_t)(2 * t) * 1024; bf16_t* d1 = d0 + 1024;
#pragma unroll
    for (int i = 0; i < 4; ++i) {
      uint2 o; o.x = pack2(v0[i].x * r0, v0[i].y * r0); o.y = pack2(v0[i].z * r0, v0[i].w * r0); *(uint2*)(d0 + i * 256 + lane * 4) = o;
      o.x = pack2(v1[i].x * r1, v1[i].y * r1); o.y = pack2(v1[i].z * r1, v1[i].w * r1); *(uint2*)(d1 + i * 256 + lane * 4) = o;
    }
  }
}

namespace pg8 {
#define PG8_LAS __attribute__((address_space(3)))
typedef unsigned short bf16_t;
typedef short bf16x8 __attribute__((ext_vector_type(8)));
typedef float f32x4 __attribute__((ext_vector_type(4)));
typedef unsigned u32x4 __attribute__((ext_vector_type(4)));
constexpr int BM = 256, BK = 64, HALF = 128, HTB = HALF * BK * 2  , STAGE_BYTES = 8 * HTB, NXCD = 8, WGM = 8;

__host__ __device__ __forceinline__ int lds_byte(int r, int c) { const int st = (r >> 4) * 2 + (c >> 5), rr = r & 15, cc = c & 31, ob = rr * 64 + cc * 2; return st * 1024 + (ob ^ (((ob >> 9) & 1) << 5)); }
__host__ __device__ __forceinline__ void stage_rc(int b, int& R, int& C) { const int st = b / 1024, sb = b % 1024, swz = sb ^ (((sb >> 9) & 1) << 5); R = (st >> 1) * 16 + swz / 64; C = (st & 1) * 32 + (swz % 64) / 2; }
__host__ __device__ __forceinline__ int perm32(int rho) { const int n = rho >> 4, i = rho & 15; return 8 * (i >> 2) + 4 * n + (i & 3); }

struct Unit { int pm, pn; };
struct Gemm { const bf16_t* A; const bf16_t* Bt; int M, N, K; };

struct StaticOrder {
    int nM, nN, nwg, G, c;
    __host__ __device__ void init(int M, int N, int G_, int c_) { nM = M / BM; nN = N / BM; nwg = nM * nN; G = G_; c = c_; }
    __host__ __device__ bool next(int i, Unit& u) const {
        const long L = (long)i * G + c; if (L >= nwg) return false;
        int wgid = (int)L; { const int q = nwg / NXCD, r = nwg % NXCD, xcd = wgid % NXCD, off = wgid / NXCD; wgid = (xcd < r ? xcd * (q + 1) : r * (q + 1) + (xcd - r) * q) + off; }
        const int nig = WGM * nN, gid = wgid / nig, fm = gid * WGM, gsz = (nM - fm) < WGM ? (nM - fm) : WGM;
        u.pm = fm + ((wgid % nig) % gsz); u.pn = (wgid % nig) / gsz; return true;
    }
    __device__ __forceinline__ void a_ready(const Unit&) const {}
    __device__ __forceinline__ void done(const Unit&) const {}
};
template <class Epi, class Sched, bool STAMP = false>
__device__ __forceinline__ void gemm_phase(PG8_LAS unsigned char* lds, const Gemm g, const Sched& S, const Epi& E, unsigned long long* stamps, const int tid_in) {
    const int tid = tid_in, wid = __builtin_amdgcn_readfirstlane(tid >> 6), lane = tid & 63, wr = wid >> 2, wc = wid & 3, fr = lane & 15, fq = lane >> 4;
    const int K = g.K, nt = K / BK;
    int ts_lo = 0, ts_hi = 0, nts = 0; const unsigned long long rt_entry = STAMP ? (unsigned long long)wall_clock64() : 0ull;
#define PG8_STAMP() do { if (STAMP && wid == 0 && nts < 64) { const unsigned long long _c = (unsigned long long)clock64(); \
        ts_lo = (lane == nts) ? (int)(unsigned)_c : ts_lo; ts_hi = (lane == nts) ? (int)(unsigned)(_c >> 32) : ts_hi; ++nts; } } while (0)
    PG8_STAMP();
    unsigned voffA[2], voffB[2];
#pragma unroll
    for (int i = 0; i < 2; ++i) { int R, C; stage_rc(tid * 16 + i * 8192, R, C); const int Rb = Epi::PERM ? ((R & ~31) + perm32(R & 31)) : R;
        voffA[i] = (unsigned)(R * K + C) * 2u; voffB[i] = (unsigned)(Rb * K + C) * 2u; }
    const size_t kstep = (size_t)(BK * 2);
    const size_t hstep = (size_t)HALF * K * 2;
    const size_t tstep = 2 * hstep;
    const unsigned ldsw = (unsigned)wid * 1024u;
    const int aoff = lds_byte(wr * 64 + fr, fq * 8), boff = lds_byte(wc * 32 + fr, fq * 8);
#define PG8_SA(b, h) (((b) * 2 + (h)) * HTB)
#define PG8_SB(b, h) ((4 + (b) * 2 + (h)) * HTB)
#define PG8_STAGE(bufoff, gbase, voff) do { _Pragma("unroll") for (int _i = 0; _i < 2; ++_i) \
        __builtin_amdgcn_global_load_lds((const unsigned*)((const char*)(gbase) + (voff)[_i]), (PG8_LAS unsigned*)(lds + (bufoff) + ldsw + _i * 8192), 16, 0, 0); } while (0)
#define PG8_LDA(dst, b, h) do { _Pragma("unroll") for (int m = 0; m < 4; ++m) _Pragma("unroll") for (int k = 0; k < 2; ++k) dst[m][k] = *(const PG8_LAS bf16x8*)(lds + PG8_SA(b, h) + aoff + m * 2048 + k * 1024); } while (0)
#define PG8_LDB(dst, b, h) do { _Pragma("unroll") for (int n = 0; n < 2; ++n) _Pragma("unroll") for (int k = 0; k < 2; ++k) dst[n][k] = *(const PG8_LAS bf16x8*)(lds + PG8_SB(b, h) + boff + n * 2048 + k * 1024); } while (0)
#define PG8_MMA(ai, bj, At, Bt) do { __builtin_amdgcn_s_setprio(1); _Pragma("unroll") for (int m = 0; m < 4; ++m) _Pragma("unroll") for (int n = 0; n < 2; ++n) _Pragma("unroll") for (int k = 0; k < 2; ++k) \
        acc[ai][bj][m][n] = __builtin_amdgcn_mfma_f32_16x16x32_bf16(Bt[n][k], At[m][k], acc[ai][bj][m][n], 0, 0, 0); __builtin_amdgcn_s_setprio(0); } while (0)
#define PG8_WAIT_V(n) asm volatile("s_waitcnt vmcnt(" #n ")" ::: "memory")
#define PG8_WAIT_L(n) asm volatile("s_waitcnt lgkmcnt(" #n ")" ::: "memory")
#define PG8_BAR __builtin_amdgcn_s_barrier()
#define PG8_SCHED __builtin_amdgcn_sched_barrier(0)
    Unit cur, nxt; int ui = 0;
    if (!S.next(0, cur)) return;
    f32x4 acc[2][2][4][2];
#pragma unroll
    for (int a = 0; a < 2; ++a)
#pragma unroll
        for (int b = 0; b < 2; ++b)
#pragma unroll
            for (int m = 0; m < 4; ++m)
#pragma unroll
                for (int n = 0; n < 2; ++n) acc[a][b][m][n] = (f32x4){0.f, 0.f, 0.f, 0.f};
    bf16x8 At[4][2], B0[2][2], B1[2][2];
    const char* cA = (const char*)g.A + (size_t)cur.pm * tstep; const char* cB = (const char*)g.Bt + (size_t)cur.pn * tstep;
    S.a_ready(cur);
    PG8_STAGE(PG8_SB(0, 0), cB, voffB); PG8_STAGE(PG8_SA(0, 0), cA, voffA); PG8_STAGE(PG8_SB(0, 1), cB + hstep, voffB); PG8_STAGE(PG8_SA(0, 1), cA + hstep, voffA);
    if (wr == 1) PG8_BAR;
    PG8_WAIT_V(4); PG8_BAR;
    PG8_STAGE(PG8_SB(1, 0), cB + kstep, voffB); PG8_STAGE(PG8_SA(1, 0), cA + kstep, voffA); PG8_STAGE(PG8_SB(1, 1), cB + hstep + kstep, voffB);
    PG8_WAIT_V(6); PG8_BAR;
    PG8_STAMP();
    for (;;) {
        const bool has_next = S.next(ui + 1, nxt);
        const char* nA = has_next ? (const char*)g.A + (size_t)nxt.pm * tstep : cA; const char* nB = has_next ? (const char*)g.Bt + (size_t)nxt.pn * tstep : cB;
        for (int t = 0; t < nt; t += 2) {
            const bool last = (t == nt - 2);
            const char* a1 = cA + (size_t)(t + 1) * kstep;
            const char* a2 = last ? nA : cA + (size_t)(t + 2) * kstep; const char* b2 = last ? nB : cB + (size_t)(t + 2) * kstep;
            const char* a3 = a2 + kstep; const char* b3 = b2 + kstep;
            if (last && has_next) S.a_ready(nxt);
            PG8_LDB(B0, 0, 0); PG8_SCHED; PG8_LDA(At, 0, 0); PG8_STAGE(PG8_SA(1, 1), a1 + hstep, voffA);
            PG8_WAIT_L(8); PG8_BAR; PG8_WAIT_L(0); PG8_MMA(0, 0, At, B0); PG8_BAR; PG8_SCHED;
            PG8_LDB(B1, 0, 1); PG8_STAGE(PG8_SB(0, 0), b2, voffB);
            PG8_BAR; PG8_WAIT_L(0); PG8_MMA(0, 1, At, B1); PG8_BAR;
            PG8_LDA(At, 0, 1); PG8_STAGE(PG8_SA(0, 0), a2, voffA);
            PG8_BAR; PG8_WAIT_L(0); PG8_MMA(1, 0, At, B0); PG8_BAR; PG8_SCHED;
            PG8_STAGE(PG8_SB(0, 1), b2 + hstep, voffB);
            PG8_WAIT_V(6); PG8_BAR; PG8_MMA(1, 1, At, B1); PG8_BAR;
            PG8_LDB(B0, 1, 0); PG8_SCHED; PG8_LDA(At, 1, 0); PG8_STAGE(PG8_SA(0, 1), a2 + hstep, voffA);
            PG8_WAIT_L(8); PG8_BAR; PG8_WAIT_L(0); PG8_MMA(0, 0, At, B0); PG8_BAR; PG8_SCHED;
            PG8_LDB(B1, 1, 1); PG8_STAGE(PG8_SB(1, 0), b3, voffB);
            PG8_BAR; PG8_WAIT_L(0); PG8_MMA(0, 1, At, B1); PG8_BAR;
            PG8_LDA(At, 1, 1); PG8_STAGE(PG8_SA(1, 0), a3, voffA);
            PG8_BAR; PG8_WAIT_L(0); PG8_MMA(1, 0, At, B0); PG8_BAR; PG8_SCHED;
            PG8_STAGE(PG8_SB(1, 1), b3 + hstep, voffB);
            PG8_WAIT_V(6); PG8_BAR; PG8_MMA(1, 1, At, B1); PG8_BAR;
        }
        PG8_STAMP();
        if constexpr (!Epi::AFTER_DRAIN) { E(acc, cur, wr, wc, fr, fq); S.done(cur); }
        PG8_STAMP();
        if (!has_next) break;
#pragma unroll
        for (int a = 0; a < 2; ++a)
#pragma unroll
            for (int b = 0; b < 2; ++b)
#pragma unroll
                for (int m = 0; m < 4; ++m)
#pragma unroll
                    for (int n = 0; n < 2; ++n) acc[a][b][m][n] = (f32x4){0.f, 0.f, 0.f, 0.f};
        cur = nxt; cA = nA; cB = nB; ++ui;
    }
    PG8_WAIT_V(0);
    if (wr == 0) PG8_BAR;
    PG8_BAR;
    if constexpr (Epi::AFTER_DRAIN) { E.fused(acc, cur, wr, wc, fr, fq, lds, wid, lane); S.done(cur); }
    PG8_STAMP();
    if (STAMP && wid == 0) { stamps[lane] = lane < nts ? (((unsigned long long)(unsigned)ts_hi << 32) | (unsigned)ts_lo) : 0ull;
        if (lane == 62) stamps[62] = rt_entry; if (lane == 63) stamps[63] = (unsigned long long)wall_clock64(); }
#undef PG8_STAMP
#undef PG8_SA
#undef PG8_SB
#undef PG8_STAGE
#undef PG8_LDA
#undef PG8_LDB
#undef PG8_MMA
#undef PG8_WAIT_V
#undef PG8_WAIT_L
#undef PG8_BAR
#undef PG8_SCHED
}
}

template <class F> struct EpiWrap {
  static constexpr bool PERM = false, AFTER_DRAIN = false;
  F f;
  DI void operator()(const f32x4 (&acc)[2][2][4][2], const pg8::Unit& u, int wr, int wc, int fr, int fq) const {
#pragma unroll
    for (int ai = 0; ai < 2; ++ai)
#pragma unroll
      for (int m = 0; m < 4; ++m) {
        const int row = u.pm * 256 + ai * 128 + wr * 64 + m * 16 + fr;
#pragma unroll
        for (int bj = 0; bj < 2; ++bj)
#pragma unroll
          for (int n = 0; n < 2; ++n) f(u.pn * 256 + bj * 128 + wc * 32 + n * 16 + 4 * fq, row, acc[ai][bj][m][n]);
      }
  }
};
template <class F>
DI void run_gemm_on(PG8_LAS unsigned char* lds, const bf16_t* A, const bf16_t* Bt, int M, int N, int K, const F& f, const int tid, int G, int c) {
  pg8::Gemm g; g.A = A; g.Bt = Bt; g.M = M; g.N = N; g.K = K;
  pg8::StaticOrder S; S.init(M, N, G, c);
  EpiWrap<F> E{f};
  pg8::gemm_phase<EpiWrap<F>, pg8::StaticOrder, false>(lds, g, S, E, nullptr, tid);
  __syncthreads();
}
template <class F>
DI void run_gemm(PG8_LAS unsigned char* lds, const bf16_t* A, const bf16_t* Bt, int M, int N, int K, const F& f, const int tid) {
  pg8::Gemm g; g.A = A; g.Bt = Bt; g.M = M; g.N = N; g.K = K;
  pg8::StaticOrder S; S.init(M, N, (int)gridDim.x, (int)blockIdx.x);
  EpiWrap<F> E{f};
  pg8::gemm_phase<EpiWrap<F>, pg8::StaticOrder, false>(lds, g, S, E, nullptr, tid);
  __syncthreads();
}

struct InProjEpi {
  unsigned char* ws;
  DI void operator()(int m, int n, const f32x4& v) const {
    if (m < 3072) {
      const int blk = m >> 8, c = m & 255;
      if (blk == 8) {
        bf16_t* cvt = (bf16_t*)(ws + OFF_CVT);
        const int seq = n >> 13, l = n & 8191;
        bf16_t* d = cvt + ((size_t)(seq * 256 + c)) * 8192 + l;
#pragma unroll
        for (int e = 0; e < 4; ++e) d[(size_t)e * 8192] = f2bf(v[e]);
      } else {
        bf16_t* d;
        if (blk >= 2 && blk <= 4) d = (bf16_t*)(ws + OFF_BQKV) + (size_t)n * 768 + (blk - 2) * 256 + c;
        else if (blk == 0 || blk == 5 || blk == 6 || blk == 10) d = (bf16_t*)(ws + OFF_MIX) + (size_t)n * 1024 + (blk == 0 ? 0 : blk == 5 ? 256 : blk == 6 ? 512 : 768) + c;
        else {
          size_t off = blk == 1 ? OFF_AZ : blk == 7 ? OFF_CK : blk == 9 ? OFF_CZ : OFF_DZ;
          d = (bf16_t*)(ws + off) + (size_t)n * 256 + c;
        }
        uint2 o; o.x = pack2(v[0], v[1]); o.y = pack2(v[2], v[3]); *(uint2*)d = o;
      }
    } else if (m < 3088) {
      float* g = (float*)(ws + OFF_GATES) + (size_t)n * 16 + (m - 3072);
      *(float4*)g = make_float4(v[0], v[1], v[2], v[3]);
    }
  }
};
struct MemKvEpi {
  unsigned char* ws; int l;
  DI void operator()(int m, int n, const f32x4& v) const {
    const int seq = n >> 8, key = n & 255;
    if (m < 256) {
      const int head = m >> 6, dim = m & 63;
      bf16_t* d = (bf16_t*)(ws + OFF_KMEM) + ((size_t)((l * 6 + seq) * 4 + head) * 256 + key) * 64 + dim;
      uint2 o; o.x = pack2(v[0], v[1]); o.y = pack2(v[2], v[3]); *(uint2*)d = o;
    } else {
      const int c = m - 256, head = c >> 6, dim = c & 63;
      bf16_t* d = (bf16_t*)(ws + OFF_VMEMT) + ((size_t)((l * 6 + seq) * 4 + head) * 64 + dim) * 256 + key;
#pragma unroll
      for (int e = 0; e < 4; ++e) d[e * 256] = f2bf(v[e]);
    }
  }
};
struct FnetEpi {
  unsigned char* ws;
  DI void operator()(int m, int n, const f32x4& v) const {
    const uint2 z = *(const uint2*)((const bf16_t*)(ws + OFF_AZ) + (size_t)n * 256 + m);
    uint2 o; o.x = pack2(v[0] * silu(bflo(z.x)), v[1] * silu(bfhi(z.x))); o.y = pack2(v[2] * silu(bflo(z.y)), v[3] * silu(bfhi(z.y)));
    *(uint2*)((bf16_t*)(ws + OFF_MIX) + (size_t)n * 1024 + m) = o;
  }
};
struct FnetEpiDirect {
  static constexpr bool PERM = false, AFTER_DRAIN = false;
  unsigned char* ws;
  DI void operator()(const f32x4 (&acc)[2][2][4][2], const pg8::Unit& u, int wr, int wc, int fr, int fq) const {
    const bf16_t* AZ = (const bf16_t*)(ws + OFF_AZ); bf16_t* MX = (bf16_t*)(ws + OFF_MIX);
    const int col0 = u.pn * 256 + wc * 32 + 4 * fq;
#pragma unroll
    for (int ai = 0; ai < 2; ++ai)
#pragma unroll
      for (int m2 = 0; m2 < 2; ++m2) {
        uint2 z[2][2][2];
#pragma unroll
        for (int mm = 0; mm < 2; ++mm) {
          const size_t row = (size_t)(u.pm * 256 + ai * 128 + wr * 64 + (2 * m2 + mm) * 16 + fr);
#pragma unroll
          for (int bj = 0; bj < 2; ++bj)
#pragma unroll
            for (int n = 0; n < 2; ++n) z[mm][bj][n] = *(const uint2*)(AZ + row * 256 + col0 + bj * 128 + n * 16);
        }
#pragma unroll
        for (int mm = 0; mm < 2; ++mm) {
          const size_t row = (size_t)(u.pm * 256 + ai * 128 + wr * 64 + (2 * m2 + mm) * 16 + fr);
#pragma unroll
          for (int bj = 0; bj < 2; ++bj)
#pragma unroll
            for (int n = 0; n < 2; ++n) {
              const f32x4 v = acc[ai][bj][2 * m2 + mm][n]; const uint2 zz = z[mm][bj][n];
              uint2 o; o.x = pack2(v[0] * silu(bflo(zz.x)), v[1] * silu(bfhi(zz.x))); o.y = pack2(v[2] * silu(bflo(zz.y)), v[3] * silu(bfhi(zz.y)));
              *(uint2*)(MX + row * 1024 + col0 + bj * 128 + n * 16) = o;
            }
        }
      }
  }
};
struct OutEpi {
  bf16_t* dst;
  DI void operator()(int m, int n, const f32x4& v) const { uint2 o; o.x = pack2(v[0], v[1]); o.y = pack2(v[2], v[3]); *(uint2*)(dst + (size_t)n * 1024 + m) = o; }
};

DI int fft_pos(int k) {
  return ((k & 1) << 12) | (((k >> 1) & 3) << 10) | (((k >> 3) & 3) << 8) | (((k >> 5) & 3) << 6) | (((k >> 7) & 3) << 4) | (((k >> 9) & 3) << 2) | ((k >> 11) & 3);
}
DI void fft_task(const Params& p, int task, float2* z, const int tid) {
  const int seq = task >> 7, cp = task & 127;
  const unsigned* au = (const unsigned*)(p.ws + OFF_MIX) + (size_t)seq * 8192 * 512 + cp;
  const float2* tw = (const float2*)(p.ws + OFF_TW);
  for (int i = tid; i < 8192; i += NT) { const unsigned u = au[(size_t)i * 512]; z[i] = make_float2(bflo(u), bfhi(u)); }
  __syncthreads();
  for (int b = tid; b < 4096; b += NT) {
    const float2 a = z[b], c = z[b + 4096], w = tw[b];
    z[b] = make_float2(a.x + c.x, a.y + c.y);
    const float dx = a.x - c.x, dy = a.y - c.y;
    z[b + 4096] = make_float2(dx * w.x - dy * w.y, dx * w.y + dy * w.x);
  }
  __syncthreads();
#pragma unroll 1
  for (int s4 = 0; s4 < 6; ++s4) {
    const int lq = 10 - 2 * s4, q = 1 << lq;
    for (int b = tid; b < 2048; b += NT) {
      const int j = b & (q - 1), i0 = ((b >> lq) << (lq + 2)) + j;
      const float2 a0 = z[i0], a1 = z[i0 + q], a2 = z[i0 + 2 * q], a3 = z[i0 + 3 * q];
      const float2 w1 = tw[j << (1 + 2 * s4)];
      const float2 w2 = make_float2(w1.x * w1.x - w1.y * w1.y, 2.f * w1.x * w1.y);
      const float2 w3 = make_float2(w2.x * w1.x - w2.y * w1.y, w2.x * w1.y + w2.y * w1.x);
      const float t0x = a0.x + a2.x, t0y = a0.y + a2.y, t1x = a0.x - a2.x, t1y = a0.y - a2.y;
      const float t2x = a1.x + a3.x, t2y = a1.y + a3.y, t3x = a1.y - a3.y, t3y = -(a1.x - a3.x);
      z[i0] = make_float2(t0x + t2x, t0y + t2y);
      const float y1x = t1x + t3x, y1y = t1y + t3y, y2x = t0x - t2x, y2y = t0y - t2y, y3x = t1x - t3x, y3y = t1y - t3y;
      z[i0 + q] = make_float2(y1x * w1.x - y1y * w1.y, y1x * w1.y + y1y * w1.x);
      z[i0 + 2 * q] = make_float2(y2x * w2.x - y2y * w2.y, y2x * w2.y + y2y * w2.x);
      z[i0 + 3 * q] = make_float2(y3x * w3.x - y3y * w3.y, y3x * w3.y + y3y * w3.x);
    }
    __syncthreads();
  }
  unsigned* H = (unsigned*)(p.ws + OFF_H) + (size_t)seq * 8192 * 256;
  for (int k = tid; k < 8192; k += NT) {
    const float2 zk = z[fft_pos(k)], zn = z[fft_pos((8192 - k) & 8191)];
    H[(size_t)k * 256 + cp] = pack2(0.5f * (zk.x + zn.x), 0.5f * (zk.y + zn.y));
    H[(size_t)k * 256 + 128 + cp] = pack2(0.5f * (zk.y - zn.y), -0.5f * (zk.x - zn.x));
  }
  __syncthreads();
}

template <bool NA>
DI void attn_core(const Params& p, int layer, int h, int tok0, int r, int c0, int rs, int wsx, const bf16_t* sK, const bf16_t* sVT, const float* sBias, int kb, int pitch, int vstride, int lane) {
  const int fr = lane & 15, fq = lane >> 4;
  bf16_t* Q = (bf16_t*)(p.ws + OFF_MIX) + (NA ? 512 : 768);
  const bf16_t* Z = (const bf16_t*)(p.ws + (NA ? OFF_CZ : OFF_DZ));
  const bf16_t* qp = Q + (size_t)(tok0 + fr) * 1024 + h * 64 + fq * 8;
  bf16x8 qf[2]; qf[0] = ld8(qp); qf[1] = ld8(qp + 32);
  f32x4 s[16];
#pragma unroll
  for (int kt = 0; kt < 16; ++kt) {
    const bf16_t* kp = sK + (kb + (kt >> 1) * pitch + (kt & 1) * 16 + fr) * 72 + fq * 8;
    f32x4 a = (f32x4){0.f, 0.f, 0.f, 0.f};
    a = MFMA16(ld8(kp), qf[0], a);
    a = MFMA16(ld8(kp + 32), qf[1], a);
    s[kt] = a;
  }
  float mx = -1e30f;
  if (NA) {
    const int c = c0 + fr, cs = min(max(c - 8, 0), 48);
#pragma unroll
    for (int kt = 0; kt < 16; ++kt) {
      const int kr = rs + (kt >> 1);
      const float* rb = sBias + (kr - r + 7) * 31;
#pragma unroll
      for (int e = 0; e < 4; ++e) {
        const int kc = wsx + (kt & 1) * 16 + 4 * fq + e;
        const bool valid = kc >= cs && kc < cs + 16;
        const float bias = rb[min(max(kc - c + 15, 0), 30)];
        const float v = valid ? s[kt][e] * 0.125f + bias : -1e30f;
        s[kt][e] = v; mx = fmaxf(mx, v);
      }
    }
  } else {
#pragma unroll
    for (int kt = 0; kt < 16; ++kt)
#pragma unroll
      for (int e = 0; e < 4; ++e) { const float v = s[kt][e] * 0.125f; s[kt][e] = v; mx = fmaxf(mx, v); }
  }
  mx = fmaxf(mx, __shfl_xor(mx, 16, 64)); mx = fmaxf(mx, __shfl_xor(mx, 32, 64));
  float sum = 0.f;
#pragma unroll
  for (int kt = 0; kt < 16; ++kt)
#pragma unroll
    for (int e = 0; e < 4; ++e) { const float pv = __expf(s[kt][e] - mx); s[kt][e] = pv; sum += pv; }
  sum += __shfl_xor(sum, 16, 64); sum += __shfl_xor(sum, 32, 64);
  const float inv = 1.f / sum;
  f32x4 o[4];
#pragma unroll
  for (int mt = 0; mt < 4; ++mt) o[mt] = (f32x4){0.f, 0.f, 0.f, 0.f};
#pragma unroll
  for (int u = 0; u < 8; ++u) {
    const bf16x8 pb = pack8(s[2 * u], s[2 * u + 1]);
#pragma unroll
    for (int mt = 0; mt < 4; ++mt) {
      const bf16_t* vp = sVT + (16 * mt + fr) * vstride + kb + u * pitch + 4 * fq;
      o[mt] = MFMA16(ld4x2(vp, vp + 16), pb, o[mt]);
    }
  }
  const size_t orow = (size_t)(tok0 + fr) * 256 + h * 64 + 4 * fq, qrow = (size_t)(tok0 + fr) * 1024 + h * 64 + 4 * fq;
  uint2 zg[4];
#pragma unroll
  for (int mt = 0; mt < 4; ++mt) zg[mt] = *(const uint2*)(Z + orow + 16 * mt);
#pragma unroll
  for (int mt = 0; mt < 4; ++mt) {
    const uint2 z = zg[mt];
    uint2 w; w.x = pack2(o[mt][0] * inv * silu(bflo(z.x)), o[mt][1] * inv * silu(bfhi(z.x)));
    w.y = pack2(o[mt][2] * inv * silu(bflo(z.y)), o[mt][3] * inv * silu(bfhi(z.y)));
    *(uint2*)(Q + qrow + 16 * mt) = w;
  }
}
DI void na_block(const Params& p, int layer, int bt, char* smem, const int tid) {
  const int half = bt & 1, rg = (bt >> 1) & 31, h = (bt >> 6) & 3, seq = bt >> 8;
  const int r0 = rg * 4, rsmin = min(max(r0 - 4, 0), 120), nrows = min(11, 128 - rsmin), colbase = half ? 24 : 0;
  bf16_t* sK = (bf16_t*)smem; bf16_t* sVT = sK + 440 * 72; float* sBias = (float*)(sVT + 64 * 456);
  if (tid < 465) sBias[tid] = p.rpb[(size_t)(layer * 4 + h) * 465 + tid];
  const bf16_t* CK = (const bf16_t*)(p.ws + OFF_CK) + (size_t)(seq * 8192 + rsmin * 64 + colbase) * 256 + h * 64;
  const bf16_t* CVT = (const bf16_t*)(p.ws + OFF_CVT) + (size_t)(seq * 4 + h) * 64 * 8192 + rsmin * 64 + colbase;
  {
    const int nk = nrows * 40 * 8, per_dim = nrows * 5, nv = 64 * per_dim;
    uint4 rk[7], rv[7]; int dk[7], dv[7];
#pragma unroll
    for (int i = 0; i < 7; ++i) {
      const int idx = tid + NT * i;
      const int key = idx >> 3, ch = idx & 7, ri = key / 40, cj = key - ri * 40;
      dk[i] = idx < nk ? key * 72 + ch * 8 : -1;
      rk[i] = idx < nk ? *(const uint4*)(CK + (size_t)(ri * 64 + cj) * 256 + ch * 8) : make_uint4(0, 0, 0, 0);
      const int dim = idx / per_dim, rem = idx - dim * per_dim, r2 = rem / 5, c5 = rem - r2 * 5;
      dv[i] = idx < nv ? dim * 456 + r2 * 40 + c5 * 8 : -1;
      rv[i] = idx < nv ? *(const uint4*)(CVT + (size_t)dim * 8192 + r2 * 64 + c5 * 8) : make_uint4(0, 0, 0, 0);
    }
#pragma unroll
    for (int i = 0; i < 7; ++i) { if (dk[i] >= 0) *(uint4*)(sK + dk[i]) = rk[i]; if (dv[i] >= 0) *(uint4*)(sVT + dv[i]) = rv[i]; }
  }
  __syncthreads();
  {
    const int wave = tid >> 6, lane = tid & 63;
    const int r = r0 + (wave >> 1), c0 = 32 * half + 16 * (wave & 1);
    const int rs = min(max(r - 4, 0), 120), wsx = min(max(c0 - 8, 0), 32);
    attn_core<true>(p, layer, h, seq * 8192 + r * 64 + c0, r, c0, rs, wsx, sK, sVT, sBias, (rs - rsmin) * 40 + (wsx - colbase), 40, 456, lane);
  }
  __syncthreads();
}
DI void mem_block(const Params& p, int layer, int bt, char* smem, const int tid) {
  const int g = bt & 31, h = (bt >> 5) & 3, seq = bt >> 7;
  bf16_t* sK = (bf16_t*)smem; bf16_t* sVT = sK + 256 * 72;
  const bf16_t* Kg = (const bf16_t*)(p.ws + OFF_KMEM) + (size_t)((layer * 6 + seq) * 4 + h) * 256 * 64;
  const bf16_t* Vg = (const bf16_t*)(p.ws + OFF_VMEMT) + (size_t)((layer * 6 + seq) * 4 + h) * 64 * 256;
  {
    uint4 rk[4], rv[4];
#pragma unroll
    for (int i = 0; i < 4; ++i) { const int idx = tid + NT * i; rk[i] = *(const uint4*)(Kg + (size_t)idx * 8); rv[i] = *(const uint4*)(Vg + (size_t)idx * 8); }
#pragma unroll
    for (int i = 0; i < 4; ++i) { const int idx = tid + NT * i; *(uint4*)(sK + (idx >> 3) * 72 + (idx & 7) * 8) = rk[i]; *(uint4*)(sVT + (idx >> 5) * 264 + (idx & 31) * 8) = rv[i]; }
  }
  __syncthreads();
  {
    const int wave = tid >> 6, lane = tid & 63;
#pragma unroll 1
    for (int i = 0; i < 2; ++i) { int kb0 = 0; asm volatile("" : "+v"(kb0));
      attn_core<false>(p, layer, h, seq * 8192 + (g * 16 + wave * 2 + i) * 16, 0, 0, 0, 0, sK, sVT, nullptr, kb0, 32, 264, lane); }
  }
  __syncthreads();
}

DI void gdn_prep_tok8(const Params& p, int layer, int task, int lane) {
  const int tok0 = task * 8, seq = tok0 >> 13, l0 = tok0 & 8191;
  const bf16_t* X = (const bf16_t*)(p.ws + OFF_BQKV);
  const float* cw = p.conv_w + (size_t)layer * 5 * 768;
  unsigned kp[4][4];
#pragma unroll
  for (int i = 0; i < 3; ++i) {
    const int c = i * 256 + lane * 4;
    uint2 x[12];
#pragma unroll
    for (int jj = 0; jj < 12; ++jj) {
      const int ll = l0 + jj - 2;
      x[jj] = (ll >= 0 && ll < 8192) ? *(const uint2*)(X + (size_t)(tok0 + jj - 2) * 768 + c) : make_uint2(0u, 0u);
    }
    float4 w[5];
#pragma unroll
    for (int j = 0; j < 5; ++j) w[j] = *(const float4*)(cw + j * 768 + c);
    bf16_t* dst = (bf16_t*)(p.ws + (i == 0 ? OFF_QN : i == 1 ? OFF_KN : OFF_VN)) + (size_t)tok0 * 256 + lane * 4;
#pragma unroll
    for (int t = 0; t < 8; ++t) {
      float a0 = 0.f, a1 = 0.f, a2 = 0.f, a3 = 0.f;
#pragma unroll
      for (int j = 0; j < 5; ++j) { const uint2 xv = x[t + j]; a0 += w[j].x * bflo(xv.x); a1 += w[j].y * bfhi(xv.x); a2 += w[j].z * bflo(xv.y); a3 += w[j].w * bfhi(xv.y); }
      a0 = silu(a0); a1 = silu(a1); a2 = silu(a2); a3 = silu(a3);
      if (i < 2) {
        float ss = a0 * a0 + a1 * a1 + a2 * a2 + a3 * a3;
        ss += __shfl_xor(ss, 1, 64); ss += __shfl_xor(ss, 2, 64); ss += __shfl_xor(ss, 4, 64); ss += __shfl_xor(ss, 8, 64);
        const float rs = rsqrtf(ss + 1e-6f) * (i == 0 ? 0.125f : 1.f);
        a0 *= rs; a1 *= rs; a2 *= rs; a3 *= rs;
      }
      uint2 o; o.x = pack2(a0, a1); o.y = pack2(a2, a3);
      *(uint2*)(dst + (size_t)t * 256) = o;
      if (i == 1) {
        if (t & 1) { kp[0][t >> 1] |= (unsigned)f2bf(a0) << 16; kp[1][t >> 1] |= (unsigned)f2bf(a1) << 16; kp[2][t >> 1] |= (unsigned)f2bf(a2) << 16; kp[3][t >> 1] |= (unsigned)f2bf(a3) << 16; }
        else { kp[0][t >> 1] = f2bf(a0); kp[1][t >> 1] = f2bf(a1); kp[2][t >> 1] = f2bf(a2); kp[3][t >> 1] = f2bf(a3); }
      }
    }
  }
  bf16_t* kT = (bf16_t*)(p.ws + OFF_KT) + ((size_t)seq * 256 + lane * 4) * 8192 + l0;
#pragma unroll
  for (int e = 0; e < 4; ++e) *(uint4*)(kT + (size_t)e * 8192) = make_uint4(kp[e][0], kp[e][1], kp[e][2], kp[e][3]);
#pragma unroll
  for (int i2 = 0; i2 < 2; ++i2) {
    const int idx = lane + 64 * i2, gi = idx & 15;
    float* g = (float*)(p.ws + OFF_GATES) + (size_t)tok0 * 16 + idx;
    const float x = *g;
    float r;
    if (gi < 8) {
      const float y = x + p.dt_bias[layer * 8 + gi];
      const float sp = fmaxf(y, 0.f) + __logf(1.f + __expf(-fabsf(y)));
      r = -__expf(p.a_log[layer * 8 + gi]) * sp;
    } else r = __builtin_amdgcn_rcpf(1.f + __expf(-x));
    *g = r;
  }
}

DI void chunk_task(const Params& p, int bt, char* smem, const int tid) {
  const int n = bt & 127, head = (bt >> 7) & 3, seq = bt >> 9;
  const int lane = tid & 63, wave = tid >> 6, fr = lane & 15, fq = lane >> 4;
  float* sL = (float*)smem;
  float* sg = (float*)(smem + 32768);
  float* sbeta = sg + 128; float* sG = sbeta + 128;
  const float* gb = (const float*)(p.ws + OFF_GATES);
  const bf16_t* qn = (const bf16_t*)(p.ws + OFF_QN); const bf16_t* kn = (const bf16_t*)(p.ws + OFF_KN); const bf16_t* vn = (const bf16_t*)(p.ws + OFF_VN);
  const int tokbase = seq * 8192;
  if (tid < 128) {
    const int d = tid >> 6, r = tid & 63; const int pos = d ? 8191 - 64 * n - r : 64 * n + r;
    sg[tid] = gb[(size_t)(tokbase + pos) * 16 + d * 4 + head]; sbeta[tid] = gb[(size_t)(tokbase + pos) * 16 + 8 + d * 4 + head];
  }
  __syncthreads();
  if (tid < 128) {
    float a = sg[tid];
#pragma unroll
    for (int off = 1; off < 64; off <<= 1) { const float t = __shfl_up(a, off, 64); if (lane >= off) a += t; }
    sG[tid] = a;
  }
  __syncthreads();
  {
    const int d = wave >> 1;
    const int ct = ((seq * 4 + head) * 2 + d) * 128 + n;
    if ((wave & 1) == 0) {
      float* cv = (float*)(p.ws + OFF_CVEC) + (size_t)ct * 256;
      const float G = sG[d * 64 + lane], Gl = sG[d * 64 + 63];
      cv[lane] = __expf(G); cv[64 + lane] = __expf(Gl - G); if (lane == 0) cv[128] = __expf(Gl);
    }
    bf16_t* chqk = (bf16_t*)(p.ws + OFF_CHQK) + (size_t)ct * 4096;
    const int hoff = head * 64 + fq * 8;
    bf16x8 kB[4][2];
#pragma unroll
    for (int nt = 0; nt < 4; ++nt) {
      const int rB = 16 * nt + fr; const int posB = d ? 8191 - 64 * n - rB : 64 * n + rB;
      const size_t ob = (size_t)(tokbase + posB) * 256 + hoff;
      kB[nt][0] = ld8(kn + ob); kB[nt][1] = ld8(kn + ob + 32);
    }
    bf16x8 kA[2][2], qA[2][2];
#pragma unroll
    for (int si = 0; si < 2; ++si) {
      const int rA = 16 * (2 * (wave & 1) + si) + fr; const int posA = d ? 8191 - 64 * n - rA : 64 * n + rA;
      const size_t oa = (size_t)(tokbase + posA) * 256 + hoff;
      kA[si][0] = ld8(kn + oa); kA[si][1] = ld8(kn + oa + 32); qA[si][0] = ld8(qn + oa); qA[si][1] = ld8(qn + oa + 32);
    }
#pragma unroll
    for (int si = 0; si < 2; ++si) {
      const int strip = 2 * (wave & 1) + si;
#pragma unroll
      for (int nt = 0; nt < 4; ++nt) {
        f32x4 kk = (f32x4){0.f, 0.f, 0.f, 0.f}, qk = (f32x4){0.f, 0.f, 0.f, 0.f};
        kk = MFMA16(kA[si][0], kB[nt][0], kk); kk = MFMA16(kA[si][1], kB[nt][1], kk);
        qk = MFMA16(qA[si][0], kB[nt][0], qk); qk = MFMA16(qA[si][1], kB[nt][1], qk);
        const int sc = 16 * nt + fr;
#pragma unroll
        for (int e = 0; e < 4; ++e) {
          const int r = 16 * strip + 4 * fq + e;
          const float dec = sc <= r ? __expf(sG[d * 64 + r] - sG[d * 64 + sc]) : 0.f;
          sL[d * 4096 + r * 64 + sc] = sc < r ? sbeta[d * 64 + r] * kk[e] * dec : 0.f;
          chqk[r * 64 + sc] = f2bf(qk[e] * dec);
        }
      }
    }
  }
  __syncthreads();
  {
    const int wvu = __builtin_amdgcn_readfirstlane(wave);
    const int d = wvu >> 1, half = wvu & 1;
    const int ct = ((seq * 4 + head) * 2 + d) * 128 + n;
    const bf16_t* src = (half ? kn : vn) + (size_t)(tokbase + (d ? 8191 - 64 * n : 64 * n)) * 256 + head * 64 + lane;
    const int rstep = d ? -256 : 256;
    float sol[64];
#pragma unroll
    for (int r = 0; r < 64; ++r) sol[r] = bf2f(src[r * rstep]);
#pragma unroll
    for (int r4 = 0; r4 < 16; ++r4) {
      const float4 b4 = *(const float4*)(sbeta + d * 64 + 4 * r4); const float4 g4 = *(const float4*)(sG + d * 64 + 4 * r4);
      sol[4 * r4 + 0] *= half ? b4.x * __expf(g4.x) : b4.x; sol[4 * r4 + 1] *= half ? b4.y * __expf(g4.y) : b4.y;
      sol[4 * r4 + 2] *= half ? b4.z * __expf(g4.z) : b4.z; sol[4 * r4 + 3] *= half ? b4.w * __expf(g4.w) : b4.w;
    }
    const float* Ld = sL + d * 4096;
#pragma unroll
    for (int b = 0; b < 4; ++b) {
#pragma unroll
      for (int j4 = 0; j4 < 4 * b; ++j4) {
        float4 lv[16];
#pragma unroll
        for (int q = 0; q < 16; ++q) lv[q] = *(const float4*)(Ld + (16 * b + q) * 64 + 4 * j4);
#pragma unroll
        for (int q = 0; q < 16; ++q) {
          float a = sol[16 * b + q];
          a -= lv[q].x * sol[4 * j4 + 0]; a -= lv[q].y * sol[4 * j4 + 1]; a -= lv[q].z * sol[4 * j4 + 2]; a -= lv[q].w * sol[4 * j4 + 3];
          sol[16 * b + q] = a;
        }
      }
#pragma unroll
      for (int g4 = 0; g4 < 4; ++g4) {
        float4 lv[16];
#pragma unroll
        for (int q = 4 * g4 + 1; q < 16; ++q) lv[q] = *(const float4*)(Ld + (16 * b + q) * 64 + 16 * b + 4 * g4);
        sol[16 * b + 4 * g4 + 1] -= lv[4 * g4 + 1].x * sol[16 * b + 4 * g4];
        sol[16 * b + 4 * g4 + 2] -= lv[4 * g4 + 2].x * sol[16 * b + 4 * g4] + lv[4 * g4 + 2].y * sol[16 * b + 4 * g4 + 1];
        sol[16 * b + 4 * g4 + 3] -= lv[4 * g4 + 3].x * sol[16 * b + 4 * g4] + lv[4 * g4 + 3].y * sol[16 * b + 4 * g4 + 1] + lv[4 * g4 + 3].z * sol[16 * b + 4 * g4 + 2];
#pragma unroll
        for (int q = 4 * g4 + 4; q < 16; ++q) {
          float a = sol[16 * b + q];
          a -= lv[q].x * sol[16 * b + 4 * g4 + 0]; a -= lv[q].y * sol[16 * b + 4 * g4 + 1]; a -= lv[q].z * sol[16 * b + 4 * g4 + 2]; a -= lv[q].w * sol[16 * b + 4 * g4 + 3];
          sol[16 * b + q] = a;
        }
      }
    }
    if (!half) {
      bf16_t* chu = (bf16_t*)(p.ws + OFF_CHU) + (size_t)ct * 4096 + lane * 64;
#pragma unroll
      for (int r8 = 0; r8 < 8; ++r8) {
        uint4 o; o.x = pack2(sol[r8 * 8 + 0], sol[r8 * 8 + 1]); o.y = pack2(sol[r8 * 8 + 2], sol[r8 * 8 + 3]);
        o.z = pack2(sol[r8 * 8 + 4], sol[r8 * 8 + 5]); o.w = pack2(sol[r8 * 8 + 6], sol[r8 * 8 + 7]);
        *(uint4*)(chu + r8 * 8) = o;
      }
    } else {
      bf16_t* chw = (bf16_t*)(p.ws + OFF_CHW) + (size_t)ct * 4096 + lane;
#pragma unroll
      for (int r = 0; r < 64; ++r) chw[r * 64] = f2bf(sol[r]);
    }
  }
  __syncthreads();
}

DI uint4 rev8(uint4 v) {
  uint4 r;
  r.x = (v.w >> 16) | (v.w << 16); r.y = (v.z >> 16) | (v.z << 16); r.z = (v.y >> 16) | (v.y << 16); r.w = (v.x >> 16) | (v.x << 16);
  return r;
}
DI void scan_task(const Params& p, int task, char* smem, const int tid) {
  const int d = task & 1, head = (task >> 1) & 3, seq = task >> 3;
  const bool loader = tid >= 256;
  const int lt = tid & 255, lane = tid & 63, wave = lt >> 6, fr = lane & 15, fq = lane >> 4;
  const int row0 = lt >> 3, c8 = (lt & 7) * 8, rc8 = (7 - (lt & 7)) * 8;
  constexpr int BUFB = 49152;
  const int ctb = ((seq * 4 + head) * 2 + d) * 128;
  const bf16_t* chw = (const bf16_t*)(p.ws + OFF_CHW); const bf16_t* chu = (const bf16_t*)(p.ws + OFF_CHU); const bf16_t* chqk = (const bf16_t*)(p.ws + OFF_CHQK);
  const float* cvec = (const float*)(p.ws + OFF_CVEC);
  const bf16_t* qn = (const bf16_t*)(p.ws + OFF_QN) + (size_t)seq * 8192 * 256 + head * 64;
  const bf16_t* kT = (const bf16_t*)(p.ws + OFF_KT) + (size_t)(seq * 256 + head * 64) * 8192;
  bf16_t* O = (bf16_t*)(p.ws + (d ? OFF_OB : OFF_OF)) + (size_t)seq * 8192 * 256 + head * 64 + 32 * (wave & 1) + fr;
#define SCAN_STAGE(n_, buf_) do { \
    const size_t cb = (size_t)(ctb + (n_)) * 4096 + row0 * 64 + c8; \
    const uint4 rw0 = *(const uint4*)(chw + cb), rw1 = *(const uint4*)(chw + cb + 2048); \
    const uint4 rqk0 = *(const uint4*)(chqk + cb), rqk1 = *(const uint4*)(chqk + cb + 2048); \
    const uint4 ru0 = *(const uint4*)(chu + cb), ru1 = *(const uint4*)(chu + cb + 2048); \
    const int pos0 = d ? 8191 - 64 * (n_) - row0 : 64 * (n_) + row0, pos1 = d ? pos0 - 32 : pos0 + 32; \
    const uint4 rq0 = *(const uint4*)(qn + (size_t)pos0 * 256 + c8), rq1 = *(const uint4*)(qn + (size_t)pos1 * 256 + c8); \
    const int lbase = d ? 8191 - 64 * (n_) - 63 : 64 * (n_); \
    const uint4 rkt0 = *(const uint4*)(kT + (size_t)row0 * 8192 + lbase + c8), rkt1 = *(const uint4*)(kT + (size_t)(row0 + 32) * 8192 + lbase + c8); \
    const float rv = cvec[(size_t)(ctb + (n_)) * 256 + (lt < 129 ? lt : 128)]; \
    bf16_t* sW_ = (bf16_t*)(smem + (buf_) * BUFB); bf16_t* sQK_ = sW_ + 64 * 72; bf16_t* sQ_ = sQK_ + 64 * 72; bf16_t* sKT_ = sQ_ + 64 * 72; bf16_t* sU_ = sKT_ + 64 * 72; \
    float* sV_ = (float*)(smem + (buf_) * BUFB + 5 * 64 * 72 * 2); \
    *(uint4*)(sW_ + row0 * 72 + c8) = rw0; *(uint4*)(sW_ + (row0 + 32) * 72 + c8) = rw1; \
    *(uint4*)(sQK_ + row0 * 72 + c8) = rqk0; *(uint4*)(sQK_ + (row0 + 32) * 72 + c8) = rqk1; \
    *(uint4*)(sU_ + row0 * 72 + c8) = ru0; *(uint4*)(sU_ + (row0 + 32) * 72 + c8) = ru1; \
    *(uint4*)(sQ_ + row0 * 72 + c8) = rq0; *(uint4*)(sQ_ + (row0 + 32) * 72 + c8) = rq1; \
    if (d) { *(uint4*)(sKT_ + row0 * 72 + rc8) = rev8(rkt0); *(uint4*)(sKT_ + (row0 + 32) * 72 + rc8) = rev8(rkt1); } \
    else { *(uint4*)(sKT_ + row0 * 72 + c8) = rkt0; *(uint4*)(sKT_ + (row0 + 32) * 72 + c8) = rkt1; } \
    if (lt < 129) sV_[lt] = rv; } while (0)
#define SCAN_BAR() do { asm volatile("s_waitcnt lgkmcnt(0)" ::: "memory"); __builtin_amdgcn_s_barrier(); asm volatile("" ::: "memory"); } while (0)
  f32x4 S[4][2];
#pragma unroll
  for (int mt = 0; mt < 4; ++mt) { S[mt][0] = (f32x4){0.f, 0.f, 0.f, 0.f}; S[mt][1] = (f32x4){0.f, 0.f, 0.f, 0.f}; }
#define SCAN_LDF(f_, base_, h2_) do { _Pragma("unroll") for (int m2 = 0; m2 < 2; ++m2) { const bf16_t* p_ = (base_) + (16 * (2 * (h2_) + m2) + fr) * 72 + 4 * fq; \
    f_[m2][0] = ld4x2(p_, p_ + 16); f_[m2][1] = ld4x2(p_ + 32, p_ + 48); } } while (0)
#define SCAN_SB() __builtin_amdgcn_sched_barrier(0)
#define SCAN_COMPUTE(n_, buf_) do { \
    const bf16_t* sW = (const bf16_t*)(smem + (buf_) * BUFB); const bf16_t* sQK = sW + 64 * 72; const bf16_t* sQ = sQK + 64 * 72; const bf16_t* sKT = sQ + 64 * 72; const bf16_t* sU = sKT + 64 * 72; \
    const float* sV = (const float*)(smem + (buf_) * BUFB + 5 * 64 * 72 * 2); \
    bf16x8 fA[2][2], fB[2][2]; \
    SCAN_LDF(fA, sW, 0); SCAN_SB(); \
    bf16x8 Sb[2][2]; \
    _Pragma("unroll") for (int nt = 0; nt < 2; ++nt) { Sb[0][nt] = pack8(S[0][nt], S[1][nt]); Sb[1][nt] = pack8(S[2][nt], S[3][nt]); } \
    f32x4 v[4][2], o[4][2]; \
      \
    SCAN_LDF(fB, sW, 1); \
    _Pragma("unroll") for (int m2 = 0; m2 < 2; ++m2) _Pragma("unroll") for (int nt = 0; nt < 2; ++nt) { \
      v[m2][nt] = MFMA16(fA[m2][0], Sb[0][nt], ((f32x4){0.f, 0.f, 0.f, 0.f})); v[m2][nt] = MFMA16(fA[m2][1], Sb[1][nt], v[m2][nt]); } \
    SCAN_SB(); \
    SCAN_LDF(fA, sQ, 0); \
    _Pragma("unroll") for (int m2 = 0; m2 < 2; ++m2) _Pragma("unroll") for (int nt = 0; nt < 2; ++nt) { \
      v[2 + m2][nt] = MFMA16(fB[m2][0], Sb[0][nt], ((f32x4){0.f, 0.f, 0.f, 0.f})); v[2 + m2][nt] = MFMA16(fB[m2][1], Sb[1][nt], v[2 + m2][nt]); } \
    SCAN_SB(); \
    SCAN_LDF(fB, sQ, 1); \
    _Pragma("unroll") for (int m2 = 0; m2 < 2; ++m2) _Pragma("unroll") for (int nt = 0; nt < 2; ++nt) { \
      o[m2][nt] = MFMA16(fA[m2][0], Sb[0][nt], ((f32x4){0.f, 0.f, 0.f, 0.f})); o[m2][nt] = MFMA16(fA[m2][1], Sb[1][nt], o[m2][nt]); } \
    SCAN_SB(); \
    SCAN_LDF(fA, sKT, 0); \
    _Pragma("unroll") for (int m2 = 0; m2 < 2; ++m2) _Pragma("unroll") for (int nt = 0; nt < 2; ++nt) { \
      o[2 + m2][nt] = MFMA16(fB[m2][0], Sb[0][nt], ((f32x4){0.f, 0.f, 0.f, 0.f})); o[2 + m2][nt] = MFMA16(fB[m2][1], Sb[1][nt], o[2 + m2][nt]); } \
    SCAN_SB(); \
    bf16x8 Vb[2][2], Vkb[2][2]; \
    {   \
      _Pragma("unroll") for (int mt = 0; mt < 4; ++mt) { \
        const float4 eg = *(const float4*)(sV + 16 * mt + 4 * fq); \
        _Pragma("unroll") for (int nt = 0; nt < 2; ++nt) { \
          const uint2 u = *(const uint2*)(sU + (32 * wave + 16 * nt + fr) * 72 + 16 * mt + 4 * fq); \
          v[mt][nt][0] = bflo(u.x) - v[mt][nt][0]; v[mt][nt][1] = bfhi(u.x) - v[mt][nt][1]; v[mt][nt][2] = bflo(u.y) - v[mt][nt][2]; v[mt][nt][3] = bfhi(u.y) - v[mt][nt][3]; \
          o[mt][nt][0] *= eg.x; o[mt][nt][1] *= eg.y; o[mt][nt][2] *= eg.z; o[mt][nt][3] *= eg.w; } \
      } \
      _Pragma("unroll") for (int nt = 0; nt < 2; ++nt) { \
        Vb[0][nt] = pack8(v[0][nt], v[1][nt]); Vb[1][nt] = pack8(v[2][nt], v[3][nt]); } \
      _Pragma("unroll") for (int mt = 0; mt < 4; ++mt) { \
        const float4 ek = *(const float4*)(sV + 64 + 16 * mt + 4 * fq); \
        _Pragma("unroll") for (int nt = 0; nt < 2; ++nt) { v[mt][nt][0] *= ek.x; v[mt][nt][1] *= ek.y; v[mt][nt][2] *= ek.z; v[mt][nt][3] *= ek.w; } } \
      _Pragma("unroll") for (int nt = 0; nt < 2; ++nt) { \
        Vkb[0][nt] = pack8(v[0][nt], v[1][nt]); Vkb[1][nt] = pack8(v[2][nt], v[3][nt]); } \
    } \
    const float gl = sV[128]; \
    SCAN_SB(); \
    SCAN_LDF(fB, sKT, 1); \
    _Pragma("unroll") for (int m2 = 0; m2 < 2; ++m2) _Pragma("unroll") for (int nt = 0; nt < 2; ++nt) { \
      f32x4 a; a[0] = S[m2][nt][0] * gl; a[1] = S[m2][nt][1] * gl; a[2] = S[m2][nt][2] * gl; a[3] = S[m2][nt][3] * gl; \
      a = MFMA16(fA[m2][0], Vkb[0][nt], a); S[m2][nt] = MFMA16(fA[m2][1], Vkb[1][nt], a); } \
    SCAN_SB(); \
    SCAN_LDF(fA, sQK, 0); \
    _Pragma("unroll") for (int m2 = 0; m2 < 2; ++m2) _Pragma("unroll") for (int nt = 0; nt < 2; ++nt) { \
      f32x4 a; a[0] = S[2 + m2][nt][0] * gl; a[1] = S[2 + m2][nt][1] * gl; a[2] = S[2 + m2][nt][2] * gl; a[3] = S[2 + m2][nt][3] * gl; \
      a = MFMA16(fB[m2][0], Vkb[0][nt], a); S[2 + m2][nt] = MFMA16(fB[m2][1], Vkb[1][nt], a); } \
    SCAN_SB(); \
    SCAN_LDF(fB, sQK, 1); \
    _Pragma("unroll") for (int m2 = 0; m2 < 2; ++m2) _Pragma("unroll") for (int nt = 0; nt < 2; ++nt) { \
      o[m2][nt] = MFMA16(fA[m2][0], Vb[0][nt], o[m2][nt]); o[m2][nt] = MFMA16(fA[m2][1], Vb[1][nt], o[m2][nt]); } \
    SCAN_SB(); \
    _Pragma("unroll") for (int m2 = 0; m2 < 2; ++m2) _Pragma("unroll") for (int nt = 0; nt < 2; ++nt) { \
      o[2 + m2][nt] = MFMA16(fB[m2][0], Vb[0][nt], o[2 + m2][nt]); o[2 + m2][nt] = MFMA16(fB[m2][1], Vb[1][nt], o[2 + m2][nt]); } \
    _Pragma("unroll") for (int mt = 0; mt < 4; ++mt) _Pragma("unroll") for (int e = 0; e < 4; ++e) { \
      const int r_ = 16 * mt + 4 * fq + e; const int pos = d ? 8191 - 64 * (n_) - r_ : 64 * (n_) + r_; \
      O[(size_t)pos * 256] = f2bf(o[mt][0][e]); O[(size_t)pos * 256 + 16] = f2bf(o[mt][1][e]); \
    } } while (0)
  __syncthreads();
  if (loader) SCAN_STAGE(0, 0);
  SCAN_BAR();
#pragma unroll 1
  for (int n = 0; n < 128; ++n) {
    if (loader) { if (n + 1 < 128) SCAN_STAGE(n + 1, ((n + 1) & 1)); }
    else if (wave < 2) SCAN_COMPUTE(n, (n & 1));
    SCAN_BAR();
  }
  asm volatile("s_waitcnt vmcnt(0)" ::: "memory");
  __syncthreads();
#undef SCAN_STAGE
#undef SCAN_BAR
#undef SCAN_COMPUTE
#undef SCAN_LDF
#undef SCAN_SB
}

DI void gdn_finish_tok4(const Params& p, int layer, int tok0, int lane) {
  const float4 g = *(const float4*)(p.gdn_g + layer * 64 + (lane & 15) * 4);
  uint2 a[4], b[4], z[4];
#pragma unroll
  for (int t = 0; t < 4; ++t) {
    const size_t ro = (size_t)(tok0 + t) * 256 + lane * 4;
    a[t] = *(const uint2*)((const bf16_t*)(p.ws + OFF_OF) + ro); b[t] = *(const uint2*)((const bf16_t*)(p.ws + OFF_OB) + ro);
    z[t] = *(const uint2*)((const bf16_t*)(p.ws + OFF_MIX) + (size_t)(tok0 + t) * 1024 + 256 + lane * 4);
  }
#pragma unroll
  for (int t = 0; t < 4; ++t) {
    const float o0 = bflo(a[t].x) + bflo(b[t].x), o1 = bfhi(a[t].x) + bfhi(b[t].x), o2 = bflo(a[t].y) + bflo(b[t].y), o3 = bfhi(a[t].y) + bfhi(b[t].y);
    float ss = o0 * o0 + o1 * o1 + o2 * o2 + o3 * o3;
    ss += __shfl_xor(ss, 1, 64); ss += __shfl_xor(ss, 2, 64); ss += __shfl_xor(ss, 4, 64); ss += __shfl_xor(ss, 8, 64);
    const float rs = rsqrtf(ss * (1.f / 64.f) + 1e-6f);
    uint2 w; w.x = pack2(o0 * rs * g.x * silu(bflo(z[t].x)), o1 * rs * g.y * silu(bfhi(z[t].x)));
    w.y = pack2(o2 * rs * g.z * silu(bflo(z[t].y)), o3 * rs * g.w * silu(bfhi(z[t].y)));
    *(uint2*)((bf16_t*)(p.ws + OFF_MIX) + (size_t)(tok0 + t) * 1024 + 256 + lane * 4) = w;
  }
}

DI void post_token2(const Params& p, int layer, int tok0, int lane) {
  const float* pg = p.post_g + layer * 1024;
  uint2 ob[2][4]; float4 xr[2][4], g[4];
#pragma unroll
  for (int t = 0; t < 2; ++t) {
    const bf16_t* o = (const bf16_t*)(p.ws + OFF_OUTTMP) + (size_t)(tok0 + t) * 1024;
    const float* xp = layer == 0 ? xrow(p, tok0 + t) : p.out + (size_t)(tok0 + t) * 1024;
#pragma unroll
    for (int i = 0; i < 4; ++i) { ob[t][i] = *(const uint2*)(o + i * 256 + lane * 4); xr[t][i] = *(const float4*)(xp + i * 256 + lane * 4); }
  }
#pragma unroll
  for (int i = 0; i < 4; ++i) g[i] = *(const float4*)(pg + i * 256 + lane * 4);
#pragma unroll
  for (int t = 0; t < 2; ++t) {
    float4 v[4]; float ss = 0.f;
#pragma unroll
    for (int i = 0; i < 4; ++i) { const uint2 u = ob[t][i]; v[i] = make_float4(bflo(u.x), bfhi(u.x), bflo(u.y), bfhi(u.y));
      ss += v[i].x * v[i].x + v[i].y * v[i].y + v[i].z * v[i].z + v[i].w * v[i].w; }
    ss = wave_sum(ss);
    const float rs = rsqrtf(ss * (1.f / 1024.f) + 1e-6f);
    float ss2 = 0.f;
#pragma unroll
    for (int i = 0; i < 4; ++i) {
      const float4 x = xr[t][i];
      v[i].x = x.x + v[i].x * rs * g[i].x; v[i].y = x.y + v[i].y * rs * g[i].y; v[i].z = x.z + v[i].z * rs * g[i].z; v[i].w = x.w + v[i].w * rs * g[i].w;
      ss2 += v[i].x * v[i].x + v[i].y * v[i].y + v[i].z * v[i].z + v[i].w * v[i].w;
      *(float4*)(p.out + (size_t)(tok0 + t) * 1024 + i * 256 + lane * 4) = v[i];
    }
    if (layer == 0) {
      ss2 = wave_sum(ss2);
      const float rs2 = rsqrtf(ss2 * (1.f / 1024.f) + 1e-6f);
      bf16_t* dst = (bf16_t*)(p.ws + OFF_X) + (size_t)(tok0 + t) * 1024;
#pragma unroll
      for (int i = 0; i < 4; ++i) { uint2 w; w.x = pack2(v[i].x * rs2, v[i].y * rs2); w.y = pack2(v[i].z * rs2, v[i].w * rs2); *(uint2*)(dst + i * 256 + lane * 4) = w; }
    }
  }
}

#define XB_TMO      128
#define XB_XCNT(j)  (256  + 64 * (j))
#define XB_XSUB(j)  (1280 + 64 * (j))
#define XB_XGEN(j)  (2304 + 64 * (j))
#define XB_TOP      3328
#define XB_TOPGEN   3392
#define XCD_BAR_WORDS 3456
#define XB_SPIN_CAP (1u << 18)
#define XLAS __attribute__((address_space(3)))

__device__ __forceinline__ unsigned xb_ld(unsigned* p)              { return __hip_atomic_load(p, __ATOMIC_RELAXED, __HIP_MEMORY_SCOPE_AGENT); }
__device__ __forceinline__ unsigned xb_add(unsigned* p, unsigned v) { return __hip_atomic_fetch_add(p, v, __ATOMIC_RELAXED, __HIP_MEMORY_SCOPE_AGENT); }
__device__ __forceinline__ unsigned xb_xcc_id() { return (unsigned)__builtin_amdgcn_s_getreg((3 << 11) | 20) & 0xFu; }
#define XB_SPIN(cond, bar) do { unsigned _sp = 0; while (cond) { __builtin_amdgcn_s_sleep(1); \
    if ((++_sp & 255u) == 0u) { if (xb_ld(&(bar)[XB_TMO])) break; if (_sp > XB_SPIN_CAP) { atomicAdd(&(bar)[XB_TMO], 1u); break; } } } } while (0)

struct XcdBarrier {
    unsigned* bar; unsigned x;
    volatile XLAS unsigned* st;
};

__device__ __forceinline__ XcdBarrier xcd_barrier_post(unsigned* bar, volatile XLAS unsigned* st) {
    XcdBarrier b; b.bar = bar; b.x = xb_xcc_id(); b.st = st;
    if (threadIdx.x == 0) (void)xb_add(&bar[XB_XCNT(b.x)], 1u);
    return b;
}
__device__ __forceinline__ void xcd_barrier_complete(unsigned* bar, unsigned x, unsigned& nloc, unsigned& nx) {
    const unsigned G = gridDim.x * gridDim.y * gridDim.z;
    unsigned sum, cnt, mine, sp = 0u;
    for (;;) {
        sum = 0u; cnt = 0u; mine = 0u;
#pragma unroll
        for (unsigned j = 0; j < 16; ++j) { const unsigned c = xb_ld(&bar[XB_XCNT(j)]); sum += c; cnt += (c > 0u) ? 1u : 0u; mine = (j == x) ? c : mine; }
        if (sum == G) break;
        __builtin_amdgcn_s_sleep(1);
        if ((++sp & 255u) == 0u) { if (xb_ld(&bar[XB_TMO])) break; if (sp > XB_SPIN_CAP) { atomicAdd(&bar[XB_TMO], 1u); break; } }
    }
    nloc = mine > 0u ? mine : 1u; nx = cnt > 0u ? cnt : 1u;
}

__device__ __forceinline__ void xcd_barrier(const XcdBarrier& b) {
    asm volatile("s_waitcnt vmcnt(0)" ::: "memory");
    __syncthreads();
    if (threadIdx.x == 0) {
        unsigned* bar = b.bar;
        __builtin_amdgcn_s_waitcnt(0);
        unsigned nloc = b.st[0], nx = b.st[1];
        if (nloc == 0u) { xcd_barrier_complete(bar, b.x, nloc, nx); b.st[0] = nloc; b.st[1] = nx; }
        const unsigned old = xb_add(&bar[XB_XSUB(b.x)], 1u);
        const unsigned gen = old / nloc;
        if (old + 1u == (gen + 1u) * nloc) {
            __builtin_amdgcn_fence(__ATOMIC_RELEASE, "agent");
            asm volatile("s_waitcnt vmcnt(0)" ::: "memory");
            const unsigned og = xb_add(&bar[XB_TOP], 1u);
            const unsigned tg = og / nx;
            if (og + 1u == (tg + 1u) * nx) xb_add(&bar[XB_TOPGEN], 1u);
            else XB_SPIN(xb_ld(&bar[XB_TOPGEN]) == tg, bar);
            __builtin_amdgcn_fence(__ATOMIC_ACQUIRE, "agent");
            xb_add(&bar[XB_XGEN(b.x)], 1u);
            asm volatile("s_waitcnt vmcnt(0)" ::: "memory");
        } else {
            XB_SPIN(xb_ld(&bar[XB_XGEN(b.x)]) == gen, bar);
            __builtin_amdgcn_fence(__ATOMIC_ACQUIRE, "agent");
            asm volatile("s_waitcnt vmcnt(0)" ::: "memory");
        }
    }
    __syncthreads();
}

constexpr int LDS_BYTES = 131072;
__global__ void __launch_bounds__(NT, 2) fwd_megakernel(Params p0) {
  cg::grid_group grid = cg::this_grid();
  extern __shared__ __attribute__((aligned(16))) unsigned char shm[];
  char* smem = (char*)shm;
  PG8_LAS unsigned char* lds = (PG8_LAS unsigned char*)shm;
  const int nb = gridDim.x, bid = blockIdx.x, nw = gridDim.x * (NT / 64);
  __shared__ __attribute__((aligned(16))) unsigned xb_st[4];
  if (threadIdx.x < 4) xb_st[threadIdx.x] = 0u;
  __syncthreads();
  const XcdBarrier xbar = xcd_barrier_post((unsigned*)(p0.ws + OFF_BAR), (volatile XLAS unsigned*)xb_st);
#define GSYNC() xcd_barrier(xbar)
#define PH_BEGIN const Params p = launder(p0); const int tid = ltid(); const int lane = tid & 63; const int gw = bid * (NT / 64) + (tid >> 6); (void)lane; (void)gw;
  { PH_BEGIN phase0(p, tid); }
  grid.sync();
#pragma unroll 1
  for (int layer = 0; layer < 2; ++layer) {
    {
      PH_BEGIN
      InProjEpi epi{p.ws};
      run_gemm(lds, (const bf16_t*)(p.ws + OFF_X), (const bf16_t*)(p.ws + OFF_WIN) + (size_t)layer * NPAD * 1024, NTOK, NPAD, 1024, epi, tid);
    }
    if (layer == 0 && bid >= 192 && bid < 216) {
      PH_BEGIN
      const int l2 = (bid - 192) / 12, c = (bid - 192) - 12 * l2;
      MemKvEpi me{p.ws, l2};
      run_gemm_on(lds, (const bf16_t*)(p.ws + OFF_MEMN), (const bf16_t*)(p.ws + OFF_WMEM) + (size_t)l2 * 512 * 1024, 1536, 512, 1024, me, tid, 12, c);
    }
    GSYNC();
    { PH_BEGIN
#pragma unroll 1
      for (int t = bid; t < 1536; t += nb) na_block(p, layer, t, smem, tid); }
    { PH_BEGIN
#pragma unroll 1
      for (int t = gw; t < NTOK / 8; t += nw) gdn_prep_tok8(p, layer, t, lane); }
    GSYNC();
    { PH_BEGIN
      const int half = tid >> 8;
#pragma unroll 1
      for (int t = bid; t < 1536; t += nb) chunk_task(p, 2 * t + half, smem + half * 36864, tid & 255); }
    GSYNC();
    if (bid < 48) { PH_BEGIN scan_task(p, bid, smem, tid); }
    else { PH_BEGIN
#pragma unroll 1
      for (int t = bid - 48; t < 768; t += nb - 48) fft_task(p, t, (float2*)smem, tid);
#pragma unroll 1
      for (int t = bid - 48; t < 768; t += nb - 48) mem_block(p, layer, t, smem, tid); }
    GSYNC();
    { PH_BEGIN
#pragma unroll 1
      for (int t = gw; t < NTOK / 4; t += nw) gdn_finish_tok4(p, layer, 4 * t, lane); }
    {
      PH_BEGIN
      FnetEpiDirect fe{p.ws};
      { pg8::Gemm g; g.A = (const bf16_t*)(p.ws + OFF_H); g.Bt = (const bf16_t*)(p.ws + OFF_WF) + (size_t)layer * 256 * 512; g.M = NTOK; g.N = 256; g.K = 512;
        pg8::StaticOrder S; S.init(NTOK, 256, (int)gridDim.x, (int)blockIdx.x);
        pg8::gemm_phase<FnetEpiDirect, pg8::StaticOrder, false>(lds, g, S, fe, nullptr, tid);
        __syncthreads(); }
    }
    GSYNC();
    {
      PH_BEGIN
      OutEpi oe{(bf16_t*)(p.ws + OFF_OUTTMP)};
      run_gemm(lds, (const bf16_t*)(p.ws + OFF_MIX), (const bf16_t*)(p.ws + OFF_WOUT) + (size_t)layer * 1024 * 1024, NTOK, 1024, 1024, oe, tid);
    }
    GSYNC();
    { PH_BEGIN
#pragma unroll 1
      for (int t = gw; t < NTOK / 2; t += nw) post_token2(p, layer, 2 * t, lane); }
    if (layer == 0) GSYNC();
  }
}

extern "C" void kernel_launch(void* const* d_in, const int* in_sizes, int n_in, void* d_out, int out_size, void* d_ws, size_t ws_size, hipStream_t stream) {
  static int grid_blocks = 0;
  if (!grid_blocks) {
    int dev = 0, cus = 0, per_cu = 0;
    (void)hipGetDevice(&dev);
    (void)hipDeviceGetAttribute(&cus, hipDeviceAttributeMultiprocessorCount, dev);
    if (hipFuncSetAttribute((const void*)fwd_megakernel, hipFuncAttributeMaxDynamicSharedMemorySize, LDS_BYTES) != hipSuccess) fprintf(stderr, "hipFuncSetAttribute failed\n");
    (void)hipOccupancyMaxActiveBlocksPerMultiprocessor(&per_cu, fwd_megakernel, NT, LDS_BYTES);
    if (per_cu > 1) per_cu = 1;
    grid_blocks = cus * per_cu;
    if (grid_blocks <= 0) { fprintf(stderr, "occupancy query returned %d x %d\n", cus, per_cu); grid_blocks = -1; }
  }
  if (grid_blocks < 0) return;
  if (ws_size < WS_NEED || n_in != 16) { fprintf(stderr, "kernel_launch: need %zu bytes of workspace, got %zu (n_in %d)\n", (size_t)WS_NEED, ws_size, n_in); return; }
  Params p{};
  p.x_prompt = (const float*)d_in[0]; p.x_sample = (const float*)d_in[1]; p.mem_prompt = (const float*)d_in[2]; p.mem_sample = (const float*)d_in[3];
  p.pre_g = (const float*)d_in[4]; p.post_g = (const float*)d_in[5]; p.w_in = (const float*)d_in[6]; p.w_fnet = (const float*)d_in[7];
  p.conv_w = (const float*)d_in[8]; p.a_log = (const float*)d_in[9]; p.dt_bias = (const float*)d_in[10]; p.gdn_g = (const float*)d_in[11];
  p.rpb = (const float*)d_in[12]; p.mem_g = (const float*)d_in[13]; p.w_mem_kv = (const float*)d_in[14]; p.w_out = (const float*)d_in[15];
  p.out = (float*)d_out; p.ws = (unsigned char*)d_ws;
  if (hipMemsetAsync((unsigned char*)d_ws + OFF_BAR, 0, XCD_BAR_WORDS * sizeof(unsigned), stream) != hipSuccess) { fprintf(stderr, "memset failed\n"); return; }
  void* args[] = {&p};
  hipError_t e = hipLaunchCooperativeKernel((void*)fwd_megakernel, dim3(grid_blocks), dim3(NT), args, LDS_BYTES, stream);
  if (e != hipSuccess) fprintf(stderr, "cooperative launch failed: %s (grid %d)\n", hipGetErrorString(e), grid_blocks);
}
```

```cpp
#include <hip/hip_runtime.h>
#include <hip/hip_cooperative_groups.h>
#include <cstdio>
namespace cg = cooperative_groups;

typedef unsigned short bf16_t;
typedef short bf16x8 __attribute__((ext_vector_type(8)));
typedef float f32x4 __attribute__((ext_vector_type(4)));

#define NT 512
#define DI __device__ __forceinline__
#define MFMA16(a, b, c) __builtin_amdgcn_mfma_f32_16x16x32_bf16((a), (b), (c), 0, 0, 0)

constexpr int SEQL = 8192, NTOK = 49152;
constexpr size_t MiB = (size_t)1 << 20;
constexpr int NPAD = 3328;
constexpr size_t OFF_WIN = 0, OFF_WOUT = 13631488, OFF_WMEM = 17825792, OFF_WF = 19922944, OFF_MEMN = 20447232,
                 OFF_KMEM = 23592960, OFF_VMEMT = 25165824, OFF_TW = 26738688;
constexpr size_t OFF_MIX = 26 * MiB, OFF_AZ = 122 * MiB, OFF_CZ = 146 * MiB, OFF_DZ = 170 * MiB, OFF_GATES = 194 * MiB, OFF_X = 197 * MiB,
                 OFF_BQKV = 293 * MiB, OFF_CK = 365 * MiB, OFF_CVT = 389 * MiB;
constexpr size_t OFF_H = OFF_X, OFF_QN = 245 * MiB, OFF_KN = 269 * MiB, OFF_KT = 464 * MiB, OFF_VN = 488 * MiB;
constexpr size_t OFF_CHW = 293 * MiB, OFF_CHU = 341 * MiB, OFF_CHQK = 389 * MiB, OFF_CVEC = 437 * MiB;
constexpr size_t OFF_OF = OFF_KN, OFF_OB = OFF_VN, OFF_OUTTMP = 293 * MiB;
constexpr size_t OFF_BAR = 26771456;
constexpr size_t WS_NEED = 512 * MiB;

struct Params {
  const float* x_prompt; const float* x_sample; const float* mem_prompt; const float* mem_sample;
  const float* pre_g; const float* post_g; const float* w_in; const float* w_fnet; const float* conv_w;
  const float* a_log; const float* dt_bias; const float* gdn_g; const float* rpb; const float* mem_g;
  const float* w_mem_kv; const float* w_out;
  float* out; unsigned char* ws;
};

typedef float f32x2_t __attribute__((ext_vector_type(2)));
typedef __bf16 bf16x2_t __attribute__((ext_vector_type(2)));
DI unsigned pack2(float lo, float hi) { f32x2_t f = {lo, hi}; return __builtin_bit_cast(unsigned, __builtin_convertvector(f, bf16x2_t)); }
DI bf16_t f2bf(float x) { return (bf16_t)(pack2(x, 0.f) & 0xffffu); }
DI float bf2f(bf16_t h) { return __uint_as_float(((unsigned)h) << 16); }
DI float bflo(unsigned u) { return __uint_as_float(u << 16); }
DI float bfhi(unsigned u) { return __uint_as_float(u & 0xffff0000u); }
DI float wave_sum(float v) {
#pragma unroll
  for (int m = 32; m >= 1; m >>= 1) v += __shfl_xor(v, m, 64);
  return v;
}
DI float silu(float x) { return x * __builtin_amdgcn_rcpf(1.f + __expf(-x)); }
DI bf16x8 pack8(const f32x4& a, const f32x4& b) {
  uint4 u; u.x = pack2(a[0], a[1]); u.y = pack2(a[2], a[3]); u.z = pack2(b[0], b[1]); u.w = pack2(b[2], b[3]);
  return __builtin_bit_cast(bf16x8, u);
}
DI bf16x8 ld8(const bf16_t* p) { return *(const bf16x8*)p; }
DI bf16x8 ld4x2(const bf16_t* lo, const bf16_t* hi) {
  uint2 a = *(const uint2*)lo, b = *(const uint2*)hi; uint4 u; u.x = a.x; u.y = a.y; u.z = b.x; u.w = b.y;
  return __builtin_bit_cast(bf16x8, u);
}
DI int ltid() { int t = threadIdx.x; asm volatile("" : "+v"(t)); return t; }
DI Params launder(Params p) { size_t z = 0; asm volatile("" : "+s"(z)); p.ws = p.ws + z; return p; }
DI const float* xrow(const Params& p, int tok) {
  return tok < 32768 ? p.x_prompt + (size_t)tok * 1024 : p.x_sample + (size_t)(tok - 32768) * 1024;
}

DI void norm_row_bf16(const float* src, bf16_t* dst, int lane) {
  float4 v[4]; float ss = 0.f;
#pragma unroll
  for (int i = 0; i < 4; ++i) { v[i] = *(const float4*)(src + i * 256 + lane * 4); ss += v[i].x * v[i].x + v[i].y * v[i].y + v[i].z * v[i].z + v[i].w * v[i].w; }
  ss = wave_sum(ss);
  const float rs = rsqrtf(ss * (1.f / 1024.f) + 1e-6f);
#pragma unroll
  for (int i = 0; i < 4; ++i) { uint2 o; o.x = pack2(v[i].x * rs, v[i].y * rs); o.y = pack2(v[i].z * rs, v[i].w * rs); *(uint2*)(dst + i * 256 + lane * 4) = o; }
}

DI void phase0(const Params& p, const int tid) {
  const int gtid = blockIdx.x * NT + tid, gsz = gridDim.x * NT;
  bf16_t* WinT = (bf16_t*)(p.ws + OFF_WIN);
  for (int idx = gtid; idx < 2 * NPAD * 128; idx += gsz) {
    const int l = idx / (NPAD * 128); const int rem = idx - l * NPAD * 128; const int k8 = rem / NPAD; const int r = rem - k8 * NPAD;
    const int src = r < 1536 ? r : (r < 3072 ? r + 16 : (r < 3088 ? 1536 + (r - 3072) : -1));
    uint4 o = make_uint4(0, 0, 0, 0);
    if (src >= 0) {
      const float* w = p.w_in + ((size_t)l * 1024 + k8 * 8) * 3088 + src;
      const float* g = p.pre_g + l * 1024 + k8 * 8;
      float v[8];
#pragma unroll
      for (int j = 0; j < 8; ++j) v[j] = w[(size_t)j * 3088] * g[j];
      o.x = pack2(v[0], v[1]); o.y = pack2(v[2], v[3]); o.z = pack2(v[4], v[5]); o.w = pack2(v[6], v[7]);
    }
    *(uint4*)(WinT + ((size_t)l * NPAD + r) * 1024 + k8 * 8) = o;
  }
  bf16_t* WoutT = (bf16_t*)(p.ws + OFF_WOUT);
  for (int idx = gtid; idx < 2 * 1024 * 128; idx += gsz) {
    const int l = idx / (1024 * 128); const int rem = idx - l * 1024 * 128; const int k8 = rem / 1024; const int r = rem - k8 * 1024;
    const float* w = p.w_out + ((size_t)l * 1024 + k8 * 8) * 1024 + r;
    float v[8];
#pragma unroll
    for (int j = 0; j < 8; ++j) v[j] = w[(size_t)j * 1024];
    uint4 o; o.x = pack2(v[0], v[1]); o.y = pack2(v[2], v[3]); o.z = pack2(v[4], v[5]); o.w = pack2(v[6], v[7]);
    *(uint4*)(WoutT + ((size_t)l * 1024 + r) * 1024 + k8 * 8) = o;
  }
  bf16_t* WmemT = (bf16_t*)(p.ws + OFF_WMEM);
  for (int idx = gtid; idx < 2 * 512 * 128; idx += gsz) {
    const int l = idx / (512 * 128); const int rem = idx - l * 512 * 128; const int k8 = rem / 512; const int r = rem - k8 * 512;
    const float* w = p.w_mem_kv + ((size_t)l * 1024 + k8 * 8) * 512 + r;
    const float* g = p.mem_g + l * 1024 + k8 * 8;
    float v[8];
#pragma unroll
    for (int j = 0; j < 8; ++j) v[j] = w[(size_t)j * 512] * g[j];
    uint4 o; o.x = pack2(v[0], v[1]); o.y = pack2(v[2], v[3]); o.z = pack2(v[4], v[5]); o.w = pack2(v[6], v[7]);
    *(uint4*)(WmemT + ((size_t)l * 512 + r) * 1024 + k8 * 8) = o;
  }
  bf16_t* WfT = (bf16_t*)(p.ws + OFF_WF);
  const float fscale = 0.00138106793f;
  for (int idx = gtid; idx < 2 * 256 * 512; idx += gsz) {
    const int l = idx >> 17; const int rem = idx & 131071; const int kk = rem >> 8; const int j = rem & 255;
    const int k2 = kk & 255, blk = k2 >> 6, cp = k2 & 63;
    const float* w = p.w_fnet + ((size_t)l * 256 + blk * 64) * 256 + j;
    float a = 0.f;
    for (int c = 0; c < 64; ++c) {
      const float turns = (float)((c * cp) & 63) * (1.f / 64.f);
      const float tr = kk < 256 ? __builtin_amdgcn_cosf(turns) : __builtin_amdgcn_sinf(turns);
      a += tr * w[(size_t)c * 256];
    }
    WfT[((size_t)l * 256 + j) * 512 + kk] = f2bf(a * fscale);
  }
  float2* tw = (float2*)(p.ws + OFF_TW);
  for (int t = gtid; t < 4096; t += gsz) { float s, c; sincospif((float)t * (1.f / 4096.f), &s, &c); tw[t] = make_float2(c, -s); }
  const int lane = tid & 63, gw = blockIdx.x * (NT / 64) + (tid >> 6), nw = gridDim.x * (NT / 64);
  bf16_t* memn = (bf16_t*)(p.ws + OFF_MEMN);
  for (int r = gw; r < 1536; r += nw) {
    const float* src = r < 1024 ? p.mem_prompt + (size_t)r * 1024 : p.mem_sample + (size_t)(r - 1024) * 1024;
    norm_row_bf16(src, memn + (size_t)r * 1024, lane);
  }
  bf16_t* xn = (bf16_t*)(p.ws + OFF_X);
  for (int t = gw; t < NTOK / 2; t += nw) {
    const float* s0 = xrow(p, 2 * t); const float* s1 = xrow(p, 2 * t + 1);
    float4 v0[4], v1[4]; float a0 = 0.f, a1 = 0.f;
#pragma unroll
    for (int i = 0; i < 4; ++i) { v0[i] = *(const float4*)(s0 + i * 256 + lane * 4); v1[i] = *(const float4*)(s1 + i * 256 + lane * 4); }
#pragma unroll
    for (int i = 0; i < 4; ++i) { a0 += v0[i].x * v0[i].x + v0[i].y * v0[i].y + v0[i].z * v0[i].z + v0[i].w * v0[i].w; a1 += v1[i].x * v1[i].x + v1[i].y * v1[i].y + v1[i].z * v1[i].z + v1[i].w * v1[i].w; }
    a0 = wave_sum(a0); a1 = wave_sum(a1);
    const float r0 = rsqrtf(a0 * (1.f / 1024.f) + 1e-6f), r1 = rsqrtf(a1 * (1.f / 1024.f) + 1e-6f);
    bf16_t* d0 = xn + (size_t)(2 * t) * 1024; bf16_t* d1 = d0 + 1024;
#pragma unroll
    for (int i = 0; i < 4; ++i) {
      uint2 o; o.x = pack2(v0[i].x * r0, v0[i].y * r0); o.y = pack2(v0[i].z * r0, v0[i].w * r0); *(uint2*)(d0 + i * 256 + lane * 4) = o;
      o.x = pack2(v1[i].x * r1, v1[i].y * r1); o.y = pack2(v1[i].z * r1, v1[i].w * r1); *(uint2*)(d1 + i * 256 + lane * 4) = o;
    }
  }
}

namespace pg8 {
#define PG8_LAS __attribute__((address_space(3)))
typedef unsigned short bf16_t;
typedef short bf16x8 __attribute__((ext_vector_type(8)));
typedef float f32x4 __attribute__((ext_vector_type(4)));
typedef unsigned u32x4 __attribute__((ext_vector_type(4)));
constexpr int BM = 256, BK = 64, HALF = 128, HTB = HALF * BK * 2  , STAGE_BYTES = 8 * HTB, NXCD = 8, WGM = 8;

__host__ __device__ __forceinline__ int lds_byte(int r, int c) { const int st = (r >> 4) * 2 + (c >> 5), rr = r & 15, cc = c & 31, ob = rr * 64 + cc * 2; return st * 1024 + (ob ^ (((ob >> 9) & 1) << 5)); }
__host__ __device__ __forceinline__ void stage_rc(int b, int& R, int& C) { const int st = b / 1024, sb = b % 1024, swz = sb ^ (((sb >> 9) & 1) << 5); R = (st >> 1) * 16 + swz / 64; C = (st & 1) * 32 + (swz % 64) / 2; }
__host__ __device__ __forceinline__ int perm32(int rho) { const int n = rho >> 4, i = rho & 15; return 8 * (i >> 2) + 4 * n + (i & 3); }

struct Unit { int pm, pn; };
struct Gemm { const bf16_t* A; const bf16_t* Bt; int M, N, K; };

struct StaticOrder {
    int nM, nN, nwg, G, c;
    __host__ __device__ void init(int M, int N, int G_, int c_) { nM = M / BM; nN = N / BM; nwg = nM * nN; G = G_; c = c_; }
    __host__ __device__ bool next(int i, Unit& u) const {
        const long L = (long)i * G + c; if (L >= nwg) return false;
        int wgid = (int)L; { const int q = nwg / NXCD, r = nwg % NXCD, xcd = wgid % NXCD, off = wgid / NXCD; wgid = (xcd < r ? xcd * (q + 1) : r * (q + 1) + (xcd - r) * q) + off; }
        const int nig = WGM * nN, gid = wgid / nig, fm = gid * WGM, gsz = (nM - fm) < WGM ? (nM - fm) : WGM;
        u.pm = fm + ((wgid % nig) % gsz); u.pn = (wgid % nig) / gsz; return true;
    }
    __device__ __forceinline__ void a_ready(const Unit&) const {}
    __device__ __forceinline__ void done(const Unit&) const {}
};
template <class Epi, class Sched, bool STAMP = false>
__device__ __forceinline__ void gemm_phase(PG8_LAS unsigned char* lds, const Gemm g, const Sched& S, const Epi& E, unsigned long long* stamps, const int tid_in) {
    const int tid = tid_in, wid = __builtin_amdgcn_readfirstlane(tid >> 6), lane = tid & 63, wr = wid >> 2, wc = wid & 3, fr = lane & 15, fq = lane >> 4;
    const int K = g.K, nt = K / BK;
    int ts_lo = 0, ts_hi = 0, nts = 0; const unsigned long long rt_entry = STAMP ? (unsigned long long)wall_clock64() : 0ull;
#define PG8_STAMP() do { if (STAMP && wid == 0 && nts < 64) { const unsigned long long _c = (unsigned long long)clock64(); \
        ts_lo = (lane == nts) ? (int)(unsigned)_c : ts_lo; ts_hi = (lane == nts) ? (int)(unsigned)(_c >> 32) : ts_hi; ++nts; } } while (0)
    PG8_STAMP();
    unsigned voffA[2], voffB[2];
#pragma unroll
    for (int i = 0; i < 2; ++i) { int R, C; stage_rc(tid * 16 + i * 8192, R, C); const int Rb = Epi::PERM ? ((R & ~31) + perm32(R & 31)) : R;
        voffA[i] = (unsigned)(R * K + C) * 2u; voffB[i] = (unsigned)(Rb * K + C) * 2u; }
    const size_t kstep = (size_t)(BK * 2);
    const size_t hstep = (size_t)HALF * K * 2;
    const size_t tstep = 2 * hstep;
    const unsigned ldsw = (unsigned)wid * 1024u;
    const int aoff = lds_byte(wr * 64 + fr, fq * 8), boff = lds_byte(wc * 32 + fr, fq * 8);
#define PG8_SA(b, h) (((b) * 2 + (h)) * HTB)
#define PG8_SB(b, h) ((4 + (b) * 2 + (h)) * HTB)
#define PG8_STAGE(bufoff, gbase, voff) do { _Pragma("unroll") for (int _i = 0; _i < 2; ++_i) \
        __builtin_amdgcn_global_load_lds((const unsigned*)((const char*)(gbase) + (voff)[_i]), (PG8_LAS unsigned*)(lds + (bufoff) + ldsw + _i * 8192), 16, 0, 0); } while (0)
#define PG8_LDA(dst, b, h) do { _Pragma("unroll") for (int m = 0; m < 4; ++m) _Pragma("unroll") for (int k = 0; k < 2; ++k) dst[m][k] = *(const PG8_LAS bf16x8*)(lds + PG8_SA(b, h) + aoff + m * 2048 + k * 1024); } while (0)
#define PG8_LDB(dst, b, h) do { _Pragma("unroll") for (int n = 0; n < 2; ++n) _Pragma("unroll") for (int k = 0; k < 2; ++k) dst[n][k] = *(const PG8_LAS bf16x8*)(lds + PG8_SB(b, h) + boff + n * 2048 + k * 1024); } while (0)
#define PG8_MMA(ai, bj, At, Bt) do { __builtin_amdgcn_s_setprio(1); _Pragma("unroll") for (int m = 0; m < 4; ++m) _Pragma("unroll") for (int n = 0; n < 2; ++n) _Pragma("unroll") for (int k = 0; k < 2; ++k) \
        acc[ai][bj][m][n] = __builtin_amdgcn_mfma_f32_16x16x32_bf16(Bt[n][k], At[m][k], acc[ai][bj][m][n], 0, 0, 0); __builtin_amdgcn_s_setprio(0); } while (0)
#define PG8_WAIT_V(n) asm volatile("s_waitcnt vmcnt(" #n ")" ::: "memory")
#define PG8_WAIT_L(n) asm volatile("s_waitcnt lgkmcnt(" #n ")" ::: "memory")
#define PG8_BAR __builtin_amdgcn_s_barrier()
#define PG8_SCHED __builtin_amdgcn_sched_barrier(0)
    Unit cur, nxt; int ui = 0;
    if (!S.next(0, cur)) return;
    f32x4 acc[2][2][4][2];
#pragma unroll
    for (int a = 0; a < 2; ++a)
#pragma unroll
        for (int b = 0; b < 2; ++b)
#pragma unroll
            for (int m = 0; m < 4; ++m)
#pragma unroll
                for (int n = 0; n < 2; ++n) acc[a][b][m][n] = (f32x4){0.f, 0.f, 0.f, 0.f};
    bf16x8 At[4][2], B0[2][2], B1[2][2];
    const char* cA = (const char*)g.A + (size_t)cur.pm * tstep; const char* cB = (const char*)g.Bt + (size_t)cur.pn * tstep;
    S.a_ready(cur);
    PG8_STAGE(PG8_SB(0, 0), cB, voffB); PG8_STAGE(PG8_SA(0, 0), cA, voffA); PG8_STAGE(PG8_SB(0, 1), cB + hstep, voffB); PG8_STAGE(PG8_SA(0, 1), cA + hstep, voffA);
    if (wr == 1) PG8_BAR;
    PG8_WAIT_V(4); PG8_BAR;
    PG8_STAGE(PG8_SB(1, 0), cB + kstep, voffB); PG8_STAGE(PG8_SA(1, 0), cA + kstep, voffA); PG8_STAGE(PG8_SB(1, 1), cB + hstep + kstep, voffB);
    PG8_WAIT_V(6); PG8_BAR;
    PG8_STAMP();
    for (;;) {
        const bool has_next = S.next(ui + 1, nxt);
        const char* nA = has_next ? (const char*)g.A + (size_t)nxt.pm * tstep : cA; const char* nB = has_next ? (const char*)g.Bt + (size_t)nxt.pn * tstep : cB;
        for (int t = 0; t < nt; t += 2) {
            const bool last = (t == nt - 2);
            const char* a1 = cA + (size_t)(t + 1) * kstep;
            const char* a2 = last ? nA : cA + (size_t)(t + 2) * kstep; const char* b2 = last ? nB : cB + (size_t)(t + 2) * kstep;
            const char* a3 = a2 + kstep; const char* b3 = b2 + kstep;
            if (last && has_next) S.a_ready(nxt);
            PG8_LDB(B0, 0, 0); PG8_SCHED; PG8_LDA(At, 0, 0); PG8_STAGE(PG8_SA(1, 1), a1 + hstep, voffA);
            PG8_WAIT_L(8); PG8_BAR; PG8_WAIT_L(0); PG8_MMA(0, 0, At, B0); PG8_BAR; PG8_SCHED;
            PG8_LDB(B1, 0, 1); PG8_STAGE(PG8_SB(0, 0), b2, voffB);
            PG8_BAR; PG8_WAIT_L(0); PG8_MMA(0, 1, At, B1); PG8_BAR;
            PG8_LDA(At, 0, 1); PG8_STAGE(PG8_SA(0, 0), a2, voffA);
            PG8_BAR; PG8_WAIT_L(0); PG8_MMA(1, 0, At, B0); PG8_BAR; PG8_SCHED;
            PG8_STAGE(PG8_SB(0, 1), b2 + hstep, voffB);
            PG8_WAIT_V(6); PG8_BAR; PG8_MMA(1, 1, At, B1); PG8_BAR;
            PG8_LDB(B0, 1, 0); PG8_SCHED; PG8_LDA(At, 1, 0); PG8_STAGE(PG8_SA(0, 1), a2 + hstep, voffA);
            PG8_WAIT_L(8); PG8_BAR; PG8_WAIT_L(0); PG8_MMA(0, 0, At, B0); PG8_BAR; PG8_SCHED;
            PG8_LDB(B1, 1, 1); PG8_STAGE(PG8_SB(1, 0), b3, voffB);
            PG8_BAR; PG8_WAIT_L(0); PG8_MMA(0, 1, At, B1); PG8_BAR;
            PG8_LDA(At, 1, 1); PG8_STAGE(PG8_SA(1, 0), a3, voffA);
            PG8_BAR; PG8_WAIT_L(0); PG8_MMA(1, 0, At, B0); PG8_BAR; PG8_SCHED;
            PG8_STAGE(PG8_SB(1, 1), b3 + hstep, voffB);
            PG8_WAIT_V(6); PG8_BAR; PG8_MMA(1, 1, At, B1); PG8_BAR;
        }
        PG8_STAMP();
        if constexpr (!Epi::AFTER_DRAIN) { E(acc, cur, wr, wc, fr, fq); S.done(cur); }
        PG8_STAMP();
        if (!has_next) break;
#pragma unroll
        for (int a = 0; a < 2; ++a)
#pragma unroll
            for (int b = 0; b < 2; ++b)
#pragma unroll
                for (int m = 0; m < 4; ++m)
#pragma unroll
                    for (int n = 0; n < 2; ++n) acc[a][b][m][n] = (f32x4){0.f, 0.f, 0.f, 0.f};
        cur = nxt; cA = nA; cB = nB; ++ui;
    }
    PG8_WAIT_V(0);
    if (wr == 0) PG8_BAR;
    PG8_BAR;
    if constexpr (Epi::AFTER_DRAIN) { E.fused(acc, cur, wr, wc, fr, fq, lds, wid, lane); S.done(cur); }
    PG8_STAMP();
    if (STAMP && wid == 0) { stamps[lane] = lane < nts ? (((unsigned long long)(unsigned)ts_hi << 32) | (unsigned)ts_lo) : 0ull;
        if (lane == 62) stamps[62] = rt_entry; if (lane == 63) stamps[63] = (unsigned long long)wall_clock64(); }
#undef PG8_STAMP
#undef PG8_SA
#undef PG8_SB
#undef PG8_STAGE
#undef PG8_LDA
#undef PG8_LDB
#undef PG8_MMA
#undef PG8_WAIT_V
#undef PG8_WAIT_L
#undef PG8_BAR
#undef PG8_SCHED
}
}

template <class F> struct EpiWrap {
  static constexpr bool PERM = false, AFTER_DRAIN = false;
  F f;
  DI void operator()(const f32x4 (&acc)[2][2][4][2], const pg8::Unit& u, int wr, int wc, int fr, int fq) const {
#pragma unroll
    for (int ai = 0; ai < 2; ++ai)
#pragma unroll
      for (int m = 0; m < 4; ++m) {
        const int row = u.pm * 256 + ai * 128 + wr * 64 + m * 16 + fr;
#pragma unroll
        for (int bj = 0; bj < 2; ++bj)
#pragma unroll
          for (int n = 0; n < 2; ++n) f(u.pn * 256 + bj * 128 + wc * 32 + n * 16 + 4 * fq, row, acc[ai][bj][m][n]);
      }
  }
};
template <class F>
DI void run_gemm_on(PG8_LAS unsigned char* lds, const bf16_t* A, const bf16_t* Bt, int M, int N, int K, const F& f, const int tid, int G, int c) {
  pg8::Gemm g; g.A = A; g.Bt = Bt; g.M = M; g.N = N; g.K = K;
  pg8::StaticOrder S; S.init(M, N, G, c);
  EpiWrap<F> E{f};
  pg8::gemm_phase<EpiWrap<F>, pg8::StaticOrder, false>(lds, g, S, E, nullptr, tid);
  __syncthreads();
}
template <class F>
DI void run_gemm(PG8_LAS unsigned char* lds, const bf16_t* A, const bf16_t* Bt, int M, int N, int K, const F& f, const int tid) {
  pg8::Gemm g; g.A = A; g.Bt = Bt; g.M = M; g.N = N; g.K = K;
  pg8::StaticOrder S; S.init(M, N, (int)gridDim.x, (int)blockIdx.x);
  EpiWrap<F> E{f};
  pg8::gemm_phase<EpiWrap<F>, pg8::StaticOrder, false>(lds, g, S, E, nullptr, tid);
  __syncthreads();
}

struct InProjEpi {
  unsigned char* ws;
  DI void operator()(int m, int n, const f32x4& v) const {
    if (m < 3072) {
      const int blk = m >> 8, c = m & 255;
      if (blk == 8) {
        bf16_t* cvt = (bf16_t*)(ws + OFF_CVT);
        const int seq = n >> 13, l = n & 8191;
        bf16_t* d = cvt + ((size_t)(seq * 256 + c)) * 8192 + l;
#pragma unroll
        for (int e = 0; e < 4; ++e) d[(size_t)e * 8192] = f2bf(v[e]);
      } else {
        bf16_t* d;
        if (blk >= 2 && blk <= 4) d = (bf16_t*)(ws + OFF_BQKV) + (size_t)n * 768 + (blk - 2) * 256 + c;
        else if (blk == 0 || blk == 5 || blk == 6 || blk == 10) d = (bf16_t*)(ws + OFF_MIX) + (size_t)n * 1024 + (blk == 0 ? 0 : blk == 5 ? 256 : blk == 6 ? 512 : 768) + c;
        else {
          size_t off = blk == 1 ? OFF_AZ : blk == 7 ? OFF_CK : blk == 9 ? OFF_CZ : OFF_DZ;
          d = (bf16_t*)(ws + off) + (size_t)n * 256 + c;
        }
        uint2 o; o.x = pack2(v[0], v[1]); o.y = pack2(v[2], v[3]); *(uint2*)d = o;
      }
    } else if (m < 3088) {
      float* g = (float*)(ws + OFF_GATES) + (size_t)n * 16 + (m - 3072);
      *(float4*)g = make_float4(v[0], v[1], v[2], v[3]);
    }
  }
};
struct MemKvEpi {
  unsigned char* ws; int l;
  DI void operator()(int m, int n, const f32x4& v) const {
    const int seq = n >> 8, key = n & 255;
    if (m < 256) {
      const int head = m >> 6, dim = m & 63;
      bf16_t* d = (bf16_t*)(ws + OFF_KMEM) + ((size_t)((l * 6 + seq) * 4 + head) * 256 + key) * 64 + dim;
      uint2 o; o.x = pack2(v[0], v[1]); o.y = pack2(v[2], v[3]); *(uint2*)d = o;
    } else {
      const int c = m - 256, head = c >> 6, dim = c & 63;
      bf16_t* d = (bf16_t*)(ws + OFF_VMEMT) + ((size_t)((l * 6 + seq) * 4 + head) * 64 + dim) * 256 + key;
#pragma unroll
      for (int e = 0; e < 4; ++e) d[e * 256] = f2bf(v[e]);
    }
  }
};
struct FnetEpi {
  unsigned char* ws;
  DI void operator()(int m, int n, const f32x4& v) const {
    const uint2 z = *(const uint2*)((const bf16_t*)(ws + OFF_AZ) + (size_t)n * 256 + m);
    uint2 o; o.x = pack2(v[0] * silu(bflo(z.x)), v[1] * silu(bfhi(z.x))); o.y = pack2(v[2] * silu(bflo(z.y)), v[3] * silu(bfhi(z.y)));
    *(uint2*)((bf16_t*)(ws + OFF_MIX) + (size_t)n * 1024 + m) = o;
  }
};
struct FnetEpiDirect {
  static constexpr bool PERM = false, AFTER_DRAIN = false;
  unsigned char* ws;
  DI void operator()(const f32x4 (&acc)[2][2][4][2], const pg8::Unit& u, int wr, int wc, int fr, int fq) const {
    const bf16_t* AZ = (const bf16_t*)(ws + OFF_AZ); bf16_t* MX = (bf16_t*)(ws + OFF_MIX);
    const int col0 = u.pn * 256 + wc * 32 + 4 * fq;
#pragma unroll
    for (int ai = 0; ai < 2; ++ai)
#pragma unroll
      for (int m2 = 0; m2 < 2; ++m2) {
        uint2 z[2][2][2];
#pragma unroll
        for (int mm = 0; mm < 2; ++mm) {
          const size_t row = (size_t)(u.pm * 256 + ai * 128 + wr * 64 + (2 * m2 + mm) * 16 + fr);
#pragma unroll
          for (int bj = 0; bj < 2; ++bj)
#pragma unroll
            for (int n = 0; n < 2; ++n) z[mm][bj][n] = *(const uint2*)(AZ + row * 256 + col0 + bj * 128 + n * 16);
        }
#pragma unroll
        for (int mm = 0; mm < 2; ++mm) {
          const size_t row = (size_t)(u.pm * 256 + ai * 128 + wr * 64 + (2 * m2 + mm) * 16 + fr);
#pragma unroll
          for (int bj = 0; bj < 2; ++bj)
#pragma unroll
            for (int n = 0; n < 2; ++n) {
              const f32x4 v = acc[ai][bj][2 * m2 + mm][n]; const uint2 zz = z[mm][bj][n];
              uint2 o; o.x = pack2(v[0] * silu(bflo(zz.x)), v[1] * silu(bfhi(zz.x))); o.y = pack2(v[2] * silu(bflo(zz.y)), v[3] * silu(bfhi(zz.y)));
              *(uint2*)(MX + row * 1024 + col0 + bj * 128 + n * 16) = o;
            }
        }
      }
  }
};
struct OutEpi {
  bf16_t* dst;
  DI void operator()(int m, int n, const f32x4& v) const { uint2 o; o.x = pack2(v[0], v[1]); o.y = pack2(v[2], v[3]); *(uint2*)(dst + (size_t)n * 1024 + m) = o; }
};

DI int fft_pos(int k) {
  return ((k & 1) << 12) | (((k >> 1) & 3) << 10) | (((k >> 3) & 3) << 8) | (((k >> 5) & 3) << 6) | (((k >> 7) & 3) << 4) | (((k >> 9) & 3) << 2) | ((k >> 11) & 3);
}
DI void fft_task(const Params& p, int task, float2* z, const int tid) {
  const int seq = task >> 7, cp = task & 127;
  const unsigned* au = (const unsigned*)(p.ws + OFF_MIX) + (size_t)seq * 8192 * 512 + cp;
  const float2* tw = (const float2*)(p.ws + OFF_TW);
  for (int i = tid; i < 8192; i += NT) { const unsigned u = au[(size_t)i * 512]; z[i] = make_float2(bflo(u), bfhi(u)); }
  __syncthreads();
  for (int b = tid; b < 4096; b += NT) {
    const float2 a = z[b], c = z[b + 4096], w = tw[b];
    z[b] = make_float2(a.x + c.x, a.y + c.y);
    const float dx = a.x - c.x, dy = a.y - c.y;
    z[b + 4096] = make_float2(dx * w.x - dy * w.y, dx * w.y + dy * w.x);
  }
  __syncthreads();
#pragma unroll 1
  for (int s4 = 0; s4 < 6; ++s4) {
    const int lq = 10 - 2 * s4, q = 1 << lq;
    for (int b = tid; b < 2048; b += NT) {
      const int j = b & (q - 1), i0 = ((b >> lq) << (lq + 2)) + j;
      const float2 a0 = z[i0], a1 = z[i0 + q], a2 = z[i0 + 2 * q], a3 = z[i0 + 3 * q];
      const float2 w1 = tw[j << (1 + 2 * s4)];
      const float2 w2 = make_float2(w1.x * w1.x - w1.y * w1.y, 2.f * w1.x * w1.y);
      const float2 w3 = make_float2(w2.x * w1.x - w2.y * w1.y, w2.x * w1.y + w2.y * w1.x);
      const float t0x = a0.x + a2.x, t0y = a0.y + a2.y, t1x = a0.x - a2.x, t1y = a0.y - a2.y;
      const float t2x = a1.x + a3.x, t2y = a1.y + a3.y, t3x = a1.y - a3.y, t3y = -(a1.x - a3.x);
      z[i0] = make_float2(t0x + t2x, t0y + t2y);
      const float y1x = t1x + t3x, y1y = t1y + t3y, y2x = t0x - t2x, y2y = t0y - t2y, y3x = t1x - t3x, y3y = t1y - t3y;
      z[i0 + q] = make_float2(y1x * w1.x - y1y * w1.y, y1x * w1.y + y1y * w1.x);
      z[i0 + 2 * q] = make_float2(y2x * w2.x - y2y * w2.y, y2x * w2.y + y2y * w2.x);
      z[i0 + 3 * q] = make_float2(y3x * w3.x - y3y * w3.y, y3x * w3.y + y3y * w3.x);
    }
    __syncthreads();
  }
  unsigned* H = (unsigned*)(p.ws + OFF_H) + (size_t)seq * 8192 * 256;
  for (int k = tid; k < 8192; k += NT) {
    const float2 zk = z[fft_pos(k)], zn = z[fft_pos((8192 - k) & 8191)];
    H[(size_t)k * 256 + cp] = pack2(0.5f * (zk.x + zn.x), 0.5f * (zk.y + zn.y));
    H[(size_t)k * 256 + 128 + cp] = pack2(0.5f * (zk.y - zn.y), -0.5f * (zk.x - zn.x));
  }
  __syncthreads();
}

template <bool NA>
DI void attn_core(const Params& p, int layer, int h, int tok0, int r, int c0, int rs, int wsx, const bf16_t* sK, const bf16_t* sVT, const float* sBias, int kb, int pitch, int vstride, int lane) {
  const int fr = lane & 15, fq = lane >> 4;
  bf16_t* Q = (bf16_t*)(p.ws + OFF_MIX) + (NA ? 512 : 768);
  const bf16_t* Z = (const bf16_t*)(p.ws + (NA ? OFF_CZ : OFF_DZ));
  const bf16_t* qp = Q + (size_t)(tok0 + fr) * 1024 + h * 64 + fq * 8;
  bf16x8 qf[2]; qf[0] = ld8(qp); qf[1] = ld8(qp + 32);
  f32x4 s[16];
#pragma unroll
  for (int kt = 0; kt < 16; ++kt) {
    const bf16_t* kp = sK + (kb + (kt >> 1) * pitch + (kt & 1) * 16 + fr) * 72 + fq * 8;
    f32x4 a = (f32x4){0.f, 0.f, 0.f, 0.f};
    a = MFMA16(ld8(kp), qf[0], a);
    a = MFMA16(ld8(kp + 32), qf[1], a);
    s[kt] = a;
  }
  float mx = -1e30f;
  if (NA) {
    const int c = c0 + fr, cs = min(max(c - 8, 0), 48);
#pragma unroll
    for (int kt = 0; kt < 16; ++kt) {
      const int kr = rs + (kt >> 1);
      const float* rb = sBias + (kr - r + 7) * 31;
#pragma unroll
      for (int e = 0; e < 4; ++e) {
        const int kc = wsx + (kt & 1) * 16 + 4 * fq + e;
        const bool valid = kc >= cs && kc < cs + 16;
        const float bias = rb[min(max(kc - c + 15, 0), 30)];
        const float v = valid ? s[kt][e] * 0.125f + bias : -1e30f;
        s[kt][e] = v; mx = fmaxf(mx, v);
      }
    }
  } else {
#pragma unroll
    for (int kt = 0; kt < 16; ++kt)
#pragma unroll
      for (int e = 0; e < 4; ++e) { const float v = s[kt][e] * 0.125f; s[kt][e] = v; mx = fmaxf(mx, v); }
  }
  mx = fmaxf(mx, __shfl_xor(mx, 16, 64)); mx = fmaxf(mx, __shfl_xor(mx, 32, 64));
  float sum = 0.f;
#pragma unroll
  for (int kt = 0; kt < 16; ++kt)
#pragma unroll
    for (int e = 0; e < 4; ++e) { const float pv = __expf(s[kt][e] - mx); s[kt][e] = pv; sum += pv; }
  sum += __shfl_xor(sum, 16, 64); sum += __shfl_xor(sum, 32, 64);
  const float inv = 1.f / sum;
  f32x4 o[4];
#pragma unroll
  for (int mt = 0; mt < 4; ++mt) o[mt] = (f32x4){0.f, 0.f, 0.f, 0.f};
#pragma unroll
  for (int u = 0; u < 8; ++u) {
    const bf16x8 pb = pack8(s[2 * u], s[2 * u + 1]);
#pragma unroll
    for (int mt = 0; mt < 4; ++mt) {
      const bf16_t* vp = sVT + (16 * mt + fr) * vstride + kb + u * pitch + 4 * fq;
      o[mt] = MFMA16(ld4x2(vp, vp + 16), pb, o[mt]);
    }
  }
  const size_t orow = (size_t)(tok0 + fr) * 256 + h * 64 + 4 * fq, qrow = (size_t)(tok0 + fr) * 1024 + h * 64 + 4 * fq;
  uint2 zg[4];
#pragma unroll
  for (int mt = 0; mt < 4; ++mt) zg[mt] = *(const uint2*)(Z + orow + 16 * mt);
#pragma unroll
  for (int mt = 0; mt < 4; ++mt) {
    const uint2 z = zg[mt];
    uint2 w; w.x = pack2(o[mt][0] * inv * silu(bflo(z.x)), o[mt][1] * inv * silu(bfhi(z.x)));
    w.y = pack2(o[mt][2] * inv * silu(bflo(z.y)), o[mt][3] * inv * silu(bfhi(z.y)));
    *(uint2*)(Q + qrow + 16 * mt) = w;
  }
}
DI void na_block(const Params& p, int layer, int bt, char* smem, const int tid) {
  const int half = bt & 1, rg = (bt >> 1) & 31, h = (bt >> 6) & 3, seq = bt >> 8;
  const int r0 = rg * 4, rsmin = min(max(r0 - 4, 0), 120), nrows = min(11, 128 - rsmin), colbase = half ? 24 : 0;
  bf16_t* sK = (bf16_t*)smem; bf16_t* sVT = sK + 440 * 72; float* sBias = (float*)(sVT + 64 * 456);
  if (tid < 465) sBias[tid] = p.rpb[(size_t)(layer * 4 + h) * 465 + tid];
  const bf16_t* CK = (const bf16_t*)(p.ws + OFF_CK) + (size_t)(seq * 8192 + rsmin * 64 + colbase) * 256 + h * 64;
  const bf16_t* CVT = (const bf16_t*)(p.ws + OFF_CVT) + (size_t)(seq * 4 + h) * 64 * 8192 + rsmin * 64 + colbase;
  {
    const int nk = nrows * 40 * 8, per_dim = nrows * 5, nv = 64 * per_dim;
    uint4 rk[7], rv[7]; int dk[7], dv[7];
#pragma unroll
    for (int i = 0; i < 7; ++i) {
      const int idx = tid + NT * i;
      const int key = idx >> 3, ch = idx & 7, ri = key / 40, cj = key - ri * 40;
      dk[i] = idx < nk ? key * 72 + ch * 8 : -1;
      rk[i] = idx < nk ? *(const uint4*)(CK + (size_t)(ri * 64 + cj) * 256 + ch * 8) : make_uint4(0, 0, 0, 0);
      const int dim = idx / per_dim, rem = idx - dim * per_dim, r2 = rem / 5, c5 = rem - r2 * 5;
      dv[i] = idx < nv ? dim * 456 + r2 * 40 + c5 * 8 : -1;
      rv[i] = idx < nv ? *(const uint4*)(CVT + (size_t)dim * 8192 + r2 * 64 + c5 * 8) : make_uint4(0, 0, 0, 0);
    }
#pragma unroll
    for (int i = 0; i < 7; ++i) { if (dk[i] >= 0) *(uint4*)(sK + dk[i]) = rk[i]; if (dv[i] >= 0) *(uint4*)(sVT + dv[i]) = rv[i]; }
  }
  __syncthreads();
  {
    const int wave = tid >> 6, lane = tid & 63;
    const int r = r0 + (wave >> 1), c0 = 32 * half + 16 * (wave & 1);
    const int rs = min(max(r - 4, 0), 120), wsx = min(max(c0 - 8, 0), 32);
    attn_core<true>(p, layer, h, seq * 8192 + r * 64 + c0, r, c0, rs, wsx, sK, sVT, sBias, (rs - rsmin) * 40 + (wsx - colbase), 40, 456, lane);
  }
  __syncthreads();
}
DI void mem_block(const Params& p, int layer, int bt, char* smem, const int tid) {
  const int g = bt & 31, h = (bt >> 5) & 3, seq = bt >> 7;
  bf16_t* sK = (bf16_t*)smem; bf16_t* sVT = sK + 256 * 72;
  const bf16_t* Kg = (const bf16_t*)(p.ws + OFF_KMEM) + (size_t)((layer * 6 + seq) * 4 + h) * 256 * 64;
  const bf16_t* Vg = (const bf16_t*)(p.ws + OFF_VMEMT) + (size_t)((layer * 6 + seq) * 4 + h) * 64 * 256;
  {
    uint4 rk[4], rv[4];
#pragma unroll
    for (int i = 0; i < 4; ++i) { const int idx = tid + NT * i; rk[i] = *(const uint4*)(Kg + (size_t)idx * 8); rv[i] = *(const uint4*)(Vg + (size_t)idx * 8); }
#pragma unroll
    for (int i = 0; i < 4; ++i) { const int idx = tid + NT * i; *(uint4*)(sK + (idx >> 3) * 72 + (idx & 7) * 8) = rk[i]; *(uint4*)(sVT + (idx >> 5) * 264 + (idx & 31) * 8) = rv[i]; }
  }
  __syncthreads();
  {
    const int wave = tid >> 6, lane = tid & 63;
#pragma unroll 1
    for (int i = 0; i < 2; ++i) { int kb0 = 0; asm volatile("" : "+v"(kb0));
      attn_core<false>(p, layer, h, seq * 8192 + (g * 16 + wave * 2 + i) * 16, 0, 0, 0, 0, sK, sVT, nullptr, kb0, 32, 264, lane); }
  }
  __syncthreads();
}

DI void gdn_prep_tok8(const Params& p, int layer, int task, int lane) {
  const int tok0 = task * 8, seq = tok0 >> 13, l0 = tok0 & 8191;
  const bf16_t* X = (const bf16_t*)(p.ws + OFF_BQKV);
  const float* cw = p.conv_w + (size_t)layer * 5 * 768;
  unsigned kp[4][4];
#pragma unroll
  for (int i = 0; i < 3; ++i) {
    const int c = i * 256 + lane * 4;
    uint2 x[12];
#pragma unroll
    for (int jj = 0; jj < 12; ++jj) {
      const int ll = l0 + jj - 2;
      x[jj] = (ll >= 0 && ll < 8192) ? *(const uint2*)(X + (size_t)(tok0 + jj - 2) * 768 + c) : make_uint2(0u, 0u);
    }
    float4 w[5];
#pragma unroll
    for (int j = 0; j < 5; ++j) w[j] = *(const float4*)(cw + j * 768 + c);
    bf16_t* dst = (bf16_t*)(p.ws + (i == 0 ? OFF_QN : i == 1 ? OFF_KN : OFF_VN)) + (size_t)tok0 * 256 + lane * 4;
#pragma unroll
    for (int t = 0; t < 8; ++t) {
      float a0 = 0.f, a1 = 0.f, a2 = 0.f, a3 = 0.f;
#pragma unroll
      for (int j = 0; j < 5; ++j) { const uint2 xv = x[t + j]; a0 += w[j].x * bflo(xv.x); a1 += w[j].y * bfhi(xv.x); a2 += w[j].z * bflo(xv.y); a3 += w[j].w * bfhi(xv.y); }
      a0 = silu(a0); a1 = silu(a1); a2 = silu(a2); a3 = silu(a3);
      if (i < 2) {
        float ss = a0 * a0 + a1 * a1 + a2 * a2 + a3 * a3;
        ss += __shfl_xor(ss, 1, 64); ss += __shfl_xor(ss, 2, 64); ss += __shfl_xor(ss, 4, 64); ss += __shfl_xor(ss, 8, 64);
        const float rs = rsqrtf(ss + 1e-6f) * (i == 0 ? 0.125f : 1.f);
        a0 *= rs; a1 *= rs; a2 *= rs; a3 *= rs;
      }
      uint2 o; o.x = pack2(a0, a1); o.y = pack2(a2, a3);
      *(uint2*)(dst + (size_t)t * 256) = o;
      if (i == 1) {
        if (t & 1) { kp[0][t >> 1] |= (unsigned)f2bf(a0) << 16; kp[1][t >> 1] |= (unsigned)f2bf(a1) << 16; kp[2][t >> 1] |= (unsigned)f2bf(a2) << 16; kp[3][t >> 1] |= (unsigned)f2bf(a3) << 16; }
        else { kp[0][t >> 1] = f2bf(a0); kp[1][t >> 1] = f2bf(a1); kp[2][t >> 1] = f2bf(a2); kp[3][t >> 1] = f2bf(a3); }
      }
    }
  }
  bf16_t* kT = (bf16_t*)(p.ws + OFF_KT) + ((size_t)seq * 256 + lane * 4) * 8192 + l0;
#pragma unroll
  for (int e = 0; e < 4; ++e) *(uint4*)(kT + (size_t)e * 8192) = make_uint4(kp[e][0], kp[e][1], kp[e][2], kp[e][3]);
#pragma unroll
  for (int i2 = 0; i2 < 2; ++i2) {
    const int idx = lane + 64 * i2, gi = idx & 15;
    float* g = (float*)(p.ws + OFF_GATES) + (size_t)tok0 * 16 + idx;
    const float x = *g;
    float r;
    if (gi < 8) {
      const float y = x + p.dt_bias[layer * 8 + gi];
      const float sp = fmaxf(y, 0.f) + __logf(1.f + __expf(-fabsf(y)));
      r = -__expf(p.a_log[layer * 8 + gi]) * sp;
    } else r = __builtin_amdgcn_rcpf(1.f + __expf(-x));
    *g = r;
  }
}

DI void chunk_task(const Params& p, int bt, char* smem, const int tid) {
  const int n = bt & 127, head = (bt >> 7) & 3, seq = bt >> 9;
  const int lane = tid & 63, wave = tid >> 6, fr = lane & 15, fq = lane >> 4;
  float* sL = (float*)smem;
  float* sg = (float*)(smem + 32768);
  float* sbeta = sg + 128; float* sG = sbeta + 128;
  const float* gb = (const float*)(p.ws + OFF_GATES);
  const bf16_t* qn = (const bf16_t*)(p.ws + OFF_QN); const bf16_t* kn = (const bf16_t*)(p.ws + OFF_KN); const bf16_t* vn = (const bf16_t*)(p.ws + OFF_VN);
  const int tokbase = seq * 8192;
  if (tid < 128) {
    const int d = tid >> 6, r = tid & 63; const int pos = d ? 8191 - 64 * n - r : 64 * n + r;
    sg[tid] = gb[(size_t)(tokbase + pos) * 16 + d * 4 + head]; sbeta[tid] = gb[(size_t)(tokbase + pos) * 16 + 8 + d * 4 + head];
  }
  __syncthreads();
  if (tid < 128) {
    float a = sg[tid];
#pragma unroll
    for (int off = 1; off < 64; off <<= 1) { const float t = __shfl_up(a, off, 64); if (lane >= off) a += t; }
    sG[tid] = a;
  }
  __syncthreads();
  {
    const int d = wave >> 1;
    const int ct = ((seq * 4 + head) * 2 + d) * 128 + n;
    if ((wave & 1) == 0) {
      float* cv = (float*)(p.ws + OFF_CVEC) + (size_t)ct * 256;
      const float G = sG[d * 64 + lane], Gl = sG[d * 64 + 63];
      cv[lane] = __expf(G); cv[64 + lane] = __expf(Gl - G); if (lane == 0) cv[128] = __expf(Gl);
    }
    bf16_t* chqk = (bf16_t*)(p.ws + OFF_CHQK) + (size_t)ct * 4096;
    const int hoff = head * 64 + fq * 8;
    bf16x8 kB[4][2];
#pragma unroll
    for (int nt = 0; nt < 4; ++nt) {
      const int rB = 16 * nt + fr; const int posB = d ? 8191 - 64 * n - rB : 64 * n + rB;
      const size_t ob = (size_t)(tokbase + posB) * 256 + hoff;
      kB[nt][0] = ld8(kn + ob); kB[nt][1] = ld8(kn + ob + 32);
    }
    bf16x8 kA[2][2], qA[2][2];
#pragma unroll
    for (int si = 0; si < 2; ++si) {
      const int rA = 16 * (2 * (wave & 1) + si) + fr; const int posA = d ? 8191 - 64 * n - rA : 64 * n + rA;
      const size_t oa = (size_t)(tokbase + posA) * 256 + hoff;
      kA[si][0] = ld8(kn + oa); kA[si][1] = ld8(kn + oa + 32); qA[si][0] = ld8(qn + oa); qA[si][1] = ld8(qn + oa + 32);
    }
#pragma unroll
    for (int si = 0; si < 2; ++si) {
      const int strip = 2 * (wave & 1) + si;
#pragma unroll
      for (int nt = 0; nt < 4; ++nt) {
        f32x4 kk = (f32x4){0.f, 0.f, 0.f, 0.f}, qk = (f32x4){0.f, 0.f, 0.f, 0.f};
        kk = MFMA16(kA[si][0], kB[nt][0], kk); kk = MFMA16(kA[si][1], kB[nt][1], kk);
        qk = MFMA16(qA[si][0], kB[nt][0], qk); qk = MFMA16(qA[si][1], kB[nt][1], qk);
        const int sc = 16 * nt + fr;
#pragma unroll
        for (int e = 0; e < 4; ++e) {
          const int r = 16 * strip + 4 * fq + e;
          const float dec = sc <= r ? __expf(sG[d * 64 + r] - sG[d * 64 + sc]) : 0.f;
          sL[d * 4096 + r * 64 + sc] = sc < r ? sbeta[d * 64 + r] * kk[e] * dec : 0.f;
          chqk[r * 64 + sc] = f2bf(qk[e] * dec);
        }
      }
    }
  }
  __syncthreads();
  {
    const int wvu = __builtin_amdgcn_readfirstlane(wave);
    const int d = wvu >> 1, half = wvu & 1;
    const int ct = ((seq * 4 + head) * 2 + d) * 128 + n;
    const bf16_t* src = (half ? kn : vn) + (size_t)(tokbase + (d ? 8191 - 64 * n : 64 * n)) * 256 + head * 64 + lane;
    const int rstep = d ? -256 : 256;
    float sol[64];
#pragma unroll
    for (int r = 0; r < 64; ++r) sol[r] = bf2f(src[r * rstep]);
#pragma unroll
    for (int r4 = 0; r4 < 16; ++r4) {
      const float4 b4 = *(const float4*)(sbeta + d * 64 + 4 * r4); const float4 g4 = *(const float4*)(sG + d * 64 + 4 * r4);
      sol[4 * r4 + 0] *= half ? b4.x * __expf(g4.x) : b4.x; sol[4 * r4 + 1] *= half ? b4.y * __expf(g4.y) : b4.y;
      sol[4 * r4 + 2] *= half ? b4.z * __expf(g4.z) : b4.z; sol[4 * r4 + 3] *= half ? b4.w * __expf(g4.w) : b4.w;
    }
    const float* Ld = sL + d * 4096;
#pragma unroll
    for (int b = 0; b < 4; ++b) {
#pragma unroll
      for (int j4 = 0; j4 < 4 * b; ++j4) {
        float4 lv[16];
#pragma unroll
        for (int q = 0; q < 16; ++q) lv[q] = *(const float4*)(Ld + (16 * b + q) * 64 + 4 * j4);
#pragma unroll
        for (int q = 0; q < 16; ++q) {
          float a = sol[16 * b + q];
          a -= lv[q].x * sol[4 * j4 + 0]; a -= lv[q].y * sol[4 * j4 + 1]; a -= lv[q].z * sol[4 * j4 + 2]; a -= lv[q].w * sol[4 * j4 + 3];
          sol[16 * b + q] = a;
        }
      }
#pragma unroll
      for (int g4 = 0; g4 < 4; ++g4) {
        float4 lv[16];
#pragma unroll
        for (int q = 4 * g4 + 1; q < 16; ++q) lv[q] = *(const float4*)(Ld + (16 * b + q) * 64 + 16 * b + 4 * g4);
        sol[16 * b + 4 * g4 + 1] -= lv[4 * g4 + 1].x * sol[16 * b + 4 * g4];
        sol[16 * b + 4 * g4 + 2] -= lv[4 * g4 + 2].x * sol[16 * b + 4 * g4] + lv[4 * g4 + 2].y * sol[16 * b + 4 * g4 + 1];
        sol[16 * b + 4 * g4 + 3] -= lv[4 * g4 + 3].x * sol[16 * b + 4 * g4] + lv[4 * g4 + 3].y * sol[16 * b + 4 * g4 + 1] + lv[4 * g4 + 3].z * sol[16 * b + 4 * g4 + 2];
#pragma unroll
        for (int q = 4 * g4 + 4; q < 16; ++q) {
          float a = sol[16 * b + q];
          a -= lv[q].x * sol[16 * b + 4 * g4 + 0]; a -= lv[q].y * sol[16 * b + 4 * g4 + 1]; a -= lv[q].z * sol[16 * b + 4 * g4 + 2]; a -= lv[q].w * sol[16 * b + 4 * g4 + 3];
          sol[16 * b + q] = a;
        }
      }
    }
    if (!half) {
      bf16_t* chu = (bf16_t*)(p.ws + OFF_CHU) + (size_t)ct * 4096 + lane * 64;
#pragma unroll
      for (int r8 = 0; r8 < 8; ++r8) {
        uint4 o; o.x = pack2(sol[r8 * 8 + 0], sol[r8 * 8 + 1]); o.y = pack2(sol[r8 * 8 + 2], sol[r8 * 8 + 3]);
        o.z = pack2(sol[r8 * 8 + 4], sol[r8 * 8 + 5]); o.w = pack2(sol[r8 * 8 + 6], sol[r8 * 8 + 7]);
        *(uint4*)(chu + r8 * 8) = o;
      }
    } else {
      bf16_t* chw = (bf16_t*)(p.ws + OFF_CHW) + (size_t)ct * 4096 + lane;
#pragma unroll
      for (int r = 0; r < 64; ++r) chw[r * 64] = f2bf(sol[r]);
    }
  }
  __syncthreads();
}

DI uint4 rev8(uint4 v) {
  uint4 r;
  r.x = (v.w >> 16) | (v.w << 16); r.y = (v.z >> 16) | (v.z << 16); r.z = (v.y >> 16) | (v.y << 16); r.w = (v.x >> 16) | (v.x << 16);
  return r;
}
DI void scan_task(const Params& p, int task, char* smem, const int tid) {
  const int d = task & 1, head = (task >> 1) & 3, seq = task >> 3;
  const bool loader = tid >= 256;
  const int lt = tid & 255, lane = tid & 63, wave = lt >> 6, fr = lane & 15, fq = lane >> 4;
  const int row0 = lt >> 3, c8 = (lt & 7) * 8, rc8 = (7 - (lt & 7)) * 8;
  constexpr int BUFB = 49152;
  const int ctb = ((seq * 4 + head) * 2 + d) * 128;
  const bf16_t* chw = (const bf16_t*)(p.ws + OFF_CHW); const bf16_t* chu = (const bf16_t*)(p.ws + OFF_CHU); const bf16_t* chqk = (const bf16_t*)(p.ws + OFF_CHQK);
  const float* cvec = (const float*)(p.ws + OFF_CVEC);
  const bf16_t* qn = (const bf16_t*)(p.ws + OFF_QN) + (size_t)seq * 8192 * 256 + head * 64;
  const bf16_t* kT = (const bf16_t*)(p.ws + OFF_KT) + (size_t)(seq * 256 + head * 64) * 8192;
  bf16_t* O = (bf16_t*)(p.ws + (d ? OFF_OB : OFF_OF)) + (size_t)seq * 8192 * 256 + head * 64 + 32 * (wave & 1) + fr;
#define SCAN_STAGE(n_, buf_) do { \
    const size_t cb = (size_t)(ctb + (n_)) * 4096 + row0 * 64 + c8; \
    const uint4 rw0 = *(const uint4*)(chw + cb), rw1 = *(const uint4*)(chw + cb + 2048); \
    const uint4 rqk0 = *(const uint4*)(chqk + cb), rqk1 = *(const uint4*)(chqk + cb + 2048); \
    const uint4 ru0 = *(const uint4*)(chu + cb), ru1 = *(const uint4*)(chu + cb + 2048); \
    const int pos0 = d ? 8191 - 64 * (n_) - row0 : 64 * (n_) + row0, pos1 = d ? pos0 - 32 : pos0 + 32; \
    const uint4 rq0 = *(const uint4*)(qn + (size_t)pos0 * 256 + c8), rq1 = *(const uint4*)(qn + (size_t)pos1 * 256 + c8); \
    const int lbase = d ? 8191 - 64 * (n_) - 63 : 64 * (n_); \
    const uint4 rkt0 = *(const uint4*)(kT + (size_t)row0 * 8192 + lbase + c8), rkt1 = *(const uint4*)(kT + (size_t)(row0 + 32) * 8192 + lbase + c8); \
    const float rv = cvec[(size_t)(ctb + (n_)) * 256 + (lt < 129 ? lt : 128)]; \
    bf16_t* sW_ = (bf16_t*)(smem + (buf_) * BUFB); bf16_t* sQK_ = sW_ + 64 * 72; bf16_t* sQ_ = sQK_ + 64 * 72; bf16_t* sKT_ = sQ_ + 64 * 72; bf16_t* sU_ = sKT_ + 64 * 72; \
    float* sV_ = (float*)(smem + (buf_) * BUFB + 5 * 64 * 72 * 2); \
    *(uint4*)(sW_ + row0 * 72 + c8) = rw0; *(uint4*)(sW_ + (row0 + 32) * 72 + c8) = rw1; \
    *(uint4*)(sQK_ + row0 * 72 + c8) = rqk0; *(uint4*)(sQK_ + (row0 + 32) * 72 + c8) = rqk1; \
    *(uint4*)(sU_ + row0 * 72 + c8) = ru0; *(uint4*)(sU_ + (row0 + 32) * 72 + c8) = ru1; \
    *(uint4*)(sQ_ + row0 * 72 + c8) = rq0; *(uint4*)(sQ_ + (row0 + 32) * 72 + c8) = rq1; \
    if (d) { *(uint4*)(sKT_ + row0 * 72 + rc8) = rev8(rkt0); *(uint4*)(sKT_ + (row0 + 32) * 72 + rc8) = rev8(rkt1); } \
    else { *(uint4*)(sKT_ + row0 * 72 + c8) = rkt0; *(uint4*)(sKT_ + (row0 + 32) * 72 + c8) = rkt1; } \
    if (lt < 129) sV_[lt] = rv; } while (0)
#define SCAN_BAR() do { asm volatile("s_waitcnt lgkmcnt(0)" ::: "memory"); __builtin_amdgcn_s_barrier(); asm volatile("" ::: "memory"); } while (0)
  f32x4 S[4][2];
#pragma unroll
  for (int mt = 0; mt < 4; ++mt) { S[mt][0] = (f32x4){0.f, 0.f, 0.f, 0.f}; S[mt][1] = (f32x4){0.f, 0.f, 0.f, 0.f}; }
#define SCAN_LDF(f_, base_, h2_) do { _Pragma("unroll") for (int m2 = 0; m2 < 2; ++m2) { const bf16_t* p_ = (base_) + (16 * (2 * (h2_) + m2) + fr) * 72 + 4 * fq; \
    f_[m2][0] = ld4x2(p_, p_ + 16); f_[m2][1] = ld4x2(p_ + 32, p_ + 48); } } while (0)
#define SCAN_SB() __builtin_amdgcn_sched_barrier(0)
#define SCAN_COMPUTE(n_, buf_) do { \
    const bf16_t* sW = (const bf16_t*)(smem + (buf_) * BUFB); const bf16_t* sQK = sW + 64 * 72; const bf16_t* sQ = sQK + 64 * 72; const bf16_t* sKT = sQ + 64 * 72; const bf16_t* sU = sKT + 64 * 72; \
    const float* sV = (const float*)(smem + (buf_) * BUFB + 5 * 64 * 72 * 2); \
    bf16x8 fA[2][2], fB[2][2]; \
    SCAN_LDF(fA, sW, 0); SCAN_SB(); \
    bf16x8 Sb[2][2]; \
    _Pragma("unroll") for (int nt = 0; nt < 2; ++nt) { Sb[0][nt] = pack8(S[0][nt], S[1][nt]); Sb[1][nt] = pack8(S[2][nt], S[3][nt]); } \
    f32x4 v[4][2], o[4][2]; \
      \
    SCAN_LDF(fB, sW, 1); \
    _Pragma("unroll") for (int m2 = 0; m2 < 2; ++m2) _Pragma("unroll") for (int nt = 0; nt < 2; ++nt) { \
      v[m2][nt] = MFMA16(fA[m2][0], Sb[0][nt], ((f32x4){0.f, 0.f, 0.f, 0.f})); v[m2][nt] = MFMA16(fA[m2][1], Sb[1][nt], v[m2][nt]); } \
    SCAN_SB(); \
    SCAN_LDF(fA, sQ, 0); \
    _Pragma("unroll") for (int m2 = 0; m2 < 2; ++m2) _Pragma("unroll") for (int nt = 0; nt < 2; ++nt) { \
      v[2 + m2][nt] = MFMA16(fB[m2][0], Sb[0][nt], ((f32x4){0.f, 0.f, 0.f, 0.f})); v[2 + m2][nt] = MFMA16(fB[m2][1], Sb[1][nt], v[2 + m2][nt]); } \
    SCAN_SB(); \
    SCAN_LDF(fB, sQ, 1); \
    _Pragma("unroll") for (int m2 = 0; m2 < 2; ++m2) _Pragma("unroll") for (int nt = 0; nt < 2; ++nt) { \
      o[m2][nt] = MFMA16(fA[m2][0], Sb[0][nt], ((f32x4){0.f, 0.f, 0.f, 0.f})); o[m2][nt] = MFMA16(fA[m2][1], Sb[1][nt], o[m2][nt]); } \
    SCAN_SB(); \
    SCAN_LDF(fA, sKT, 0); \
    _Pragma("unroll") for (int m2 = 0; m2 < 2; ++m2) _Pragma("unroll") for (int nt = 0; nt < 2; ++nt) { \
      o[2 + m2][nt] = MFMA16(fB[m2][0], Sb[0][nt], ((f32x4){0.f, 0.f, 0.f, 0.f})); o[2 + m2][nt] = MFMA16(fB[m2][1], Sb[1][nt], o[2 + m2][nt]); } \
    SCAN_SB(); \
    bf16x8 Vb[2][2], Vkb[2][2]; \
    {   \
      _Pragma("unroll") for (int mt = 0; mt < 4; ++mt) { \
        const float4 eg = *(const float4*)(sV + 16 * mt + 4 * fq); \
        _Pragma("unroll") for (int nt = 0; nt < 2; ++nt) { \
          const uint2 u = *(const uint2*)(sU + (32 * wave + 16 * nt + fr) * 72 + 16 * mt + 4 * fq); \
          v[mt][nt][0] = bflo(u.x) - v[mt][nt][0]; v[mt][nt][1] = bfhi(u.x) - v[mt][nt][1]; v[mt][nt][2] = bflo(u.y) - v[mt][nt][2]; v[mt][nt][3] = bfhi(u.y) - v[mt][nt][3]; \
          o[mt][nt][0] *= eg.x; o[mt][nt][1] *= eg.y; o[mt][nt][2] *= eg.z; o[mt][nt][3] *= eg.w; } \
      } \
      _Pragma("unroll") for (int nt = 0; nt < 2; ++nt) { \
        Vb[0][nt] = pack8(v[0][nt], v[1][nt]); Vb[1][nt] = pack8(v[2][nt], v[3][nt]); } \
      _Pragma("unroll") for (int mt = 0; mt < 4; ++mt) { \
        const float4 ek = *(const float4*)(sV + 64 + 16 * mt + 4 * fq); \
        _Pragma("unroll") for (int nt = 0; nt < 2; ++nt) { v[mt][nt][0] *= ek.x; v[mt][nt][1] *= ek.y; v[mt][nt][2] *= ek.z; v[mt][nt][3] *= ek.w; } } \
      _Pragma("unroll") for (int nt = 0; nt < 2; ++nt) { \
        Vkb[0][nt] = pack8(v[0][nt], v[1][nt]); Vkb[1][nt] = pack8(v[2][nt], v[3][nt]); } \
    } \
    const float gl = sV[128]; \
    SCAN_SB(); \
    SCAN_LDF(fB, sKT, 1); \
    _Pragma("unroll") for (int m2 = 0; m2 < 2; ++m2) _Pragma("unroll") for (int nt = 0; nt < 2; ++nt) { \
      f32x4 a; a[0] = S[m2][nt][0] * gl; a[1] = S[m2][nt][1] * gl; a[2] = S[m2][nt][2] * gl; a[3] = S[m2][nt][3] * gl; \
      a = MFMA16(fA[m2][0], Vkb[0][nt], a); S[m2][nt] = MFMA16(fA[m2][1], Vkb[1][nt], a); } \
    SCAN_SB(); \
    SCAN_LDF(fA, sQK, 0); \
    _Pragma("unroll") for (int m2 = 0; m2 < 2; ++m2) _Pragma("unroll") for (int nt = 0; nt < 2; ++nt) { \
      f32x4 a; a[0] = S[2 + m2][nt][0] * gl; a[1] = S[2 + m2][nt][1] * gl; a[2] = S[2 + m2][nt][2] * gl; a[3] = S[2 + m2][nt][3] * gl; \
      a = MFMA16(fB[m2][0], Vkb[0][nt], a); S[2 + m2][nt] = MFMA16(fB[m2][1], Vkb[1][nt], a); } \
    SCAN_SB(); \
    SCAN_LDF(fB, sQK, 1); \
    _Pragma("unroll") for (int m2 = 0; m2 < 2; ++m2) _Pragma("unroll") for (int nt = 0; nt < 2; ++nt) { \
      o[m2][nt] = MFMA16(fA[m2][0], Vb[0][nt], o[m2][nt]); o[m2][nt] = MFMA16(fA[m2][1], Vb[1][nt], o[m2][nt]); } \
    SCAN_SB(); \
    _Pragma("unroll") for (int m2 = 0; m2 < 2; ++m2) _Pragma("unroll") for (int nt = 0; nt < 2; ++nt) { \
      o[2 + m2][nt] = MFMA16(fB[m2][0], Vb[0][nt], o[2 + m2][nt]); o[2 + m2][nt] = MFMA16(fB[m2][1], Vb[1][nt], o[2 + m2][nt]); } \
    _Pragma("unroll") for (int mt = 0; mt < 4; ++mt) _Pragma("unroll") for (int e = 0; e < 4; ++e) { \
      const int r_ = 16 * mt + 4 * fq + e; const int pos = d ? 8191 - 64 * (n_) - r_ : 64 * (n_) + r_; \
      O[(size_t)pos * 256] = f2bf(o[mt][0][e]); O[(size_t)pos * 256 + 16] = f2bf(o[mt][1][e]); \
    } } while (0)
  __syncthreads();
  if (loader) SCAN_STAGE(0, 0);
  SCAN_BAR();
#pragma unroll 1
  for (int n = 0; n < 128; ++n) {
    if (loader) { if (n + 1 < 128) SCAN_STAGE(n + 1, ((n + 1) & 1)); }
    else if (wave < 2) SCAN_COMPUTE(n, (n & 1));
    SCAN_BAR();
  }
  asm volatile("s_waitcnt vmcnt(0)" ::: "memory");
  __syncthreads();
#undef SCAN_STAGE
#undef SCAN_BAR
#undef SCAN_COMPUTE
#undef SCAN_LDF
#undef SCAN_SB
}

DI void gdn_finish_tok4(const Params& p, int layer, int tok0, int lane) {
  const float4 g = *(const float4*)(p.gdn_g + layer * 64 + (lane & 15) * 4);
  uint2 a[4], b[4], z[4];
#pragma unroll
  for (int t = 0; t < 4; ++t) {
    const size_t ro = (size_t)(tok0 + t) * 256 + lane * 4;
    a[t] = *(const uint2*)((const bf16_t*)(p.ws + OFF_OF) + ro); b[t] = *(const uint2*)((const bf16_t*)(p.ws + OFF_OB) + ro);
    z[t] = *(const uint2*)((const bf16_t*)(p.ws + OFF_MIX) + (size_t)(tok0 + t) * 1024 + 256 + lane * 4);
  }
#pragma unroll
  for (int t = 0; t < 4; ++t) {
    const float o0 = bflo(a[t].x) + bflo(b[t].x), o1 = bfhi(a[t].x) + bfhi(b[t].x), o2 = bflo(a[t].y) + bflo(b[t].y), o3 = bfhi(a[t].y) + bfhi(b[t].y);
    float ss = o0 * o0 + o1 * o1 + o2 * o2 + o3 * o3;
    ss += __shfl_xor(ss, 1, 64); ss += __shfl_xor(ss, 2, 64); ss += __shfl_xor(ss, 4, 64); ss += __shfl_xor(ss, 8, 64);
    const float rs = rsqrtf(ss * (1.f / 64.f) + 1e-6f);
    uint2 w; w.x = pack2(o0 * rs * g.x * silu(bflo(z[t].x)), o1 * rs * g.y * silu(bfhi(z[t].x)));
    w.y = pack2(o2 * rs * g.z * silu(bflo(z[t].y)), o3 * rs * g.w * silu(bfhi(z[t].y)));
    *(uint2*)((bf16_t*)(p.ws + OFF_MIX) + (size_t)(tok0 + t) * 1024 + 256 + lane * 4) = w;
  }
}

DI void post_token2(const Params& p, int layer, int tok0, int lane) {
  const float* pg = p.post_g + layer * 1024;
  uint2 ob[2][4]; float4 xr[2][4], g[4];
#pragma unroll
  for (int t = 0; t < 2; ++t) {
    const bf16_t* o = (const bf16_t*)(p.ws + OFF_OUTTMP) + (size_t)(tok0 + t) * 1024;
    const float* xp = layer == 0 ? xrow(p, tok0 + t) : p.out + (size_t)(tok0 + t) * 1024;
#pragma unroll
    for (int i = 0; i < 4; ++i) { ob[t][i] = *(const uint2*)(o + i * 256 + lane * 4); xr[t][i] = *(const float4*)(xp + i * 256 + lane * 4); }
  }
#pragma unroll
  for (int i = 0; i < 4; ++i) g[i] = *(const float4*)(pg + i * 256 + lane * 4);
#pragma unroll
  for (int t = 0; t < 2; ++t) {
    float4 v[4]; float ss = 0.f;
#pragma unroll
    for (int i = 0; i < 4; ++i) { const uint2 u = ob[t][i]; v[i] = make_float4(bflo(u.x), bfhi(u.x), bflo(u.y), bfhi(u.y));
      ss += v[i].x * v[i].x + v[i].y * v[i].y + v[i].z * v[i].z + v[i].w * v[i].w; }
    ss = wave_sum(ss);
    const float rs = rsqrtf(ss * (1.f / 1024.f) + 1e-6f);
    float ss2 = 0.f;
#pragma unroll
    for (int i = 0; i < 4; ++i) {
      const float4 x = xr[t][i];
      v[i].x = x.x + v[i].x * rs * g[i].x; v[i].y = x.y + v[i].y * rs * g[i].y; v[i].z = x.z + v[i].z * rs * g[i].z; v[i].w = x.w + v[i].w * rs * g[i].w;
      ss2 += v[i].x * v[i].x + v[i].y * v[i].y + v[i].z * v[i].z + v[i].w * v[i].w;
      *(float4*)(p.out + (size_t)(tok0 + t) * 1024 + i * 256 + lane * 4) = v[i];
    }
    if (layer == 0) {
      ss2 = wave_sum(ss2);
      const float rs2 = rsqrtf(ss2 * (1.f / 1024.f) + 1e-6f);
      bf16_t* dst = (bf16_t*)(p.ws + OFF_X) + (size_t)(tok0 + t) * 1024;
#pragma unroll
      for (int i = 0; i < 4; ++i) { uint2 w; w.x = pack2(v[i].x * rs2, v[i].y * rs2); w.y = pack2(v[i].z * rs2, v[i].w * rs2); *(uint2*)(dst + i * 256 + lane * 4) = w; }
    }
  }
}

#define XB_TMO      128
#define XB_XCNT(j)  (256  + 64 * (j))
#define XB_XSUB(j)  (1280 + 64 * (j))
#define XB_XGEN(j)  (2304 + 64 * (j))
#define XB_TOP      3328
#define XB_TOPGEN   3392
#define XCD_BAR_WORDS 3456
#define XB_SPIN_CAP (1u << 18)
#define XLAS __attribute__((address_space(3)))

__device__ __forceinline__ unsigned xb_ld(unsigned* p)              { return __hip_atomic_load(p, __ATOMIC_RELAXED, __HIP_MEMORY_SCOPE_AGENT); }
__device__ __forceinline__ unsigned xb_add(unsigned* p, unsigned v) { return __hip_atomic_fetch_add(p, v, __ATOMIC_RELAXED, __HIP_MEMORY_SCOPE_AGENT); }
__device__ __forceinline__ unsigned xb_xcc_id() { return (unsigned)__builtin_amdgcn_s_getreg((3 << 11) | 20) & 0xFu; }
#define XB_SPIN(cond, bar) do { unsigned _sp = 0; while (cond) { __builtin_amdgcn_s_sleep(1); \
    if ((++_sp & 255u) == 0u) { if (xb_ld(&(bar)[XB_TMO])) break; if (_sp > XB_SPIN_CAP) { atomicAdd(&(bar)[XB_TMO], 1u); break; } } } } while (0)

struct XcdBarrier {
    unsigned* bar; unsigned x;
    volatile XLAS unsigned* st;
};

__device__ __forceinline__ XcdBarrier xcd_barrier_post(unsigned* bar, volatile XLAS unsigned* st) {
    XcdBarrier b; b.bar = bar; b.x = xb_xcc_id(); b.st = st;
    if (threadIdx.x == 0) (void)xb_add(&bar[XB_XCNT(b.x)], 1u);
    return b;
}
__device__ __forceinline__ void xcd_barrier_complete(unsigned* bar, unsigned x, unsigned& nloc, unsigned& nx) {
    const unsigned G = gridDim.x * gridDim.y * gridDim.z;
    unsigned sum, cnt, mine, sp = 0u;
    for (;;) {
        sum = 0u; cnt = 0u; mine = 0u;
#pragma unroll
        for (unsigned j = 0; j < 16; ++j) { const unsigned c = xb_ld(&bar[XB_XCNT(j)]); sum += c; cnt += (c > 0u) ? 1u : 0u; mine = (j == x) ? c : mine; }
        if (sum == G) break;
        __builtin_amdgcn_s_sleep(1);
        if ((++sp & 255u) == 0u) { if (xb_ld(&bar[XB_TMO])) break; if (sp > XB_SPIN_CAP) { atomicAdd(&bar[XB_TMO], 1u); break; } }
    }
    nloc = mine > 0u ? mine : 1u; nx = cnt > 0u ? cnt : 1u;
}

__device__ __forceinline__ void xcd_barrier(const XcdBarrier& b) {
    asm volatile("s_waitcnt vmcnt(0)" ::: "memory");
    __syncthreads();
    if (threadIdx.x == 0) {
        unsigned* bar = b.bar;
        __builtin_amdgcn_s_waitcnt(0);
        unsigned nloc = b.st[0], nx = b.st[1];
        if (nloc == 0u) { xcd_barrier_complete(bar, b.x, nloc, nx); b.st[0] = nloc; b.st[1] = nx; }
        const unsigned old = xb_add(&bar[XB_XSUB(b.x)], 1u);
        const unsigned gen = old / nloc;
        if (old + 1u == (gen + 1u) * nloc) {
            __builtin_amdgcn_fence(__ATOMIC_RELEASE, "agent");
            asm volatile("s_waitcnt vmcnt(0)" ::: "memory");
            const unsigned og = xb_add(&bar[XB_TOP], 1u);
            const unsigned tg = og / nx;
            if (og + 1u == (tg + 1u) * nx) xb_add(&bar[XB_TOPGEN], 1u);
            else XB_SPIN(xb_ld(&bar[XB_TOPGEN]) == tg, bar);
            __builtin_amdgcn_fence(__ATOMIC_ACQUIRE, "agent");
            xb_add(&bar[XB_XGEN(b.x)], 1u);
            asm volatile("s_waitcnt vmcnt(0)" ::: "memory");
        } else {
            XB_SPIN(xb_ld(&bar[XB_XGEN(b.x)]) == gen, bar);
            __builtin_amdgcn_fence(__ATOMIC_ACQUIRE, "agent");
            asm volatile("s_waitcnt vmcnt(0)" ::: "memory");
        }
    }
    __syncthreads();
}

constexpr int LDS_BYTES = 131072;
__global__ void __launch_bounds__(NT, 2) fwd_megakernel(Params p0) {
  cg::grid_group grid = cg::this_grid();
  extern __shared__ __attribute__((aligned(16))) unsigned char shm[];
  char* smem = (char*)shm;
  PG8_LAS unsigned char* lds = (PG8_LAS unsigned char*)shm;
  const int nb = gridDim.x, bid = blockIdx.x, nw = gridDim.x * (NT / 64);
  __shared__ __attribute__((aligned(16))) unsigned xb_st[4];
  if (threadIdx.x < 4) xb_st[threadIdx.x] = 0u;
  __syncthreads();
  const XcdBarrier xbar = xcd_barrier_post((unsigned*)(p0.ws + OFF_BAR), (volatile XLAS unsigned*)xb_st);
#define GSYNC() xcd_barrier(xbar)
#define PH_BEGIN const Params p = launder(p0); const int tid = ltid(); const int lane = tid & 63; const int gw = bid * (NT / 64) + (tid >> 6); (void)lane; (void)gw;
  { PH_BEGIN phase0(p, tid); }
  grid.sync();
#pragma unroll 1
  for (int layer = 0; layer < 2; ++layer) {
    {
      PH_BEGIN
      InProjEpi epi{p.ws};
      run_gemm(lds, (const bf16_t*)(p.ws + OFF_X), (const bf16_t*)(p.ws + OFF_WIN) + (size_t)layer * NPAD * 1024, NTOK, NPAD, 1024, epi, tid);
    }
    if (layer == 0 && bid >= 192 && bid < 216) {
      PH_BEGIN
      const int l2 = (bid - 192) / 12, c = (bid - 192) - 12 * l2;
      MemKvEpi me{p.ws, l2};
      run_gemm_on(lds, (const bf16_t*)(p.ws + OFF_MEMN), (const bf16_t*)(p.ws + OFF_WMEM) + (size_t)l2 * 512 * 1024, 1536, 512, 1024, me, tid, 12, c);
    }
    GSYNC();
    { PH_BEGIN
      if (nb == 256) {
#pragma unroll 1
        for (int k = 0; k < 6; ++k) na_block(p, layer, (bid & 7) * 192 + (bid >> 3) + 32 * k, smem, tid);
      } else {
#pragma unroll 1
        for (int t = bid; t < 1536; t += nb) na_block(p, layer, t, smem, tid);
      } }
    { PH_BEGIN
#pragma unroll 1
      for (int t = gw; t < NTOK / 8; t += nw) gdn_prep_tok8(p, layer, t, lane); }
    GSYNC();
    { PH_BEGIN
      const int half = tid >> 8;
#pragma unroll 1
      for (int t = bid; t < 1536; t += nb) chunk_task(p, 2 * t + half, smem + half * 36864, tid & 255); }
    GSYNC();
    if (bid < 48) { PH_BEGIN scan_task(p, bid, smem, tid); }
    else { PH_BEGIN
      if (nb == 256) {
        const int x = bid & 7, j = (bid - 48) >> 3;
#pragma unroll 1
        for (int li = j; li < 96; li += 26) fft_task(p, (li >> 4) * 128 + 16 * x + (li & 15), (float2*)smem, tid);
      } else {
#pragma unroll 1
        for (int t = bid - 48; t < 768; t += nb - 48) fft_task(p, t, (float2*)smem, tid);
      }
#pragma unroll 1
      for (int t = bid - 48; t < 768; t += nb - 48) mem_block(p, layer, t, smem, tid); }
    GSYNC();
    { PH_BEGIN
#pragma unroll 1
      for (int t = gw; t < NTOK / 4; t += nw) gdn_finish_tok4(p, layer, 4 * t, lane); }
    {
      PH_BEGIN
      FnetEpiDirect fe{p.ws};
      { pg8::Gemm g; g.A = (const bf16_t*)(p.ws + OFF_H); g.Bt = (const bf16_t*)(p.ws + OFF_WF) + (size_t)layer * 256 * 512; g.M = NTOK; g.N = 256; g.K = 512;
        pg8::StaticOrder S; S.init(NTOK, 256, (int)gridDim.x, (int)blockIdx.x);
        pg8::gemm_phase<FnetEpiDirect, pg8::StaticOrder, false>(lds, g, S, fe, nullptr, tid);
        __syncthreads(); }
    }
    GSYNC();
    {
      PH_BEGIN
      OutEpi oe{(bf16_t*)(p.ws + OFF_OUTTMP)};
      run_gemm(lds, (const bf16_t*)(p.ws + OFF_MIX), (const bf16_t*)(p.ws + OFF_WOUT) + (size_t)layer * 1024 * 1024, NTOK, 1024, 1024, oe, tid);
    }
    GSYNC();
    { PH_BEGIN
#pragma unroll 1
      for (int t = gw; t < NTOK / 2; t += nw) post_token2(p, layer, 2 * t, lane); }
    if (layer == 0) GSYNC();
  }
}

extern "C" void kernel_launch(void* const* d_in, const int* in_sizes, int n_in, void* d_out, int out_size, void* d_ws, size_t ws_size, hipStream_t stream) {
  static int grid_blocks = 0;
  if (!grid_blocks) {
    int dev = 0, cus = 0, per_cu = 0;
    (void)hipGetDevice(&dev);
    (void)hipDeviceGetAttribute(&cus, hipDeviceAttributeMultiprocessorCount, dev);
    if (hipFuncSetAttribute((const void*)fwd_megakernel, hipFuncAttributeMaxDynamicSharedMemorySize, LDS_BYTES) != hipSuccess) fprintf(stderr, "hipFuncSetAttribute failed\n");
    (void)hipOccupancyMaxActiveBlocksPerMultiprocessor(&per_cu, fwd_megakernel, NT, LDS_BYTES);
    if (per_cu > 1) per_cu = 1;
    grid_blocks = cus * per_cu;
    if (grid_blocks <= 0) { fprintf(stderr, "occupancy query returned %d x %d\n", cus, per_cu); grid_blocks = -1; }
  }
  if (grid_blocks < 0) return;
  if (ws_size < WS_NEED || n_in != 16) { fprintf(stderr, "kernel_launch: need %zu bytes of workspace, got %zu (n_in %d)\n", (size_t)WS_NEED, ws_size, n_in); return; }
  Params p{};
  p.x_prompt = (const float*)d_in[0]; p.x_sample = (const float*)d_in[1]; p.mem_prompt = (const float*)d_in[2]; p.mem_sample = (const float*)d_in[3];
  p.pre_g = (const float*)d_in[4]; p.post_g = (const float*)d_in[5]; p.w_in = (const float*)d_in[6]; p.w_fnet = (const float*)d_in[7];
  p.conv_w = (const float*)d_in[8]; p.a_log = (const float*)d_in[9]; p.dt_bias = (const float*)d_in[10]; p.gdn_g = (const float*)d_in[11];
  p.rpb = (const float*)d_in[12]; p.mem_g = (const float*)d_in[13]; p.w_mem_kv = (const float*)d_in[14]; p.w_out = (const float*)d_in[15];
  p.out = (float*)d_out; p.ws = (unsigned char*)d_ws;
  if (hipMemsetAsync((unsigned char*)d_ws + OFF_BAR, 0, XCD_BAR_WORDS * sizeof(unsigned), stream) != hipSuccess) { fprintf(stderr, "memset failed\n"); return; }
  void* args[] = {&p};
  hipError_t e = hipLaunchCooperativeKernel((void*)fwd_megakernel, dim3(grid_blocks), dim3(NT), args, LDS_BYTES, stream);
  if (e != hipSuccess) fprintf(stderr, "cooperative launch failed: %s (grid %d)\n", hipGetErrorString(e), grid_blocks);
}
```

```cpp
#include <hip/hip_runtime.h>
#include <hip/hip_cooperative_groups.h>
#include <cstdio>
namespace cg = cooperative_groups;

typedef unsigned short bf16_t;
typedef short bf16x8 __attribute__((ext_vector_type(8)));
typedef float f32x4 __attribute__((ext_vector_type(4)));

#define NT 512
#define DI __device__ __forceinline__
#define MFMA16(a, b, c) __builtin_amdgcn_mfma_f32_16x16x32_bf16((a), (b), (c), 0, 0, 0)

constexpr int SEQL = 8192, NTOK = 49152;
constexpr size_t MiB = (size_t)1 << 20;
constexpr int NPAD = 3328;
constexpr size_t OFF_WIN = 0, OFF_WOUT = 13631488, OFF_WMEM = 17825792, OFF_WF = 19922944, OFF_MEMN = 20447232,
                 OFF_KMEM = 23592960, OFF_VMEMT = 25165824, OFF_TW = 26738688;
constexpr size_t OFF_MIX = 26 * MiB, OFF_AZ = 122 * MiB, OFF_CZ = 146 * MiB, OFF_DZ = 170 * MiB, OFF_GATES = 194 * MiB, OFF_X = 197 * MiB,
                 OFF_BQKV = 293 * MiB, OFF_CK = 365 * MiB, OFF_CVT = 389 * MiB;
constexpr size_t OFF_H = OFF_X, OFF_QN = 245 * MiB, OFF_KN = 269 * MiB, OFF_KT = 464 * MiB, OFF_VN = 488 * MiB;
constexpr size_t OFF_CHW = 293 * MiB, OFF_CHU = 341 * MiB, OFF_CHQK = 389 * MiB, OFF_CVEC = 437 * MiB;
constexpr size_t OFF_OF = OFF_KN, OFF_OB = OFF_VN, OFF_OUTTMP = 293 * MiB;
constexpr size_t OFF_BAR = 26771456;
constexpr size_t WS_NEED = 512 * MiB;

struct Params {
  const float* x_prompt; const float* x_sample; const float* mem_prompt; const float* mem_sample;
  const float* pre_g; const float* post_g; const float* w_in; const float* w_fnet; const float* conv_w;
  const float* a_log; const float* dt_bias; const float* gdn_g; const float* rpb; const float* mem_g;
  const float* w_mem_kv; const float* w_out;
  float* out; unsigned char* ws;
};

typedef float f32x2_t __attribute__((ext_vector_type(2)));
typedef __bf16 bf16x2_t __attribute__((ext_vector_type(2)));
DI unsigned pack2(float lo, float hi) { f32x2_t f = {lo, hi}; return __builtin_bit_cast(unsigned, __builtin_convertvector(f, bf16x2_t)); }
DI bf16_t f2bf(float x) { return (bf16_t)(pack2(x, 0.f) & 0xffffu); }
DI float bf2f(bf16_t h) { return __uint_as_float(((unsigned)h) << 16); }
DI float bflo(unsigned u) { return __uint_as_float(u << 16); }
DI float bfhi(unsigned u) { return __uint_as_float(u & 0xffff0000u); }
DI float wave_sum(float v) {
#pragma unroll
  for (int m = 32; m >= 1; m >>= 1) v += __shfl_xor(v, m, 64);
  return v;
}
DI float silu(float x) { return x * __builtin_amdgcn_rcpf(1.f + __expf(-x)); }
DI bf16x8 pack8(const f32x4& a, const f32x4& b) {
  uint4 u; u.x = pack2(a[0], a[1]); u.y = pack2(a[2], a[3]); u.z = pack2(b[0], b[1]); u.w = pack2(b[2], b[3]);
  return __builtin_bit_cast(bf16x8, u);
}
DI bf16x8 ld8(const bf16_t* p) { return *(const bf16x8*)p; }
DI bf16x8 ld4x2(const bf16_t* lo, const bf16_t* hi) {
  uint2 a = *(const uint2*)lo, b = *(const uint2*)hi; uint4 u; u.x = a.x; u.y = a.y; u.z = b.x; u.w = b.y;
  return __builtin_bit_cast(bf16x8, u);
}
DI int ltid() { int t = threadIdx.x; asm volatile("" : "+v"(t)); return t; }
DI Params launder(Params p) { size_t z = 0; asm volatile("" : "+s"(z)); p.ws = p.ws + z; return p; }
DI const float* xrow(const Params& p, int tok) {
  return tok < 32768 ? p.x_prompt + (size_t)tok * 1024 : p.x_sample + (size_t)(tok - 32768) * 1024;
}

DI void norm_row_bf16(const float* src, bf16_t* dst, int lane) {
  float4 v[4]; float ss = 0.f;
#pragma unroll
  for (int i = 0; i < 4; ++i) { v[i] = *(const float4*)(src + i * 256 + lane * 4); ss += v[i].x * v[i].x + v[i].y * v[i].y + v[i].z * v[i].z + v[i].w * v[i].w; }
  ss = wave_sum(ss);
  const float rs = rsqrtf(ss * (1.f / 1024.f) + 1e-6f);
#pragma unroll
  for (int i = 0; i < 4; ++i) { uint2 o; o.x = pack2(v[i].x * rs, v[i].y * rs); o.y = pack2(v[i].z * rs, v[i].w * rs); *(uint2*)(dst + i * 256 + lane * 4) = o; }
}

DI void phase0(const Params& p, const int tid) {
  const int gtid = blockIdx.x * NT + tid, gsz = gridDim.x * NT;
  bf16_t* WinT = (bf16_t*)(p.ws + OFF_WIN);
  for (int idx = gtid; idx < 2 * NPAD * 128; idx += gsz) {
    const int l = idx / (NPAD * 128); const int rem = idx - l * NPAD * 128; const int k8 = rem / NPAD; const int r = rem - k8 * NPAD;
    const int src = r < 1536 ? r : (r < 3072 ? r + 16 : (r < 3088 ? 1536 + (r - 3072) : -1));
    uint4 o = make_uint4(0, 0, 0, 0);
    if (src >= 0) {
      const float* w = p.w_in + ((size_t)l * 1024 + k8 * 8) * 3088 + src;
      const float* g = p.pre_g + l * 1024 + k8 * 8;
      float v[8];
#pragma unroll
      for (int j = 0; j < 8; ++j) v[j] = w[(size_t)j * 3088] * g[j];
      o.x = pack2(v[0], v[1]); o.y = pack2(v[2], v[3]); o.z = pack2(v[4], v[5]); o.w = pack2(v[6], v[7]);
    }
    *(uint4*)(WinT + ((size_t)l * NPAD + r) * 1024 + k8 * 8) = o;
  }
  bf16_t* WoutT = (bf16_t*)(p.ws + OFF_WOUT);
  for (int idx = gtid; idx < 2 * 1024 * 128; idx += gsz) {
    const int l = idx / (1024 * 128); const int rem = idx - l * 1024 * 128; const int k8 = rem / 1024; const int r = rem - k8 * 1024;
    const float* w = p.w_out + ((size_t)l * 1024 + k8 * 8) * 1024 + r;
    float v[8];
#pragma unroll
    for (int j = 0; j < 8; ++j) v[j] = w[(size_t)j * 1024];
    uint4 o; o.x = pack2(v[0], v[1]); o.y = pack2(v[2], v[3]); o.z = pack2(v[4], v[5]); o.w = pack2(v[6], v[7]);
    *(uint4*)(WoutT + ((size_t)l * 1024 + r) * 1024 + k8 * 8) = o;
  }
  bf16_t* WmemT = (bf16_t*)(p.ws + OFF_WMEM);
  for (int idx = gtid; idx < 2 * 512 * 128; idx += gsz) {
    const int l = idx / (512 * 128); const int rem = idx - l * 512 * 128; const int k8 = rem / 512; const int r = rem - k8 * 512;
    const float* w = p.w_mem_kv + ((size_t)l * 1024 + k8 * 8) * 512 + r;
    const float* g = p.mem_g + l * 1024 + k8 * 8;
    float v[8];
#pragma unroll
    for (int j = 0; j < 8; ++j) v[j] = w[(size_t)j * 512] * g[j];
    uint4 o; o.x = pack2(v[0], v[1]); o.y = pack2(v[2], v[3]); o.z = pack2(v[4], v[5]); o.w = pack2(v[6], v[7]);
    *(uint4*)(WmemT + ((size_t)l * 512 + r) * 1024 + k8 * 8) = o;
  }
  bf16_t* WfT = (bf16_t*)(p.ws + OFF_WF);
  const float fscale = 0.00138106793f;
  for (int idx = gtid; idx < 2 * 256 * 512; idx += gsz) {
    const int l = idx >> 17; const int rem = idx & 131071; const int kk = rem >> 8; const int j = rem & 255;
    const int k2 = kk & 255, blk = k2 >> 6, cp = k2 & 63;
    const float* w = p.w_fnet + ((size_t)l * 256 + blk * 64) * 256 + j;
    float a = 0.f;
    for (int c = 0; c < 64; ++c) {
      const float turns = (float)((c * cp) & 63) * (1.f / 64.f);
      const float tr = kk < 256 ? __builtin_amdgcn_cosf(turns) : __builtin_amdgcn_sinf(turns);
      a += tr * w[(size_t)c * 256];
    }
    WfT[((size_t)l * 256 + j) * 512 + kk] = f2bf(a * fscale);
  }
  float2* tw = (float2*)(p.ws + OFF_TW);
  for (int t = gtid; t < 4096; t += gsz) { float s, c; sincospif((float)t * (1.f / 4096.f), &s, &c); tw[t] = make_float2(c, -s); }
  const int lane = tid & 63, gw = blockIdx.x * (NT / 64) + (tid >> 6), nw = gridDim.x * (NT / 64);
  bf16_t* memn = (bf16_t*)(p.ws + OFF_MEMN);
  for (int r = gw; r < 1536; r += nw) {
    const float* src = r < 1024 ? p.mem_prompt + (size_t)r * 1024 : p.mem_sample + (size_t)(r - 1024) * 1024;
    norm_row_bf16(src, memn + (size_t)r * 1024, lane);
  }
  bf16_t* xn = (bf16_t*)(p.ws + OFF_X);
  for (int t = gw; t < NTOK / 2; t += nw) {
    const float* s0 = xrow(p, 2 * t); const float* s1 = xrow(p, 2 * t + 1);
    float4 v0[4], v1[4]; float a0 = 0.f, a1 = 0.f;
#pragma unroll
    for (int i = 0; i < 4; ++i) { v0[i] = *(const float4*)(s0 + i * 256 + lane * 4); v1[i] = *(const float4*)(s1 + i * 256 + lane * 4); }
#pragma unroll
    for (int i = 0; i < 4; ++i) { a0 += v0[i].x * v0[i].x + v0[i].y * v0[i].y + v0[i].z * v0[i].z + v0[i].w * v0[i].w; a1 += v1[i].x * v1[i].x + v1[i].y * v1[i].y + v1[i].z * v1[i].z + v1[i].w * v1[i].w; }
    a0 = wave_sum(a0); a1 = wave_sum(a1);
    const float r0 = rsqrtf(a0 * (1.f / 1024.f) + 1e-6f), r1 = rsqrtf(a1 * (1.f / 1024.f) + 1e-6f);
    bf16_t* d0 = xn + (size_t)(2 * t) * 1024; bf16_t* d1 = d0 + 1024;
#pragma unroll
    for (int i = 0; i < 4; ++i) {
      uint2 o; o.x = pack2(v0[i].x * r0, v0[i].y * r0); o.y = pack2(v0[i].z * r0, v0[i].w * r0); *(uint2*)(d0 + i * 256 + lane * 4) = o;
      o.x = pack2(v1[i].x * r1, v1[i].y * r1); o.y = pack2(v1[i].z * r1, v1[i].w * r1); *(uint2*)(d1 + i * 256 + lane * 4) = o;
    }
  }
}

namespace pg8 {
#define PG8_LAS __attribute__((address_space(3)))
typedef unsigned short bf16_t;
typedef short bf16x8 __attribute__((ext_vector_type(8)));
typedef float f32x4 __attribute__((ext_vector_type(4)));
typedef unsigned u32x4 __attribute__((ext_vector_type(4)));
constexpr int BM = 256, BK = 64, HALF = 128, HTB = HALF * BK * 2  , STAGE_BYTES = 8 * HTB, NXCD = 8, WGM = 8;

__host__ __device__ __forceinline__ int lds_byte(int r, int c) { const int st = (r >> 4) * 2 + (c >> 5), rr = r & 15, cc = c & 31, ob = rr * 64 + cc * 2; return st * 1024 + (ob ^ (((ob >> 9) & 1) << 5)); }
__host__ __device__ __forceinline__ void stage_rc(int b, int& R, int& C) { const int st = b / 1024, sb = b % 1024, swz = sb ^ (((sb >> 9) & 1) << 5); R = (st >> 1) * 16 + swz / 64; C = (st & 1) * 32 + (swz % 64) / 2; }
__host__ __device__ __forceinline__ int perm32(int rho) { const int n = rho >> 4, i = rho & 15; return 8 * (i >> 2) + 4 * n + (i & 3); }

struct Unit { int pm, pn; };
struct Gemm { const bf16_t* A; const bf16_t* Bt; int M, N, K; };

struct StaticOrder {
    int nM, nN, nwg, G, c;
    __host__ __device__ void init(int M, int N, int G_, int c_) { nM = M / BM; nN = N / BM; nwg = nM * nN; G = G_; c = c_; }
    __host__ __device__ bool next(int i, Unit& u) const {
        const long L = (long)i * G + c; if (L >= nwg) return false;
        int wgid = (int)L; { const int q = nwg / NXCD, r = nwg % NXCD, xcd = wgid % NXCD, off = wgid / NXCD; wgid = (xcd < r ? xcd * (q + 1) : r * (q + 1) + (xcd - r) * q) + off; }
        const int nig = WGM * nN, gid = wgid / nig, fm = gid * WGM, gsz = (nM - fm) < WGM ? (nM - fm) : WGM;
        u.pm = fm + ((wgid % nig) % gsz); u.pn = (wgid % nig) / gsz; return true;
    }
    __device__ __forceinline__ void a_ready(const Unit&) const {}
    __device__ __forceinline__ void done(const Unit&) const {}
};
template <class Epi, class Sched, bool STAMP = false>
__device__ __forceinline__ void gemm_phase(PG8_LAS unsigned char* lds, const Gemm g, const Sched& S, const Epi& E, unsigned long long* stamps, const int tid_in) {
    const int tid = tid_in, wid = __builtin_amdgcn_readfirstlane(tid >> 6), lane = tid & 63, wr = wid >> 2, wc = wid & 3, fr = lane & 15, fq = lane >> 4;
    const int K = g.K, nt = K / BK;
    int ts_lo = 0, ts_hi = 0, nts = 0; const unsigned long long rt_entry = STAMP ? (unsigned long long)wall_clock64() : 0ull;
#define PG8_STAMP() do { if (STAMP && wid == 0 && nts < 64) { const unsigned long long _c = (unsigned long long)clock64(); \
        ts_lo = (lane == nts) ? (int)(unsigned)_c : ts_lo; ts_hi = (lane == nts) ? (int)(unsigned)(_c >> 32) : ts_hi; ++nts; } } while (0)
    PG8_STAMP();
    unsigned voffA[2], voffB[2];
#pragma unroll
    for (int i = 0; i < 2; ++i) { int R, C; stage_rc(tid * 16 + i * 8192, R, C); const int Rb = Epi::PERM ? ((R & ~31) + perm32(R & 31)) : R;
        voffA[i] = (unsigned)(R * K + C) * 2u; voffB[i] = (unsigned)(Rb * K + C) * 2u; }
    const size_t kstep = (size_t)(BK * 2);
    const size_t hstep = (size_t)HALF * K * 2;
    const size_t tstep = 2 * hstep;
    const unsigned ldsw = (unsigned)wid * 1024u;
    const int aoff = lds_byte(wr * 64 + fr, fq * 8), boff = lds_byte(wc * 32 + fr, fq * 8);
#define PG8_SA(b, h) (((b) * 2 + (h)) * HTB)
#define PG8_SB(b, h) ((4 + (b) * 2 + (h)) * HTB)
#define PG8_STAGE(bufoff, gbase, voff) do { _Pragma("unroll") for (int _i = 0; _i < 2; ++_i) \
        __builtin_amdgcn_global_load_lds((const unsigned*)((const char*)(gbase) + (voff)[_i]), (PG8_LAS unsigned*)(lds + (bufoff) + ldsw + _i * 8192), 16, 0, 0); } while (0)
#define PG8_LDA(dst, b, h) do { _Pragma("unroll") for (int m = 0; m < 4; ++m) _Pragma("unroll") for (int k = 0; k < 2; ++k) dst[m][k] = *(const PG8_LAS bf16x8*)(lds + PG8_SA(b, h) + aoff + m * 2048 + k * 1024); } while (0)
#define PG8_LDB(dst, b, h) do { _Pragma("unroll") for (int n = 0; n < 2; ++n) _Pragma("unroll") for (int k = 0; k < 2; ++k) dst[n][k] = *(const PG8_LAS bf16x8*)(lds + PG8_SB(b, h) + boff + n * 2048 + k * 1024); } while (0)
#define PG8_MMA(ai, bj, At, Bt) do { __builtin_amdgcn_s_setprio(1); _Pragma("unroll") for (int m = 0; m < 4; ++m) _Pragma("unroll") for (int n = 0; n < 2; ++n) _Pragma("unroll") for (int k = 0; k < 2; ++k) \
        acc[ai][bj][m][n] = __builtin_amdgcn_mfma_f32_16x16x32_bf16(Bt[n][k], At[m][k], acc[ai][bj][m][n], 0, 0, 0); __builtin_amdgcn_s_setprio(0); } while (0)
#define PG8_WAIT_V(n) asm volatile("s_waitcnt vmcnt(" #n ")" ::: "memory")
#define PG8_WAIT_L(n) asm volatile("s_waitcnt lgkmcnt(" #n ")" ::: "memory")
#define PG8_BAR __builtin_amdgcn_s_barrier()
#define PG8_SCHED __builtin_amdgcn_sched_barrier(0)
    Unit cur, nxt; int ui = 0;
    if (!S.next(0, cur)) return;
    f32x4 acc[2][2][4][2];
#pragma unroll
    for (int a = 0; a < 2; ++a)
#pragma unroll
        for (int b = 0; b < 2; ++b)
#pragma unroll
            for (int m = 0; m < 4; ++m)
#pragma unroll
                for (int n = 0; n < 2; ++n) acc[a][b][m][n] = (f32x4){0.f, 0.f, 0.f, 0.f};
    bf16x8 At[4][2], B0[2][2], B1[2][2];
    const char* cA = (const char*)g.A + (size_t)cur.pm * tstep; const char* cB = (const char*)g.Bt + (size_t)cur.pn * tstep;
    S.a_ready(cur);
    PG8_STAGE(PG8_SB(0, 0), cB, voffB); PG8_STAGE(PG8_SA(0, 0), cA, voffA); PG8_STAGE(PG8_SB(0, 1), cB + hstep, voffB); PG8_STAGE(PG8_SA(0, 1), cA + hstep, voffA);
    if (wr == 1) PG8_BAR;
    PG8_WAIT_V(4); PG8_BAR;
    PG8_STAGE(PG8_SB(1, 0), cB + kstep, voffB); PG8_STAGE(PG8_SA(1, 0), cA + kstep, voffA); PG8_STAGE(PG8_SB(1, 1), cB + hstep + kstep, voffB);
    PG8_WAIT_V(6); PG8_BAR;
    PG8_STAMP();
    for (;;) {
        const bool has_next = S.next(ui + 1, nxt);
        const char* nA = has_next ? (const char*)g.A + (size_t)nxt.pm * tstep : cA; const char* nB = has_next ? (const char*)g.Bt + (size_t)nxt.pn * tstep : cB;
        for (int t = 0; t < nt; t += 2) {
            const bool last = (t == nt - 2);
            const char* a1 = cA + (size_t)(t + 1) * kstep;
            const char* a2 = last ? nA : cA + (size_t)(t + 2) * kstep; const char* b2 = last ? nB : cB + (size_t)(t + 2) * kstep;
            const char* a3 = a2 + kstep; const char* b3 = b2 + kstep;
            if (last && has_next) S.a_ready(nxt);
            PG8_LDB(B0, 0, 0); PG8_SCHED; PG8_LDA(At, 0, 0); PG8_STAGE(PG8_SA(1, 1), a1 + hstep, voffA);
            PG8_WAIT_L(8); PG8_BAR; PG8_WAIT_L(0); PG8_MMA(0, 0, At, B0); PG8_BAR; PG8_SCHED;
            PG8_LDB(B1, 0, 1); PG8_STAGE(PG8_SB(0, 0), b2, voffB);
            PG8_BAR; PG8_WAIT_L(0); PG8_MMA(0, 1, At, B1); PG8_BAR;
            PG8_LDA(At, 0, 1); PG8_STAGE(PG8_SA(0, 0), a2, voffA);
            PG8_BAR; PG8_WAIT_L(0); PG8_MMA(1, 0, At, B0); PG8_BAR; PG8_SCHED;
            PG8_STAGE(PG8_SB(0, 1), b2 + hstep, voffB);
            PG8_WAIT_V(6); PG8_BAR; PG8_MMA(1, 1, At, B1); PG8_BAR;
            PG8_LDB(B0, 1, 0); PG8_SCHED; PG8_LDA(At, 1, 0); PG8_STAGE(PG8_SA(0, 1), a2 + hstep, voffA);
            PG8_WAIT_L(8); PG8_BAR; PG8_WAIT_L(0); PG8_MMA(0, 0, At, B0); PG8_BAR; PG8_SCHED;
            PG8_LDB(B1, 1, 1); PG8_STAGE(PG8_SB(1, 0), b3, voffB);
            PG8_BAR; PG8_WAIT_L(0); PG8_MMA(0, 1, At, B1); PG8_BAR;
            PG8_LDA(At, 1, 1); PG8_STAGE(PG8_SA(1, 0), a3, voffA);
            PG8_BAR; PG8_WAIT_L(0); PG8_MMA(1, 0, At, B0); PG8_BAR; PG8_SCHED;
            PG8_STAGE(PG8_SB(1, 1), b3 + hstep, voffB);
            PG8_WAIT_V(6); PG8_BAR; PG8_MMA(1, 1, At, B1); PG8_BAR;
        }
        PG8_STAMP();
        if constexpr (!Epi::AFTER_DRAIN) { E(acc, cur, wr, wc, fr, fq); S.done(cur); }
        PG8_STAMP();
        if (!has_next) break;
#pragma unroll
        for (int a = 0; a < 2; ++a)
#pragma unroll
            for (int b = 0; b < 2; ++b)
#pragma unroll
                for (int m = 0; m < 4; ++m)
#pragma unroll
                    for (int n = 0; n < 2; ++n) acc[a][b][m][n] = (f32x4){0.f, 0.f, 0.f, 0.f};
        cur = nxt; cA = nA; cB = nB; ++ui;
    }
    PG8_WAIT_V(0);
    if (wr == 0) PG8_BAR;
    PG8_BAR;
    if constexpr (Epi::AFTER_DRAIN) { E.fused(acc, cur, wr, wc, fr, fq, lds, wid, lane); S.done(cur); }
    PG8_STAMP();
    if (STAMP && wid == 0) { stamps[lane] = lane < nts ? (((unsigned long long)(unsigned)ts_hi << 32) | (unsigned)ts_lo) : 0ull;
        if (lane == 62) stamps[62] = rt_entry; if (lane == 63) stamps[63] = (unsigned long long)wall_clock64(); }
#undef PG8_STAMP
#undef PG8_SA
#undef PG8_SB
#undef PG8_STAGE
#undef PG8_LDA
#undef PG8_LDB
#undef PG8_MMA
#undef PG8_WAIT_V
#undef PG8_WAIT_L
#undef PG8_BAR
#undef PG8_SCHED
}
}

template <class F> struct EpiWrap {
  static constexpr bool PERM = false, AFTER_DRAIN = false;
  F f;
  DI void operator()(const f32x4 (&acc)[2][2][4][2], const pg8::Unit& u, int wr, int wc, int fr, int fq) const {
#pragma unroll
    for (int ai = 0; ai < 2; ++ai)
#pragma unroll
      for (int m = 0; m < 4; ++m) {
        const int row = u.pm * 256 + ai * 128 + wr * 64 + m * 16 + fr;
#pragma unroll
        for (int bj = 0; bj < 2; ++bj)
#pragma unroll
          for (int n = 0; n < 2; ++n) f(u.pn * 256 + bj * 128 + wc * 32 + n * 16 + 4 * fq, row, acc[ai][bj][m][n]);
      }
  }
};
template <class F>
DI void run_gemm_on(PG8_LAS unsigned char* lds, const bf16_t* A, const bf16_t* Bt, int M, int N, int K, const F& f, const int tid, int G, int c) {
  pg8::Gemm g; g.A = A; g.Bt = Bt; g.M = M; g.N = N; g.K = K;
  pg8::StaticOrder S; S.init(M, N, G, c);
  EpiWrap<F> E{f};
  pg8::gemm_phase<EpiWrap<F>, pg8::StaticOrder, false>(lds, g, S, E, nullptr, tid);
  __syncthreads();
}
template <class F>
DI void run_gemm(PG8_LAS unsigned char* lds, const bf16_t* A, const bf16_t* Bt, int M, int N, int K, const F& f, const int tid) {
  pg8::Gemm g; g.A = A; g.Bt = Bt; g.M = M; g.N = N; g.K = K;
  pg8::StaticOrder S; S.init(M, N, (int)gridDim.x, (int)blockIdx.x);
  EpiWrap<F> E{f};
  pg8::gemm_phase<EpiWrap<F>, pg8::StaticOrder, false>(lds, g, S, E, nullptr, tid);
  __syncthreads();
}

struct InProjEpi {
  unsigned char* ws;
  DI void operator()(int m, int n, const f32x4& v) const {
    if (m < 3072) {
      const int blk = m >> 8, c = m & 255;
      if (blk == 8) {
        bf16_t* cvt = (bf16_t*)(ws + OFF_CVT);
        const int seq = n >> 13, l = n & 8191;
        bf16_t* d = cvt + ((size_t)(seq * 256 + c)) * 8192 + l;
#pragma unroll
        for (int e = 0; e < 4; ++e) d[(size_t)e * 8192] = f2bf(v[e]);
      } else {
        bf16_t* d;
        if (blk >= 2 && blk <= 4) d = (bf16_t*)(ws + OFF_BQKV) + (size_t)n * 768 + (blk - 2) * 256 + c;
        else if (blk == 0 || blk == 5 || blk == 6 || blk == 10) d = (bf16_t*)(ws + OFF_MIX) + (size_t)n * 1024 + (blk == 0 ? 0 : blk == 5 ? 256 : blk == 6 ? 512 : 768) + c;
        else {
          size_t off = blk == 1 ? OFF_AZ : blk == 7 ? OFF_CK : blk == 9 ? OFF_CZ : OFF_DZ;
          d = (bf16_t*)(ws + off) + (size_t)n * 256 + c;
        }
        uint2 o; o.x = pack2(v[0], v[1]); o.y = pack2(v[2], v[3]); *(uint2*)d = o;
      }
    } else if (m < 3088) {
      float* g = (float*)(ws + OFF_GATES) + (size_t)n * 16 + (m - 3072);
      *(float4*)g = make_float4(v[0], v[1], v[2], v[3]);
    }
  }
};
struct MemKvEpi {
  unsigned char* ws; int l;
  DI void operator()(int m, int n, const f32x4& v) const {
    const int seq = n >> 8, key = n & 255;
    if (m < 256) {
      const int head = m >> 6, dim = m & 63;
      bf16_t* d = (bf16_t*)(ws + OFF_KMEM) + ((size_t)((l * 6 + seq) * 4 + head) * 256 + key) * 64 + dim;
      uint2 o; o.x = pack2(v[0], v[1]); o.y = pack2(v[2], v[3]); *(uint2*)d = o;
    } else {
      const int c = m - 256, head = c >> 6, dim = c & 63;
      bf16_t* d = (bf16_t*)(ws + OFF_VMEMT) + ((size_t)((l * 6 + seq) * 4 + head) * 64 + dim) * 256 + key;
#pragma unroll
      for (int e = 0; e < 4; ++e) d[e * 256] = f2bf(v[e]);
    }
  }
};
struct FnetEpi {
  unsigned char* ws;
  DI void operator()(int m, int n, const f32x4& v) const {
    const uint2 z = *(const uint2*)((const bf16_t*)(ws + OFF_AZ) + (size_t)n * 256 + m);
    uint2 o; o.x = pack2(v[0] * silu(bflo(z.x)), v[1] * silu(bfhi(z.x))); o.y = pack2(v[2] * silu(bflo(z.y)), v[3] * silu(bfhi(z.y)));
    *(uint2*)((bf16_t*)(ws + OFF_MIX) + (size_t)n * 1024 + m) = o;
  }
};
struct FnetEpiDirect {
  static constexpr bool PERM = false, AFTER_DRAIN = false;
  unsigned char* ws;
  DI void operator()(const f32x4 (&acc)[2][2][4][2], const pg8::Unit& u, int wr, int wc, int fr, int fq) const {
    const bf16_t* AZ = (const bf16_t*)(ws + OFF_AZ); bf16_t* MX = (bf16_t*)(ws + OFF_MIX);
    const int col0 = u.pn * 256 + wc * 32 + 4 * fq;
#pragma unroll
    for (int ai = 0; ai < 2; ++ai)
#pragma unroll
      for (int m2 = 0; m2 < 2; ++m2) {
        uint2 z[2][2][2];
#pragma unroll
        for (int mm = 0; mm < 2; ++mm) {
          const size_t row = (size_t)(u.pm * 256 + ai * 128 + wr * 64 + (2 * m2 + mm) * 16 + fr);
#pragma unroll
          for (int bj = 0; bj < 2; ++bj)
#pragma unroll
            for (int n = 0; n < 2; ++n) z[mm][bj][n] = *(const uint2*)(AZ + row * 256 + col0 + bj * 128 + n * 16);
        }
#pragma unroll
        for (int mm = 0; mm < 2; ++mm) {
          const size_t row = (size_t)(u.pm * 256 + ai * 128 + wr * 64 + (2 * m2 + mm) * 16 + fr);
#pragma unroll
          for (int bj = 0; bj < 2; ++bj)
#pragma unroll
            for (int n = 0; n < 2; ++n) {
              const f32x4 v = acc[ai][bj][2 * m2 + mm][n]; const uint2 zz = z[mm][bj][n];
              uint2 o; o.x = pack2(v[0] * silu(bflo(zz.x)), v[1] * silu(bfhi(zz.x))); o.y = pack2(v[2] * silu(bflo(zz.y)), v[3] * silu(bfhi(zz.y)));
              *(uint2*)(MX + row * 1024 + col0 + bj * 128 + n * 16) = o;
            }
        }
      }
  }
};
struct OutEpi {
  bf16_t* dst;
  DI void operator()(int m, int n, const f32x4& v) const { uint2 o; o.x = pack2(v[0], v[1]); o.y = pack2(v[2], v[3]); *(uint2*)(dst + (size_t)n * 1024 + m) = o; }
};

DI int fft_pos(int k) {
  return ((k & 1) << 12) | (((k >> 1) & 3) << 10) | (((k >> 3) & 3) << 8) | (((k >> 5) & 3) << 6) | (((k >> 7) & 3) << 4) | (((k >> 9) & 3) << 2) | ((k >> 11) & 3);
}
DI void fft_task(const Params& p, int task, float2* z, const int tid) {
  const int seq = task >> 7, cp = task & 127;
  const unsigned* au = (const unsigned*)(p.ws + OFF_MIX) + (size_t)seq * 8192 * 512 + cp;
  const float2* tw = (const float2*)(p.ws + OFF_TW);
  for (int i = tid; i < 8192; i += NT) { const unsigned u = au[(size_t)i * 512]; z[i] = make_float2(bflo(u), bfhi(u)); }
  __syncthreads();
  for (int b = tid; b < 4096; b += NT) {
    const float2 a = z[b], c = z[b + 4096], w = tw[b];
    z[b] = make_float2(a.x + c.x, a.y + c.y);
    const float dx = a.x - c.x, dy = a.y - c.y;
    z[b + 4096] = make_float2(dx * w.x - dy * w.y, dx * w.y + dy * w.x);
  }
  __syncthreads();
#pragma unroll 1
  for (int s4 = 0; s4 < 6; ++s4) {
    const int lq = 10 - 2 * s4, q = 1 << lq;
    for (int b = tid; b < 2048; b += NT) {
      const int j = b & (q - 1), i0 = ((b >> lq) << (lq + 2)) + j;
      const float2 a0 = z[i0], a1 = z[i0 + q], a2 = z[i0 + 2 * q], a3 = z[i0 + 3 * q];
      const float2 w1 = tw[j << (1 + 2 * s4)];
      const float2 w2 = make_float2(w1.x * w1.x - w1.y * w1.y, 2.f * w1.x * w1.y);
      const float2 w3 = make_float2(w2.x * w1.x - w2.y * w1.y, w2.x * w1.y + w2.y * w1.x);
      const float t0x = a0.x + a2.x, t0y = a0.y + a2.y, t1x = a0.x - a2.x, t1y = a0.y - a2.y;
      const float t2x = a1.x + a3.x, t2y = a1.y + a3.y, t3x = a1.y - a3.y, t3y = -(a1.x - a3.x);
      z[i0] = make_float2(t0x + t2x, t0y + t2y);
      const float y1x = t1x + t3x, y1y = t1y + t3y, y2x = t0x - t2x, y2y = t0y - t2y, y3x = t1x - t3x, y3y = t1y - t3y;
      z[i0 + q] = make_float2(y1x * w1.x - y1y * w1.y, y1x * w1.y + y1y * w1.x);
      z[i0 + 2 * q] = make_float2(y2x * w2.x - y2y * w2.y, y2x * w2.y + y2y * w2.x);
      z[i0 + 3 * q] = make_float2(y3x * w3.x - y3y * w3.y, y3x * w3.y + y3y * w3.x);
    }
    __syncthreads();
  }
  unsigned* H = (unsigned*)(p.ws + OFF_H) + (size_t)seq * 8192 * 256;
  for (int k = tid; k < 8192; k += NT) {
    const float2 zk = z[fft_pos(k)], zn = z[fft_pos((8192 - k) & 8191)];
    H[(size_t)k * 256 + cp] = pack2(0.5f * (zk.x + zn.x), 0.5f * (zk.y + zn.y));
    H[(size_t)k * 256 + 128 + cp] = pack2(0.5f * (zk.y - zn.y), -0.5f * (zk.x - zn.x));
  }
  __syncthreads();
}

template <bool NA>
DI void attn_core(const Params& p, int layer, int h, int tok0, int r, int c0, int rs, int wsx, const bf16_t* sK, const bf16_t* sVT, const float* sBias, int kb, int pitch, int vstride, int lane) {
  const int fr = lane & 15, fq = lane >> 4;
  bf16_t* Q = (bf16_t*)(p.ws + OFF_MIX) + (NA ? 512 : 768);
  const bf16_t* Z = (const bf16_t*)(p.ws + (NA ? OFF_CZ : OFF_DZ));
  const bf16_t* qp = Q + (size_t)(tok0 + fr) * 1024 + h * 64 + fq * 8;
  bf16x8 qf[2]; qf[0] = ld8(qp); qf[1] = ld8(qp + 32);
  f32x4 s[16];
#pragma unroll
  for (int kt = 0; kt < 16; ++kt) {
    const bf16_t* kp = sK + (kb + (kt >> 1) * pitch + (kt & 1) * 16 + fr) * 72 + fq * 8;
    f32x4 a = (f32x4){0.f, 0.f, 0.f, 0.f};
    a = MFMA16(ld8(kp), qf[0], a);
    a = MFMA16(ld8(kp + 32), qf[1], a);
    s[kt] = a;
  }
  float mx = -1e30f;
  if (NA) {
    const int c = c0 + fr, cs = min(max(c - 8, 0), 48);
#pragma unroll
    for (int kt = 0; kt < 16; ++kt) {
      const int kr = rs + (kt >> 1);
      const float* rb = sBias + (kr - r + 7) * 31;
#pragma unroll
      for (int e = 0; e < 4; ++e) {
        const int kc = wsx + (kt & 1) * 16 + 4 * fq + e;
        const bool valid = kc >= cs && kc < cs + 16;
        const float bias = rb[min(max(kc - c + 15, 0), 30)];
        const float v = valid ? s[kt][e] * 0.125f + bias : -1e30f;
        s[kt][e] = v; mx = fmaxf(mx, v);
      }
    }
  } else {
#pragma unroll
    for (int kt = 0; kt < 16; ++kt)
#pragma unroll
      for (int e = 0; e < 4; ++e) { const float v = s[kt][e] * 0.125f; s[kt][e] = v; mx = fmaxf(mx, v); }
  }
  mx = fmaxf(mx, __shfl_xor(mx, 16, 64)); mx = fmaxf(mx, __shfl_xor(mx, 32, 64));
  float sum = 0.f;
#pragma unroll
  for (int kt = 0; kt < 16; ++kt)
#pragma unroll
    for (int e = 0; e < 4; ++e) { const float pv = __expf(s[kt][e] - mx); s[kt][e] = pv; sum += pv; }
  sum += __shfl_xor(sum, 16, 64); sum += __shfl_xor(sum, 32, 64);
  const float inv = 1.f / sum;
  f32x4 o[4];
#pragma unroll
  for (int mt = 0; mt < 4; ++mt) o[mt] = (f32x4){0.f, 0.f, 0.f, 0.f};
#pragma unroll
  for (int u = 0; u < 8; ++u) {
    const bf16x8 pb = pack8(s[2 * u], s[2 * u + 1]);
#pragma unroll
    for (int mt = 0; mt < 4; ++mt) {
      const bf16_t* vp = sVT + (16 * mt + fr) * vstride + kb + u * pitch + 4 * fq;
      o[mt] = MFMA16(ld4x2(vp, vp + 16), pb, o[mt]);
    }
  }
  const size_t orow = (size_t)(tok0 + fr) * 256 + h * 64 + 4 * fq, qrow = (size_t)(tok0 + fr) * 1024 + h * 64 + 4 * fq;
  uint2 zg[4];
#pragma unroll
  for (int mt = 0; mt < 4; ++mt) zg[mt] = *(const uint2*)(Z + orow + 16 * mt);
#pragma unroll
  for (int mt = 0; mt < 4; ++mt) {
    const uint2 z = zg[mt];
    uint2 w; w.x = pack2(o[mt][0] * inv * silu(bflo(z.x)), o[mt][1] * inv * silu(bfhi(z.x)));
    w.y = pack2(o[mt][2] * inv * silu(bflo(z.y)), o[mt][3] * inv * silu(bfhi(z.y)));
    *(uint2*)(Q + qrow + 16 * mt) = w;
  }
}
DI void na_block(const Params& p, int layer, int bt, char* smem, const int tid) {
  const int half = bt & 1, rg = (bt >> 1) & 31, h = (bt >> 6) & 3, seq = bt >> 8;
  const int r0 = rg * 4, rsmin = min(max(r0 - 4, 0), 120), nrows = min(11, 128 - rsmin), colbase = half ? 24 : 0;
  bf16_t* sK = (bf16_t*)smem; bf16_t* sVT = sK + 440 * 72; float* sBias = (float*)(sVT + 64 * 456);
  if (tid < 465) sBias[tid] = p.rpb[(size_t)(layer * 4 + h) * 465 + tid];
  const bf16_t* CK = (const bf16_t*)(p.ws + OFF_CK) + (size_t)(seq * 8192 + rsmin * 64 + colbase) * 256 + h * 64;
  const bf16_t* CVT = (const bf16_t*)(p.ws + OFF_CVT) + (size_t)(seq * 4 + h) * 64 * 8192 + rsmin * 64 + colbase;
  {
    const int nk = nrows * 40 * 8, per_dim = nrows * 5, nv = 64 * per_dim;
    uint4 rk[7], rv[7]; int dk[7], dv[7];
#pragma unroll
    for (int i = 0; i < 7; ++i) {
      const int idx = tid + NT * i;
      const int key = idx >> 3, ch = idx & 7, ri = key / 40, cj = key - ri * 40;
      dk[i] = idx < nk ? key * 72 + ch * 8 : -1;
      rk[i] = idx < nk ? *(const uint4*)(CK + (size_t)(ri * 64 + cj) * 256 + ch * 8) : make_uint4(0, 0, 0, 0);
      const int dim = idx / per_dim, rem = idx - dim * per_dim, r2 = rem / 5, c5 = rem - r2 * 5;
      dv[i] = idx < nv ? dim * 456 + r2 * 40 + c5 * 8 : -1;
      rv[i] = idx < nv ? *(const uint4*)(CVT + (size_t)dim * 8192 + r2 * 64 + c5 * 8) : make_uint4(0, 0, 0, 0);
    }
#pragma unroll
    for (int i = 0; i < 7; ++i) { if (dk[i] >= 0) *(uint4*)(sK + dk[i]) = rk[i]; if (dv[i] >= 0) *(uint4*)(sVT + dv[i]) = rv[i]; }
  }
  __syncthreads();
  {
    const int wave = tid >> 6, lane = tid & 63;
    const int r = r0 + (wave >> 1), c0 = 32 * half + 16 * (wave & 1);
    const int rs = min(max(r - 4, 0), 120), wsx = min(max(c0 - 8, 0), 32);
    attn_core<true>(p, layer, h, seq * 8192 + r * 64 + c0, r, c0, rs, wsx, sK, sVT, sBias, (rs - rsmin) * 40 + (wsx - colbase), 40, 456, lane);
  }
  __syncthreads();
}
DI void mem_block(const Params& p, int layer, int bt, char* smem, const int tid) {
  const int g = bt & 31, h = (bt >> 5) & 3, seq = bt >> 7;
  bf16_t* sK = (bf16_t*)smem; bf16_t* sVT = sK + 256 * 72;
  const bf16_t* Kg = (const bf16_t*)(p.ws + OFF_KMEM) + (size_t)((layer * 6 + seq) * 4 + h) * 256 * 64;
  const bf16_t* Vg = (const bf16_t*)(p.ws + OFF_VMEMT) + (size_t)((layer * 6 + seq) * 4 + h) * 64 * 256;
  {
    uint4 rk[4], rv[4];
#pragma unroll
    for (int i = 0; i < 4; ++i) { const int idx = tid + NT * i; rk[i] = *(const uint4*)(Kg + (size_t)idx * 8); rv[i] = *(const uint4*)(Vg + (size_t)idx * 8); }
#pragma unroll
    for (int i = 0; i < 4; ++i) { const int idx = tid + NT * i; *(uint4*)(sK + (idx >> 3) * 72 + (idx & 7) * 8) = rk[i]; *(uint4*)(sVT + (idx >> 5) * 264 + (idx & 31) * 8) = rv[i]; }
  }
  __syncthreads();
  {
    const int wave = tid >> 6, lane = tid & 63;
#pragma unroll 1
    for (int i = 0; i < 2; ++i) { int kb0 = 0; asm volatile("" : "+v"(kb0));
      attn_core<false>(p, layer, h, seq * 8192 + (g * 16 + wave * 2 + i) * 16, 0, 0, 0, 0, sK, sVT, nullptr, kb0, 32, 264, lane); }
  }
  __syncthreads();
}

DI void gdn_prep_tok8(const Params& p, int layer, int task, int lane) {
  const int tok0 = task * 8, seq = tok0 >> 13, l0 = tok0 & 8191;
  const bf16_t* X = (const bf16_t*)(p.ws + OFF_BQKV);
  const float* cw = p.conv_w + (size_t)layer * 5 * 768;
  unsigned kp[4][4];
#pragma unroll
  for (int i = 0; i < 3; ++i) {
    const int c = i * 256 + lane * 4;
    uint2 x[12];
#pragma unroll
    for (int jj = 0; jj < 12; ++jj) {
      const int ll = l0 + jj - 2;
      x[jj] = (ll >= 0 && ll < 8192) ? *(const uint2*)(X + (size_t)(tok0 + jj - 2) * 768 + c) : make_uint2(0u, 0u);
    }
    float4 w[5];
#pragma unroll
    for (int j = 0; j < 5; ++j) w[j] = *(const float4*)(cw + j * 768 + c);
    bf16_t* dst = (bf16_t*)(p.ws + (i == 0 ? OFF_QN : i == 1 ? OFF_KN : OFF_VN)) + (size_t)tok0 * 256 + lane * 4;
#pragma unroll
    for (int t = 0; t < 8; ++t) {
      float a0 = 0.f, a1 = 0.f, a2 = 0.f, a3 = 0.f;
#pragma unroll
      for (int j = 0; j < 5; ++j) { const uint2 xv = x[t + j]; a0 += w[j].x * bflo(xv.x); a1 += w[j].y * bfhi(xv.x); a2 += w[j].z * bflo(xv.y); a3 += w[j].w * bfhi(xv.y); }
      a0 = silu(a0); a1 = silu(a1); a2 = silu(a2); a3 = silu(a3);
      if (i < 2) {
        float ss = a0 * a0 + a1 * a1 + a2 * a2 + a3 * a3;
        ss += __shfl_xor(ss, 1, 64); ss += __shfl_xor(ss, 2, 64); ss += __shfl_xor(ss, 4, 64); ss += __shfl_xor(ss, 8, 64);
        const float rs = rsqrtf(ss + 1e-6f) * (i == 0 ? 0.125f : 1.f);
        a0 *= rs; a1 *= rs; a2 *= rs; a3 *= rs;
      }
      uint2 o; o.x = pack2(a0, a1); o.y = pack2(a2, a3);
      *(uint2*)(dst + (size_t)t * 256) = o;
      if (i == 1) {
        if (t & 1) { kp[0][t >> 1] |= (unsigned)f2bf(a0) << 16; kp[1][t >> 1] |= (unsigned)f2bf(a1) << 16; kp[2][t >> 1] |= (unsigned)f2bf(a2) << 16; kp[3][t >> 1] |= (unsigned)f2bf(a3) << 16; }
        else { kp[0][t >> 1] = f2bf(a0); kp[1][t >> 1] = f2bf(a1); kp[2][t >> 1] = f2bf(a2); kp[3][t >> 1] = f2bf(a3); }
      }
    }
  }
  bf16_t* kT = (bf16_t*)(p.ws + OFF_KT) + ((size_t)seq * 256 + lane * 4) * 8192 + l0;
#pragma unroll
  for (int e = 0; e < 4; ++e) *(uint4*)(kT + (size_t)e * 8192) = make_uint4(kp[e][0], kp[e][1], kp[e][2], kp[e][3]);
#pragma unroll
  for (int i2 = 0; i2 < 2; ++i2) {
    const int idx = lane + 64 * i2, gi = idx & 15;
    float* g = (float*)(p.ws + OFF_GATES) + (size_t)tok0 * 16 + idx;
    const float x = *g;
    float r;
    if (gi < 8) {
      const float y = x + p.dt_bias[layer * 8 + gi];
      const float sp = fmaxf(y, 0.f) + __logf(1.f + __expf(-fabsf(y)));
      r = -__expf(p.a_log[layer * 8 + gi]) * sp;
    } else r = __builtin_amdgcn_rcpf(1.f + __expf(-x));
    *g = r;
  }
}

DI void chunk_task(const Params& p, int bt, char* smem, const int tid) {
  const int n = bt & 127, head = (bt >> 7) & 3, seq = bt >> 9;
  const int lane = tid & 63, wave = tid >> 6, fr = lane & 15, fq = lane >> 4;
  float* sL = (float*)smem;
  float* sg = (float*)(smem + 32768);
  float* sbeta = sg + 128; float* sG = sbeta + 128;
  const float* gb = (const float*)(p.ws + OFF_GATES);
  const bf16_t* qn = (const bf16_t*)(p.ws + OFF_QN); const bf16_t* kn = (const bf16_t*)(p.ws + OFF_KN); const bf16_t* vn = (const bf16_t*)(p.ws + OFF_VN);
  const int tokbase = seq * 8192;
  if (tid < 128) {
    const int d = tid >> 6, r = tid & 63; const int pos = d ? 8191 - 64 * n - r : 64 * n + r;
    sg[tid] = gb[(size_t)(tokbase + pos) * 16 + d * 4 + head]; sbeta[tid] = gb[(size_t)(tokbase + pos) * 16 + 8 + d * 4 + head];
  }
  __syncthreads();
  if (tid < 128) {
    float a = sg[tid];
#pragma unroll
    for (int off = 1; off < 64; off <<= 1) { const float t = __shfl_up(a, off, 64); if (lane >= off) a += t; }
    sG[tid] = a;
  }
  __syncthreads();
  {
    const int d = wave >> 1;
    const int ct = ((seq * 4 + head) * 2 + d) * 128 + n;
    if ((wave & 1) == 0) {
      float* cv = (float*)(p.ws + OFF_CVEC) + (size_t)ct * 256;
      const float G = sG[d * 64 + lane], Gl = sG[d * 64 + 63];
      cv[lane] = __expf(G); cv[64 + lane] = __expf(Gl - G); if (lane == 0) cv[128] = __expf(Gl);
    }
    bf16_t* chqk = (bf16_t*)(p.ws + OFF_CHQK) + (size_t)ct * 4096;
    const int hoff = head * 64 + fq * 8;
    bf16x8 kB[4][2];
#pragma unroll
    for (int nt = 0; nt < 4; ++nt) {
      const int rB = 16 * nt + fr; const int posB = d ? 8191 - 64 * n - rB : 64 * n + rB;
      const size_t ob = (size_t)(tokbase + posB) * 256 + hoff;
      kB[nt][0] = ld8(kn + ob); kB[nt][1] = ld8(kn + ob + 32);
    }
    bf16x8 kA[2][2], qA[2][2];
#pragma unroll
    for (int si = 0; si < 2; ++si) {
      const int rA = 16 * (2 * (wave & 1) + si) + fr; const int posA = d ? 8191 - 64 * n - rA : 64 * n + rA;
      const size_t oa = (size_t)(tokbase + posA) * 256 + hoff;
      kA[si][0] = ld8(kn + oa); kA[si][1] = ld8(kn + oa + 32); qA[si][0] = ld8(qn + oa); qA[si][1] = ld8(qn + oa + 32);
    }
#pragma unroll
    for (int si = 0; si < 2; ++si) {
      const int strip = 2 * (wave & 1) + si;
#pragma unroll
      for (int nt = 0; nt < 4; ++nt) {
        f32x4 kk = (f32x4){0.f, 0.f, 0.f, 0.f}, qk = (f32x4){0.f, 0.f, 0.f, 0.f};
        kk = MFMA16(kA[si][0], kB[nt][0], kk); kk = MFMA16(kA[si][1], kB[nt][1], kk);
        qk = MFMA16(qA[si][0], kB[nt][0], qk); qk = MFMA16(qA[si][1], kB[nt][1], qk);
        const int sc = 16 * nt + fr;
#pragma unroll
        for (int e = 0; e < 4; ++e) {
          const int r = 16 * strip + 4 * fq + e;
          const float dec = sc <= r ? __expf(sG[d * 64 + r] - sG[d * 64 + sc]) : 0.f;
          sL[d * 4096 + r * 64 + sc] = sc < r ? sbeta[d * 64 + r] * kk[e] * dec : 0.f;
          chqk[r * 64 + sc] = f2bf(qk[e] * dec);
        }
      }
    }
  }
  __syncthreads();
  {
    const int wvu = __builtin_amdgcn_readfirstlane(wave);
    const int d = wvu >> 1, half = wvu & 1;
    const int ct = ((seq * 4 + head) * 2 + d) * 128 + n;
    const bf16_t* src = (half ? kn : vn) + (size_t)(tokbase + (d ? 8191 - 64 * n : 64 * n)) * 256 + head * 64 + lane;
    const int rstep = d ? -256 : 256;
    float sol[64];
#pragma unroll
    for (int r = 0; r < 64; ++r) sol[r] = bf2f(src[r * rstep]);
#pragma unroll
    for (int r4 = 0; r4 < 16; ++r4) {
      const float4 b4 = *(const float4*)(sbeta + d * 64 + 4 * r4); const float4 g4 = *(const float4*)(sG + d * 64 + 4 * r4);
      sol[4 * r4 + 0] *= half ? b4.x * __expf(g4.x) : b4.x; sol[4 * r4 + 1] *= half ? b4.y * __expf(g4.y) : b4.y;
      sol[4 * r4 + 2] *= half ? b4.z * __expf(g4.z) : b4.z; sol[4 * r4 + 3] *= half ? b4.w * __expf(g4.w) : b4.w;
    }
    const float* Ld = sL + d * 4096;
#pragma unroll
    for (int b = 0; b < 4; ++b) {
#pragma unroll
      for (int j4 = 0; j4 < 4 * b; ++j4) {
        float4 lv[16];
#pragma unroll
        for (int q = 0; q < 16; ++q) lv[q] = *(const float4*)(Ld + (16 * b + q) * 64 + 4 * j4);
#pragma unroll
        for (int q = 0; q < 16; ++q) {
          float a = sol[16 * b + q];
          a -= lv[q].x * sol[4 * j4 + 0]; a -= lv[q].y * sol[4 * j4 + 1]; a -= lv[q].z * sol[4 * j4 + 2]; a -= lv[q].w * sol[4 * j4 + 3];
          sol[16 * b + q] = a;
        }
      }
#pragma unroll
      for (int g4 = 0; g4 < 4; ++g4) {
        float4 lv[16];
#pragma unroll
        for (int q = 4 * g4 + 1; q < 16; ++q) lv[q] = *(const float4*)(Ld + (16 * b + q) * 64 + 16 * b + 4 * g4);
        sol[16 * b + 4 * g4 + 1] -= lv[4 * g4 + 1].x * sol[16 * b + 4 * g4];
        sol[16 * b + 4 * g4 + 2] -= lv[4 * g4 + 2].x * sol[16 * b + 4 * g4] + lv[4 * g4 + 2].y * sol[16 * b + 4 * g4 + 1];
        sol[16 * b + 4 * g4 + 3] -= lv[4 * g4 + 3].x * sol[16 * b + 4 * g4] + lv[4 * g4 + 3].y * sol[16 * b + 4 * g4 + 1] + lv[4 * g4 + 3].z * sol[16 * b + 4 * g4 + 2];
#pragma unroll
        for (int q = 4 * g4 + 4; q < 16; ++q) {
          float a = sol[16 * b + q];
          a -= lv[q].x * sol[16 * b + 4 * g4 + 0]; a -= lv[q].y * sol[16 * b + 4 * g4 + 1]; a -= lv[q].z * sol[16 * b + 4 * g4 + 2]; a -= lv[q].w * sol[16 * b + 4 * g4 + 3];
          sol[16 * b + q] = a;
        }
      }
    }
    if (!half) {
      bf16_t* chu = (bf16_t*)(p.ws + OFF_CHU) + (size_t)ct * 4096 + lane * 64;
#pragma unroll
      for (int r8 = 0; r8 < 8; ++r8) {
        uint4 o; o.x = pack2(sol[r8 * 8 + 0], sol[r8 * 8 + 1]); o.y = pack2(sol[r8 * 8 + 2], sol[r8 * 8 + 3]);
        o.z = pack2(sol[r8 * 8 + 4], sol[r8 * 8 + 5]); o.w = pack2(sol[r8 * 8 + 6], sol[r8 * 8 + 7]);
        *(uint4*)(chu + r8 * 8) = o;
      }
    } else {
      bf16_t* chw = (bf16_t*)(p.ws + OFF_CHW) + (size_t)ct * 4096 + lane;
#pragma unroll
      for (int r = 0; r < 64; ++r) chw[r * 64] = f2bf(sol[r]);
    }
  }
  __syncthreads();
}

DI uint4 rev8(uint4 v) {
  uint4 r;
  r.x = (v.w >> 16) | (v.w << 16); r.y = (v.z >> 16) | (v.z << 16); r.z = (v.y >> 16) | (v.y << 16); r.w = (v.x >> 16) | (v.x << 16);
  return r;
}
DI void scan_task(const Params& p, int task, char* smem, const int tid) {
  const int d = task & 1, head = (task >> 1) & 3, seq = task >> 3;
  const bool loader = tid >= 256;
  const int lt = tid & 255, lane = tid & 63, wave = lt >> 6, fr = lane & 15, fq = lane >> 4;
  const int row0 = lt >> 3, c8 = (lt & 7) * 8, rc8 = (7 - (lt & 7)) * 8;
  constexpr int BUFB = 49152;
  const int ctb = ((seq * 4 + head) * 2 + d) * 128;
  const bf16_t* chw = (const bf16_t*)(p.ws + OFF_CHW); const bf16_t* chu = (const bf16_t*)(p.ws + OFF_CHU); const bf16_t* chqk = (const bf16_t*)(p.ws + OFF_CHQK);
  const float* cvec = (const float*)(p.ws + OFF_CVEC);
  const bf16_t* qn = (const bf16_t*)(p.ws + OFF_QN) + (size_t)seq * 8192 * 256 + head * 64;
  const bf16_t* kT = (const bf16_t*)(p.ws + OFF_KT) + (size_t)(seq * 256 + head * 64) * 8192;
  bf16_t* O = (bf16_t*)(p.ws + (d ? OFF_OB : OFF_OF)) + (size_t)seq * 8192 * 256 + head * 64 + 32 * (wave & 1) + fr;
#define SCAN_STAGE(n_, buf_) do { \
    const size_t cb = (size_t)(ctb + (n_)) * 4096 + row0 * 64 + c8; \
    const uint4 rw0 = *(const uint4*)(chw + cb), rw1 = *(const uint4*)(chw + cb + 2048); \
    const uint4 rqk0 = *(const uint4*)(chqk + cb), rqk1 = *(const uint4*)(chqk + cb + 2048); \
    const uint4 ru0 = *(const uint4*)(chu + cb), ru1 = *(const uint4*)(chu + cb + 2048); \
    const int pos0 = d ? 8191 - 64 * (n_) - row0 : 64 * (n_) + row0, pos1 = d ? pos0 - 32 : pos0 + 32; \
    const uint4 rq0 = *(const uint4*)(qn + (size_t)pos0 * 256 + c8), rq1 = *(const uint4*)(qn + (size_t)pos1 * 256 + c8); \
    const int lbase = d ? 8191 - 64 * (n_) - 63 : 64 * (n_); \
    const uint4 rkt0 = *(const uint4*)(kT + (size_t)row0 * 8192 + lbase + c8), rkt1 = *(const uint4*)(kT + (size_t)(row0 + 32) * 8192 + lbase + c8); \
    const float rv = cvec[(size_t)(ctb + (n_)) * 256 + (lt < 129 ? lt : 128)]; \
    bf16_t* sW_ = (bf16_t*)(smem + (buf_) * BUFB); bf16_t* sQK_ = sW_ + 64 * 72; bf16_t* sQ_ = sQK_ + 64 * 72; bf16_t* sKT_ = sQ_ + 64 * 72; bf16_t* sU_ = sKT_ + 64 * 72; \
    float* sV_ = (float*)(smem + (buf_) * BUFB + 5 * 64 * 72 * 2); \
    *(uint4*)(sW_ + row0 * 72 + c8) = rw0; *(uint4*)(sW_ + (row0 + 32) * 72 + c8) = rw1; \
    *(uint4*)(sQK_ + row0 * 72 + c8) = rqk0; *(uint4*)(sQK_ + (row0 + 32) * 72 + c8) = rqk1; \
    *(uint4*)(sU_ + row0 * 72 + c8) = ru0; *(uint4*)(sU_ + (row0 + 32) * 72 + c8) = ru1; \
    *(uint4*)(sQ_ + row0 * 72 + c8) = rq0; *(uint4*)(sQ_ + (row0 + 32) * 72 + c8) = rq1; \
    if (d) { *(uint4*)(sKT_ + row0 * 72 + rc8) = rev8(rkt0); *(uint4*)(sKT_ + (row0 + 32) * 72 + rc8) = rev8(rkt1); } \
    else { *(uint4*)(sKT_ + row0 * 72 + c8) = rkt0; *(uint4*)(sKT_ + (row0 + 32) * 72 + c8) = rkt1; } \
    if (lt < 129) sV_[lt] = rv; } while (0)
#define SCAN_BAR() do { asm volatile("s_waitcnt lgkmcnt(0)" ::: "memory"); __builtin_amdgcn_s_barrier(); asm volatile("" ::: "memory"); } while (0)
  f32x4 S[4][2];
#pragma unroll
  for (int mt = 0; mt < 4; ++mt) { S[mt][0] = (f32x4){0.f, 0.f, 0.f, 0.f}; S[mt][1] = (f32x4){0.f, 0.f, 0.f, 0.f}; }
#define SCAN_LDF(f_, base_, h2_) do { _Pragma("unroll") for (int m2 = 0; m2 < 2; ++m2) { const bf16_t* p_ = (base_) + (16 * (2 * (h2_) + m2) + fr) * 72 + 4 * fq; \
    f_[m2][0] = ld4x2(p_, p_ + 16); f_[m2][1] = ld4x2(p_ + 32, p_ + 48); } } while (0)
#define SCAN_SB() __builtin_amdgcn_sched_barrier(0)
#define SCAN_COMPUTE(n_, buf_) do { \
    const bf16_t* sW = (const bf16_t*)(smem + (buf_) * BUFB); const bf16_t* sQK = sW + 64 * 72; const bf16_t* sQ = sQK + 64 * 72; const bf16_t* sKT = sQ + 64 * 72; const bf16_t* sU = sKT + 64 * 72; \
    const float* sV = (const float*)(smem + (buf_) * BUFB + 5 * 64 * 72 * 2); \
    bf16x8 fA[2][2], fB[2][2]; \
    SCAN_LDF(fA, sW, 0); SCAN_SB(); \
    bf16x8 Sb[2][2]; \
    _Pragma("unroll") for (int nt = 0; nt < 2; ++nt) { Sb[0][nt] = pack8(S[0][nt], S[1][nt]); Sb[1][nt] = pack8(S[2][nt], S[3][nt]); } \
    f32x4 v[4][2], o[4][2]; \
      \
    SCAN_LDF(fB, sW, 1); \
    _Pragma("unroll") for (int m2 = 0; m2 < 2; ++m2) _Pragma("unroll") for (int nt = 0; nt < 2; ++nt) { \
      v[m2][nt] = MFMA16(fA[m2][0], Sb[0][nt], ((f32x4){0.f, 0.f, 0.f, 0.f})); v[m2][nt] = MFMA16(fA[m2][1], Sb[1][nt], v[m2][nt]); } \
    SCAN_SB(); \
    SCAN_LDF(fA, sQ, 0); \
    _Pragma("unroll") for (int m2 = 0; m2 < 2; ++m2) _Pragma("unroll") for (int nt = 0; nt < 2; ++nt) { \
      v[2 + m2][nt] = MFMA16(fB[m2][0], Sb[0][nt], ((f32x4){0.f, 0.f, 0.f, 0.f})); v[2 + m2][nt] = MFMA16(fB[m2][1], Sb[1][nt], v[2 + m2][nt]); } \
    SCAN_SB(); \
    SCAN_LDF(fB, sQ, 1); \
    _Pragma("unroll") for (int m2 = 0; m2 < 2; ++m2) _Pragma("unroll") for (int nt = 0; nt < 2; ++nt) { \
      o[m2][nt] = MFMA16(fA[m2][0], Sb[0][nt], ((f32x4){0.f, 0.f, 0.f, 0.f})); o[m2][nt] = MFMA16(fA[m2][1], Sb[1][nt], o[m2][nt]); } \
    SCAN_SB(); \
    SCAN_LDF(fA, sKT, 0); \
    _Pragma("unroll") for (int m2 = 0; m2 < 2; ++m2) _Pragma("unroll") for (int nt = 0; nt < 2; ++nt) { \
      o[2 + m2][nt] = MFMA16(fB[m2][0], Sb[0][nt], ((f32x4){0.f, 0.f, 0.f, 0.f})); o[2 + m2][nt] = MFMA16(fB[m2][1], Sb[1][nt], o[2 + m2][nt]); } \
    SCAN_SB(); \
    bf16x8 Vb[2][2], Vkb[2][2]; \
    {   \
      _Pragma("unroll") for (int mt = 0; mt < 4; ++mt) { \
        const float4 eg = *(const float4*)(sV + 16 * mt + 4 * fq); \
        _Pragma("unroll") for (int nt = 0; nt < 2; ++nt) { \
          const uint2 u = *(const uint2*)(sU + (32 * wave + 16 * nt + fr) * 72 + 16 * mt + 4 * fq); \
          v[mt][nt][0] = bflo(u.x) - v[mt][nt][0]; v[mt][nt][1] = bfhi(u.x) - v[mt][nt][1]; v[mt][nt][2] = bflo(u.y) - v[mt][nt][2]; v[mt][nt][3] = bfhi(u.y) - v[mt][nt][3]; \
          o[mt][nt][0] *= eg.x; o[mt][nt][1] *= eg.y; o[mt][nt][2] *= eg.z; o[mt][nt][3] *= eg.w; } \
      } \
      _Pragma("unroll") for (int nt = 0; nt < 2; ++nt) { \
        Vb[0][nt] = pack8(v[0][nt], v[1][nt]); Vb[1][nt] = pack8(v[2][nt], v[3][nt]); } \
      _Pragma("unroll") for (int mt = 0; mt < 4; ++mt) { \
        const float4 ek = *(const float4*)(sV + 64 + 16 * mt + 4 * fq); \
        _Pragma("unroll") for (int nt = 0; nt < 2; ++nt) { v[mt][nt][0] *= ek.x; v[mt][nt][1] *= ek.y; v[mt][nt][2] *= ek.z; v[mt][nt][3] *= ek.w; } } \
      _Pragma("unroll") for (int nt = 0; nt < 2; ++nt) { \
        Vkb[0][nt] = pack8(v[0][nt], v[1][nt]); Vkb[1][nt] = pack8(v[2][nt], v[3][nt]); } \
    } \
    const float gl = sV[128]; \
    SCAN_SB(); \
    SCAN_LDF(fB, sKT, 1); \
    _Pragma("unroll") for (int m2 = 0; m2 < 2; ++m2) _Pragma("unroll") for (int nt = 0; nt < 2; ++nt) { \
      f32x4 a; a[0] = S[m2][nt][0] * gl; a[1] = S[m2][nt][1] * gl; a[2] = S[m2][nt][2] * gl; a[3] = S[m2][nt][3] * gl; \
      a = MFMA16(fA[m2][0], Vkb[0][nt], a); S[m2][nt] = MFMA16(fA[m2][1], Vkb[1][nt], a); } \
    SCAN_SB(); \
    SCAN_LDF(fA, sQK, 0); \
    _Pragma("unroll") for (int m2 = 0; m2 < 2; ++m2) _Pragma("unroll") for (int nt = 0; nt < 2; ++nt) { \
      f32x4 a; a[0] = S[2 + m2][nt][0] * gl; a[1] = S[2 + m2][nt][1] * gl; a[2] = S[2 + m2][nt][2] * gl; a[3] = S[2 + m2][nt][3] * gl; \
      a = MFMA16(fB[m2][0], Vkb[0][nt], a); S[2 + m2][nt] = MFMA16(fB[m2][1], Vkb[1][nt], a); } \
    SCAN_SB(); \
    SCAN_LDF(fB, sQK, 1); \
    _Pragma("unroll") for (int m2 = 0; m2 < 2; ++m2) _Pragma("unroll") for (int nt = 0; nt < 2; ++nt) { \
      o[m2][nt] = MFMA16(fA[m2][0], Vb[0][nt], o[m2][nt]); o[m2][nt] = MFMA16(fA[m2][1], Vb[1][nt], o[m2][nt]); } \
    SCAN_SB(); \
    _Pragma("unroll") for (int m2 = 0; m2 < 2; ++m2) _Pragma("unroll") for (int nt = 0; nt < 2; ++nt) { \
      o[2 + m2][nt] = MFMA16(fB[m2][0], Vb[0][nt], o[2 + m2][nt]); o[2 + m2][nt] = MFMA16(fB[m2][1], Vb[1][nt], o[2 + m2][nt]); } \
    _Pragma("unroll") for (int mt = 0; mt < 4; ++mt) _Pragma("unroll") for (int e = 0; e < 4; ++e) { \
      const int r_ = 16 * mt + 4 * fq + e; const int pos = d ? 8191 - 64 * (n_) - r_ : 64 * (n_) + r_; \
      O[(size_t)pos * 256] = f2bf(o[mt][0][e]); O[(size_t)pos * 256 + 16] = f2bf(o[mt][1][e]); \
    } } while (0)
  __syncthreads();
  if (loader) SCAN_STAGE(0, 0);
  SCAN_BAR();
#pragma unroll 1
  for (int n = 0; n < 128; ++n) {
    if (loader) { if (n + 1 < 128) SCAN_STAGE(n + 1, ((n + 1) & 1)); }
    else if (wave < 2) SCAN_COMPUTE(n, (n & 1));
    SCAN_BAR();
  }
  asm volatile("s_waitcnt vmcnt(0)" ::: "memory");
  __syncthreads();
#undef SCAN_STAGE
#undef SCAN_BAR
#undef SCAN_COMPUTE
#undef SCAN_LDF
#undef SCAN_SB
}

DI void gdn_finish_tok4(const Params& p, int layer, int tok0, int lane) {
  const float4 g = *(const float4*)(p.gdn_g + layer * 64 + (lane & 15) * 4);
  uint2 a[4], b[4], z[4];
#pragma unroll
  for (int t = 0; t < 4; ++t) {
    const size_t ro = (size_t)(tok0 + t) * 256 + lane * 4;
    a[t] = *(const uint2*)((const bf16_t*)(p.ws + OFF_OF) + ro); b[t] = *(const uint2*)((const bf16_t*)(p.ws + OFF_OB) + ro);
    z[t] = *(const uint2*)((const bf16_t*)(p.ws + OFF_MIX) + (size_t)(tok0 + t) * 1024 + 256 + lane * 4);
  }
#pragma unroll
  for (int t = 0; t < 4; ++t) {
    const float o0 = bflo(a[t].x) + bflo(b[t].x), o1 = bfhi(a[t].x) + bfhi(b[t].x), o2 = bflo(a[t].y) + bflo(b[t].y), o3 = bfhi(a[t].y) + bfhi(b[t].y);
    float ss = o0 * o0 + o1 * o1 + o2 * o2 + o3 * o3;
    ss += __shfl_xor(ss, 1, 64); ss += __shfl_xor(ss, 2, 64); ss += __shfl_xor(ss, 4, 64); ss += __shfl_xor(ss, 8, 64);
    const float rs = rsqrtf(ss * (1.f / 64.f) + 1e-6f);
    uint2 w; w.x = pack2(o0 * rs * g.x * silu(bflo(z[t].x)), o1 * rs * g.y * silu(bfhi(z[t].x)));
    w.y = pack2(o2 * rs * g.z * silu(bflo(z[t].y)), o3 * rs * g.w * silu(bfhi(z[t].y)));
    *(uint2*)((bf16_t*)(p.ws + OFF_MIX) + (size_t)(tok0 + t) * 1024 + 256 + lane * 4) = w;
  }
}

DI void post_token2(const Params& p, int layer, int tok0, int lane) {
  const float* pg = p.post_g + layer * 1024;
  uint2 ob[2][4]; float4 xr[2][4], g[4];
#pragma unroll
  for (int t = 0; t < 2; ++t) {
    const bf16_t* o = (const bf16_t*)(p.ws + OFF_OUTTMP) + (size_t)(tok0 + t) * 1024;
    const float* xp = layer == 0 ? xrow(p, tok0 + t) : p.out + (size_t)(tok0 + t) * 1024;
#pragma unroll
    for (int i = 0; i < 4; ++i) { ob[t][i] = *(const uint2*)(o + i * 256 + lane * 4); xr[t][i] = *(const float4*)(xp + i * 256 + lane * 4); }
  }
#pragma unroll
  for (int i = 0; i < 4; ++i) g[i] = *(const float4*)(pg + i * 256 + lane * 4);
#pragma unroll
  for (int t = 0; t < 2; ++t) {
    float4 v[4]; float ss = 0.f;
#pragma unroll
    for (int i = 0; i < 4; ++i) { const uint2 u = ob[t][i]; v[i] = make_float4(bflo(u.x), bfhi(u.x), bflo(u.y), bfhi(u.y));
      ss += v[i].x * v[i].x + v[i].y * v[i].y + v[i].z * v[i].z + v[i].w * v[i].w; }
    ss = wave_sum(ss);
    const float rs = rsqrtf(ss * (1.f / 1024.f) + 1e-6f);
    float ss2 = 0.f;
#pragma unroll
    for (int i = 0; i < 4; ++i) {
      const float4 x = xr[t][i];
      v[i].x = x.x + v[i].x * rs * g[i].x; v[i].y = x.y + v[i].y * rs * g[i].y; v[i].z = x.z + v[i].z * rs * g[i].z; v[i].w = x.w + v[i].w * rs * g[i].w;
      ss2 += v[i].x * v[i].x + v[i].y * v[i].y + v[i].z * v[i].z + v[i].w * v[i].w;
      *(float4*)(p.out + (size_t)(tok0 + t) * 1024 + i * 256 + lane * 4) = v[i];
    }
    if (layer == 0) {
      ss2 = wave_sum(ss2);
      const float rs2 = rsqrtf(ss2 * (1.f / 1024.f) + 1e-6f);
      bf16_t* dst = (bf16_t*)(p.ws + OFF_X) + (size_t)(tok0 + t) * 1024;
#pragma unroll
      for (int i = 0; i < 4; ++i) { uint2 w; w.x = pack2(v[i].x * rs2, v[i].y * rs2); w.y = pack2(v[i].z * rs2, v[i].w * rs2); *(uint2*)(dst + i * 256 + lane * 4) = w; }
    }
  }
}

#define XB_TMO      128
#define XB_XCNT(j)  (256  + 64 * (j))
#define XB_XSUB(j)  (1280 + 64 * (j))
#define XB_XGEN(j)  (2304 + 64 * (j))
#define XB_TOP      3328
#define XB_TOPGEN   3392
#define XCD_BAR_WORDS 3456
#define XB_SPIN_CAP (1u << 18)
#define XLAS __attribute__((address_space(3)))

__device__ __forceinline__ unsigned xb_ld(unsigned* p)              { return __hip_atomic_load(p, __ATOMIC_RELAXED, __HIP_MEMORY_SCOPE_AGENT); }
__device__ __forceinline__ unsigned xb_add(unsigned* p, unsigned v) { return __hip_atomic_fetch_add(p, v, __ATOMIC_RELAXED, __HIP_MEMORY_SCOPE_AGENT); }
__device__ __forceinline__ unsigned xb_xcc_id() { return (unsigned)__builtin_amdgcn_s_getreg((3 << 11) | 20) & 0xFu; }
#define XB_SPIN(cond, bar) do { unsigned _sp = 0; while (cond) { __builtin_amdgcn_s_sleep(1); \
    if ((++_sp & 255u) == 0u) { if (xb_ld(&(bar)[XB_TMO])) break; if (_sp > XB_SPIN_CAP) { atomicAdd(&(bar)[XB_TMO], 1u); break; } } } } while (0)

struct XcdBarrier {
    unsigned* bar; unsigned x;
    volatile XLAS unsigned* st;
};

__device__ __forceinline__ XcdBarrier xcd_barrier_post(unsigned* bar, volatile XLAS unsigned* st) {
    XcdBarrier b; b.bar = bar; b.x = xb_xcc_id(); b.st = st;
    if (threadIdx.x == 0) (void)xb_add(&bar[XB_XCNT(b.x)], 1u);
    return b;
}
__device__ __forceinline__ void xcd_barrier_complete(unsigned* bar, unsigned x, unsigned& nloc, unsigned& nx) {
    const unsigned G = gridDim.x * gridDim.y * gridDim.z;
    unsigned sum, cnt, mine, sp = 0u;
    for (;;) {
        sum = 0u; cnt = 0u; mine = 0u;
#pragma unroll
        for (unsigned j = 0; j < 16; ++j) { const unsigned c = xb_ld(&bar[XB_XCNT(j)]); sum += c; cnt += (c > 0u) ? 1u : 0u; mine = (j == x) ? c : mine; }
        if (sum == G) break;
        __builtin_amdgcn_s_sleep(1);
        if ((++sp & 255u) == 0u) { if (xb_ld(&bar[XB_TMO])) break; if (sp > XB_SPIN_CAP) { atomicAdd(&bar[XB_TMO], 1u); break; } }
    }
    nloc = mine > 0u ? mine : 1u; nx = cnt > 0u ? cnt : 1u;
}

__device__ __forceinline__ void xcd_barrier(const XcdBarrier& b) {
    asm volatile("s_waitcnt vmcnt(0)" ::: "memory");
    __syncthreads();
    if (threadIdx.x == 0) {
        unsigned* bar = b.bar;
        __builtin_amdgcn_s_waitcnt(0);
        unsigned nloc = b.st[0], nx = b.st[1];
        if (nloc == 0u) { xcd_barrier_complete(bar, b.x, nloc, nx); b.st[0] = nloc; b.st[1] = nx; }
        const unsigned old = xb_add(&bar[XB_XSUB(b.x)], 1u);
        const unsigned gen = old / nloc;
        if (old + 1u == (gen + 1u) * nloc) {
            __builtin_amdgcn_fence(__ATOMIC_RELEASE, "agent");
            asm volatile("s_waitcnt vmcnt(0)" ::: "memory");
            const unsigned og = xb_add(&bar[XB_TOP], 1u);
            const unsigned tg = og / nx;
            if (og + 1u == (tg + 1u) * nx) xb_add(&bar[XB_TOPGEN], 1u);
            else XB_SPIN(xb_ld(&bar[XB_TOPGEN]) == tg, bar);
            __builtin_amdgcn_fence(__ATOMIC_ACQUIRE, "agent");
            xb_add(&bar[XB_XGEN(b.x)], 1u);
            asm volatile("s_waitcnt vmcnt(0)" ::: "memory");
        } else {
            XB_SPIN(xb_ld(&bar[XB_XGEN(b.x)]) == gen, bar);
            __builtin_amdgcn_fence(__ATOMIC_ACQUIRE, "agent");
            asm volatile("s_waitcnt vmcnt(0)" ::: "memory");
        }
    }
    __syncthreads();
}

constexpr int LDS_BYTES = 131072;
__global__ void __launch_bounds__(NT, 2) fwd_megakernel(Params p0) {
  cg::grid_group grid = cg::this_grid();
  extern __shared__ __attribute__((aligned(16))) unsigned char shm[];
  char* smem = (char*)shm;
  PG8_LAS unsigned char* lds = (PG8_LAS unsigned char*)shm;
  const int nb = gridDim.x, bid = blockIdx.x, nw = gridDim.x * (NT / 64);
  __shared__ __attribute__((aligned(16))) unsigned xb_st[4];
  if (threadIdx.x < 4) xb_st[threadIdx.x] = 0u;
  __syncthreads();
  const XcdBarrier xbar = xcd_barrier_post((unsigned*)(p0.ws + OFF_BAR), (volatile XLAS unsigned*)xb_st);
#define GSYNC() xcd_barrier(xbar)
#define PH_BEGIN const Params p = launder(p0); const int tid = ltid(); const int lane = tid & 63; const int gw = bid * (NT / 64) + (tid >> 6); (void)lane; (void)gw;
  { PH_BEGIN phase0(p, tid); }
  grid.sync();
#pragma unroll 1
  for (int layer = 0; layer < 2; ++layer) {
    {
      PH_BEGIN
      InProjEpi epi{p.ws};
      run_gemm(lds, (const bf16_t*)(p.ws + OFF_X), (const bf16_t*)(p.ws + OFF_WIN) + (size_t)layer * NPAD * 1024, NTOK, NPAD, 1024, epi, tid);
    }
    if (layer == 0 && bid >= 192 && bid < 216) {
      PH_BEGIN
      const int l2 = (bid - 192) / 12, c = (bid - 192) - 12 * l2;
      MemKvEpi me{p.ws, l2};
      run_gemm_on(lds, (const bf16_t*)(p.ws + OFF_MEMN), (const bf16_t*)(p.ws + OFF_WMEM) + (size_t)l2 * 512 * 1024, 1536, 512, 1024, me, tid, 12, c);
    }
    GSYNC();
    { PH_BEGIN
      if (nb == 256) {
#pragma unroll 1
        for (int k = 0; k < 6; ++k) na_block(p, layer, (bid & 7) * 192 + (bid >> 3) + 32 * k, smem, tid);
      } else {
#pragma unroll 1
        for (int t = bid; t < 1536; t += nb) na_block(p, layer, t, smem, tid);
      } }
    { PH_BEGIN
#pragma unroll 1
      for (int t = gw; t < NTOK / 8; t += nw) gdn_prep_tok8(p, layer, t, lane); }
    GSYNC();
    { PH_BEGIN
      const int half = tid >> 8;
#pragma unroll 1
      for (int t = bid; t < 1536; t += nb) chunk_task(p, 2 * t + half, smem + half * 36864, tid & 255); }
    GSYNC();
    if (bid < 48) { PH_BEGIN scan_task(p, bid, smem, tid); }
    else { PH_BEGIN
      if (nb == 256) {
        const int x = bid & 7, j = (bid - 48) >> 3;
#pragma unroll 1
        for (int li = j; li < 96; li += 26) fft_task(p, (li >> 4) * 128 + 16 * x + (li & 15), (float2*)smem, tid);
      } else {
#pragma unroll 1
        for (int t = bid - 48; t < 768; t += nb - 48) fft_task(p, t, (float2*)smem, tid);
      }
      if (nb == 256) {
        const int x = bid & 7, j = (bid - 48) >> 3;
#pragma unroll 1
        for (int li = j; li < 96; li += 26) mem_block(p, layer, (3 * x + (li >> 5)) * 32 + (li & 31), smem, tid);
      } else {
#pragma unroll 1
        for (int t = bid - 48; t < 768; t += nb - 48) mem_block(p, layer, t, smem, tid);
      } }
    GSYNC();
    { PH_BEGIN
#pragma unroll 1
      for (int t = gw; t < NTOK / 4; t += nw) gdn_finish_tok4(p, layer, 4 * t, lane); }
    {
      PH_BEGIN
      FnetEpiDirect fe{p.ws};
      { pg8::Gemm g; g.A = (const bf16_t*)(p.ws + OFF_H); g.Bt = (const bf16_t*)(p.ws + OFF_WF) + (size_t)layer * 256 * 512; g.M = NTOK; g.N = 256; g.K = 512;
        pg8::StaticOrder S; S.init(NTOK, 256, (int)gridDim.x, (int)blockIdx.x);
        pg8::gemm_phase<FnetEpiDirect, pg8::StaticOrder, false>(lds, g, S, fe, nullptr, tid);
        __syncthreads(); }
    }
    GSYNC();
    {
      PH_BEGIN
      OutEpi oe{(bf16_t*)(p.ws + OFF_OUTTMP)};
      run_gemm(lds, (const bf16_t*)(p.ws + OFF_MIX), (const bf16_t*)(p.ws + OFF_WOUT) + (size_t)layer * 1024 * 1024, NTOK, 1024, 1024, oe, tid);
    }
    GSYNC();
    { PH_BEGIN
#pragma unroll 1
      for (int t = gw; t < NTOK / 2; t += nw) post_token2(p, layer, 2 * t, lane); }
    if (layer == 0) GSYNC();
  }
}

extern "C" void kernel_launch(void* const* d_in, const int* in_sizes, int n_in, void* d_out, int out_size, void* d_ws, size_t ws_size, hipStream_t stream) {
  static int grid_blocks = 0;
  if (!grid_blocks) {
    int dev = 0, cus = 0, per_cu = 0;
    (void)hipGetDevice(&dev);
    (void)hipDeviceGetAttribute(&cus, hipDeviceAttributeMultiprocessorCount, dev);
    if (hipFuncSetAttribute((const void*)fwd_megakernel, hipFuncAttributeMaxDynamicSharedMemorySize, LDS_BYTES) != hipSuccess) fprintf(stderr, "hipFuncSetAttribute failed\n");
    (void)hipOccupancyMaxActiveBlocksPerMultiprocessor(&per_cu, fwd_megakernel, NT, LDS_BYTES);
    if (per_cu > 1) per_cu = 1;
    grid_blocks = cus * per_cu;
    if (grid_blocks <= 0) { fprintf(stderr, "occupancy query returned %d x %d\n", cus, per_cu); grid_blocks = -1; }
  }
  if (grid_blocks < 0) return;
  if (ws_size < WS_NEED || n_in != 16) { fprintf(stderr, "kernel_launch: need %zu bytes of workspace, got %zu (n_in %d)\n", (size_t)WS_NEED, ws_size, n_in); return; }
  Params p{};
  p.x_prompt = (const float*)d_in[0]; p.x_sample = (const float*)d_in[1]; p.mem_prompt = (const float*)d_in[2]; p.mem_sample = (const float*)d_in[3];
  p.pre_g = (const float*)d_in[4]; p.post_g = (const float*)d_in[5]; p.w_in = (const float*)d_in[6]; p.w_fnet = (const float*)d_in[7];
  p.conv_w = (const float*)d_in[8]; p.a_log = (const float*)d_in[9]; p.dt_bias = (const float*)d_in[10]; p.gdn_g = (const float*)d_in[11];
  p.rpb = (const float*)d_in[12]; p.mem_g = (const float*)d_in[13]; p.w_mem_kv = (const float*)d_in[14]; p.w_out = (const float*)d_in[15];
  p.out = (float*)d_out; p.ws = (unsigned char*)d_ws;
  if (hipMemsetAsync((unsigned char*)d_ws + OFF_BAR, 0, XCD_BAR_WORDS * sizeof(unsigned), stream) != hipSuccess) { fprintf(stderr, "memset failed\n"); return; }
  void* args[] = {&p};
  hipError_t e = hipLaunchCooperativeKernel((void*)fwd_megakernel, dim3(grid_blocks), dim3(NT), args, LDS_BYTES, stream);
  if (e != hipSuccess) fprintf(stderr, "cooperative launch failed: %s (grid %d)\n", hipGetErrorString(e), grid_blocks);
}
```

```cpp
#include <hip/hip_runtime.h>
#include <hip/hip_cooperative_groups.h>
#include <cstdio>
namespace cg = cooperative_groups;

typedef unsigned short bf16_t;
typedef short bf16x8 __attribute__((ext_vector_type(8)));
typedef float f32x4 __attribute__((ext_vector_type(4)));

#define NT 512
#define DI __device__ __forceinline__
#define MFMA16(a, b, c) __builtin_amdgcn_mfma_f32_16x16x32_bf16((a), (b), (c), 0, 0, 0)

constexpr int SEQL = 8192, NTOK = 49152;
constexpr size_t MiB = (size_t)1 << 20;
constexpr int NPAD = 3328;
constexpr size_t OFF_WIN = 0, OFF_WOUT = 13631488, OFF_WMEM = 17825792, OFF_WF = 19922944, OFF_MEMN = 20447232,
                 OFF_KMEM = 23592960, OFF_VMEMT = 25165824, OFF_TW = 26738688;
constexpr size_t OFF_MIX = 26 * MiB, OFF_AZ = 122 * MiB, OFF_CZ = 146 * MiB, OFF_DZ = 170 * MiB, OFF_GATES = 194 * MiB, OFF_X = 197 * MiB,
                 OFF_BQKV = 293 * MiB, OFF_CK = 365 * MiB, OFF_CVT = 389 * MiB;
constexpr size_t OFF_H = OFF_X, OFF_QN = 245 * MiB, OFF_KN = 269 * MiB, OFF_KT = 464 * MiB, OFF_VN = 488 * MiB;
constexpr size_t OFF_CHW = 293 * MiB, OFF_CHU = 341 * MiB, OFF_CHQK = 389 * MiB, OFF_CVEC = 437 * MiB;
constexpr size_t OFF_OF = OFF_KN, OFF_OB = OFF_VN, OFF_OUTTMP = 293 * MiB;
constexpr size_t OFF_BAR = 26771456;
constexpr size_t WS_NEED = 512 * MiB;

struct Params {
  const float* x_prompt; const float* x_sample; const float* mem_prompt; const float* mem_sample;
  const float* pre_g; const float* post_g; const float* w_in; const float* w_fnet; const float* conv_w;
  const float* a_log; const float* dt_bias; const float* gdn_g; const float* rpb; const float* mem_g;
  const float* w_mem_kv; const float* w_out;
  float* out; unsigned char* ws;
};

typedef float f32x2_t __attribute__((ext_vector_type(2)));
typedef __bf16 bf16x2_t __attribute__((ext_vector_type(2)));
DI unsigned pack2(float lo, float hi) { f32x2_t f = {lo, hi}; return __builtin_bit_cast(unsigned, __builtin_convertvector(f, bf16x2_t)); }
DI bf16_t f2bf(float x) { return (bf16_t)(pack2(x, 0.f) & 0xffffu); }
DI float bf2f(bf16_t h) { return __uint_as_float(((unsigned)h) << 16); }
DI float bflo(unsigned u) { return __uint_as_float(u << 16); }
DI float bfhi(unsigned u) { return __uint_as_float(u & 0xffff0000u); }
DI float wave_sum(float v) {
#pragma unroll
  for (int m = 32; m >= 1; m >>= 1) v += __shfl_xor(v, m, 64);
  return v;
}
DI float silu(float x) { return x * __builtin_amdgcn_rcpf(1.f + __expf(-x)); }
DI bf16x8 pack8(const f32x4& a, const f32x4& b) {
  uint4 u; u.x = pack2(a[0], a[1]); u.y = pack2(a[2], a[3]); u.z = pack2(b[0], b[1]); u.w = pack2(b[2], b[3]);
  return __builtin_bit_cast(bf16x8, u);
}
DI bf16x8 ld8(const bf16_t* p) { return *(const bf16x8*)p; }
DI bf16x8 ld4x2(const bf16_t* lo, const bf16_t* hi) {
  uint2 a = *(const uint2*)lo, b = *(const uint2*)hi; uint4 u; u.x = a.x; u.y = a.y; u.z = b.x; u.w = b.y;
  return __builtin_bit_cast(bf16x8, u);
}
DI int ltid() { int t = threadIdx.x; asm volatile("" : "+v"(t)); return t; }
DI Params launder(Params p) { size_t z = 0; asm volatile("" : "+s"(z)); p.ws = p.ws + z; return p; }
DI float4 ldnt4(const float* q) { const f32x4 v = __builtin_nontemporal_load((const f32x4*)q); return make_float4(v[0], v[1], v[2], v[3]); }
DI const float* xrow(const Params& p, int tok) {
  return tok < 32768 ? p.x_prompt + (size_t)tok * 1024 : p.x_sample + (size_t)(tok - 32768) * 1024;
}

DI void norm_row_bf16(const float* src, bf16_t* dst, int lane) {
  float4 v[4]; float ss = 0.f;
#pragma unroll
  for (int i = 0; i < 4; ++i) { v[i] = *(const float4*)(src + i * 256 + lane * 4); ss += v[i].x * v[i].x + v[i].y * v[i].y + v[i].z * v[i].z + v[i].w * v[i].w; }
  ss = wave_sum(ss);
  const float rs = rsqrtf(ss * (1.f / 1024.f) + 1e-6f);
#pragma unroll
  for (int i = 0; i < 4; ++i) { uint2 o; o.x = pack2(v[i].x * rs, v[i].y * rs); o.y = pack2(v[i].z * rs, v[i].w * rs); *(uint2*)(dst + i * 256 + lane * 4) = o; }
}

DI void phase0(const Params& p, const int tid) {
  const int gtid = blockIdx.x * NT + tid, gsz = gridDim.x * NT;
  bf16_t* WinT = (bf16_t*)(p.ws + OFF_WIN);
  for (int idx = gtid; idx < 2 * NPAD * 128; idx += gsz) {
    const int l = idx / (NPAD * 128); const int rem = idx - l * NPAD * 128; const int k8 = rem / NPAD; const int r = rem - k8 * NPAD;
    const int src = r < 1536 ? r : (r < 3072 ? r + 16 : (r < 3088 ? 1536 + (r - 3072) : -1));
    uint4 o = make_uint4(0, 0, 0, 0);
    if (src >= 0) {
      const float* w = p.w_in + ((size_t)l * 1024 + k8 * 8) * 3088 + src;
      const float* g = p.pre_g + l * 1024 + k8 * 8;
      float v[8];
#pragma unroll
      for (int j = 0; j < 8; ++j) v[j] = w[(size_t)j * 3088] * g[j];
      o.x = pack2(v[0], v[1]); o.y = pack2(v[2], v[3]); o.z = pack2(v[4], v[5]); o.w = pack2(v[6], v[7]);
    }
    *(uint4*)(WinT + ((size_t)l * NPAD + r) * 1024 + k8 * 8) = o;
  }
  bf16_t* WoutT = (bf16_t*)(p.ws + OFF_WOUT);
  for (int idx = gtid; idx < 2 * 1024 * 128; idx += gsz) {
    const int l = idx / (1024 * 128); const int rem = idx - l * 1024 * 128; const int k8 = rem / 1024; const int r = rem - k8 * 1024;
    const float* w = p.w_out + ((size_t)l * 1024 + k8 * 8) * 1024 + r;
    float v[8];
#pragma unroll
    for (int j = 0; j < 8; ++j) v[j] = w[(size_t)j * 1024];
    uint4 o; o.x = pack2(v[0], v[1]); o.y = pack2(v[2], v[3]); o.z = pack2(v[4], v[5]); o.w = pack2(v[6], v[7]);
    *(uint4*)(WoutT + ((size_t)l * 1024 + r) * 1024 + k8 * 8) = o;
  }
  bf16_t* WmemT = (bf16_t*)(p.ws + OFF_WMEM);
  for (int idx = gtid; idx < 2 * 512 * 128; idx += gsz) {
    const int l = idx / (512 * 128); const int rem = idx - l * 512 * 128; const int k8 = rem / 512; const int r = rem - k8 * 512;
    const float* w = p.w_mem_kv + ((size_t)l * 1024 + k8 * 8) * 512 + r;
    const float* g = p.mem_g + l * 1024 + k8 * 8;
    float v[8];
#pragma unroll
    for (int j = 0; j < 8; ++j) v[j] = w[(size_t)j * 512] * g[j];
    uint4 o; o.x = pack2(v[0], v[1]); o.y = pack2(v[2], v[3]); o.z = pack2(v[4], v[5]); o.w = pack2(v[6], v[7]);
    *(uint4*)(WmemT + ((size_t)l * 512 + r) * 1024 + k8 * 8) = o;
  }
  bf16_t* WfT = (bf16_t*)(p.ws + OFF_WF);
  const float fscale = 0.00138106793f;
  for (int idx = gtid; idx < 2 * 256 * 512; idx += gsz) {
    const int l = idx >> 17; const int rem = idx & 131071; const int kk = rem >> 8; const int j = rem & 255;
    const int k2 = kk & 255, blk = k2 >> 6, cp = k2 & 63;
    const float* w = p.w_fnet + ((size_t)l * 256 + blk * 64) * 256 + j;
    float a = 0.f;
    for (int c = 0; c < 64; ++c) {
      const float turns = (float)((c * cp) & 63) * (1.f / 64.f);
      const float tr = kk < 256 ? __builtin_amdgcn_cosf(turns) : __builtin_amdgcn_sinf(turns);
      a += tr * w[(size_t)c * 256];
    }
    WfT[((size_t)l * 256 + j) * 512 + kk] = f2bf(a * fscale);
  }
  float2* tw = (float2*)(p.ws + OFF_TW);
  for (int t = gtid; t < 4096; t += gsz) { float s, c; sincospif((float)t * (1.f / 4096.f), &s, &c); tw[t] = make_float2(c, -s); }
  const int lane = tid & 63, gw = blockIdx.x * (NT / 64) + (tid >> 6), nw = gridDim.x * (NT / 64);
  bf16_t* memn = (bf16_t*)(p.ws + OFF_MEMN);
  for (int r = gw; r < 1536; r += nw) {
    const float* src = r < 1024 ? p.mem_prompt + (size_t)r * 1024 : p.mem_sample + (size_t)(r - 1024) * 1024;
    norm_row_bf16(src, memn + (size_t)r * 1024, lane);
  }
  bf16_t* xn = (bf16_t*)(p.ws + OFF_X);
  for (int t = gw; t < NTOK / 2; t += nw) {
    const float* s0 = xrow(p, 2 * t); const float* s1 = xrow(p, 2 * t + 1);
    float4 v0[4], v1[4]; float a0 = 0.f, a1 = 0.f;
#pragma unroll
    for (int i = 0; i < 4; ++i) { v0[i] = ldnt4(s0 + i * 256 + lane * 4); v1[i] = ldnt4(s1 + i * 256 + lane * 4); }
#pragma unroll
    for (int i = 0; i < 4; ++i) { a0 += v0[i].x * v0[i].x + v0[i].y * v0[i].y + v0[i].z * v0[i].z + v0[i].w * v0[i].w; a1 += v1[i].x * v1[i].x + v1[i].y * v1[i].y + v1[i].z * v1[i].z + v1[i].w * v1[i].w; }
    a0 = wave_sum(a0); a1 = wave_sum(a1);
    const float r0 = rsqrtf(a0 * (1.f / 1024.f) + 1e-6f), r1 = rsqrtf(a1 * (1.f / 1024.f) + 1e-6f);
    bf16_t* d0 = xn + (size_t)(2 * t) * 1024; bf16_t* d1 = d0 + 1024;
#pragma unroll
    for (int i = 0; i < 4; ++i) {
      uint2 o; o.x = pack2(v0[i].x * r0, v0[i].y * r0); o.y = pack2(v0[i].z * r0, v0[i].w * r0); *(uint2*)(d0 + i * 256 + lane * 4) = o;
      o.x = pack2(v1[i].x * r1, v1[i].y * r1); o.y = pack2(v1[i].z * r1, v1[i].w * r1); *(uint2*)(d1 + i * 256 + lane * 4) = o;
    }
  }
}

namespace pg8 {
#define PG8_LAS __attribute__((address_space(3)))
typedef unsigned short bf16_t;
typedef short bf16x8 __attribute__((ext_vector_type(8)));
typedef float f32x4 __attribute__((ext_vector_type(4)));
typedef unsigned u32x4 __attribute__((ext_vector_type(4)));
constexpr int BM = 256, BK = 64, HALF = 128, HTB = HALF * BK * 2  , STAGE_BYTES = 8 * HTB, NXCD = 8, WGM = 8;

__host__ __device__ __forceinline__ int lds_byte(int r, int c) { const int st = (r >> 4) * 2 + (c >> 5), rr = r & 15, cc = c & 31, ob = rr * 64 + cc * 2; return st * 1024 + (ob ^ (((ob >> 9) & 1) << 5)); }
__host__ __device__ __forceinline__ void stage_rc(int b, int& R, int& C) { const int st = b / 1024, sb = b % 1024, swz = sb ^ (((sb >> 9) & 1) << 5); R = (st >> 1) * 16 + swz / 64; C = (st & 1) * 32 + (swz % 64) / 2; }
__host__ __device__ __forceinline__ int perm32(int rho) { const int n = rho >> 4, i = rho & 15; return 8 * (i >> 2) + 4 * n + (i & 3); }

struct Unit { int pm, pn; };
struct Gemm { const bf16_t* A; const bf16_t* Bt; int M, N, K; };

struct StaticOrder {
    int nM, nN, nwg, G, c;
    __host__ __device__ void init(int M, int N, int G_, int c_) { nM = M / BM; nN = N / BM; nwg = nM * nN; G = G_; c = c_; }
    __host__ __device__ bool next(int i, Unit& u) const {
        const long L = (long)i * G + c; if (L >= nwg) return false;
        int wgid = (int)L; { const int q = nwg / NXCD, r = nwg % NXCD, xcd = wgid % NXCD, off = wgid / NXCD; wgid = (xcd < r ? xcd * (q + 1) : r * (q + 1) + (xcd - r) * q) + off; }
        const int nig = WGM * nN, gid = wgid / nig, fm = gid * WGM, gsz = (nM - fm) < WGM ? (nM - fm) : WGM;
        u.pm = fm + ((wgid % nig) % gsz); u.pn = (wgid % nig) / gsz; return true;
    }
    __device__ __forceinline__ void a_ready(const Unit&) const {}
    __device__ __forceinline__ void done(const Unit&) const {}
};
template <class Epi, class Sched, bool STAMP = false>
__device__ __forceinline__ void gemm_phase(PG8_LAS unsigned char* lds, const Gemm g, const Sched& S, const Epi& E, unsigned long long* stamps, const int tid_in) {
    const int tid = tid_in, wid = __builtin_amdgcn_readfirstlane(tid >> 6), lane = tid & 63, wr = wid >> 2, wc = wid & 3, fr = lane & 15, fq = lane >> 4;
    const int K = g.K, nt = K / BK;
    int ts_lo = 0, ts_hi = 0, nts = 0; const unsigned long long rt_entry = STAMP ? (unsigned long long)wall_clock64() : 0ull;
#define PG8_STAMP() do { if (STAMP && wid == 0 && nts < 64) { const unsigned long long _c = (unsigned long long)clock64(); \
        ts_lo = (lane == nts) ? (int)(unsigned)_c : ts_lo; ts_hi = (lane == nts) ? (int)(unsigned)(_c >> 32) : ts_hi; ++nts; } } while (0)
    PG8_STAMP();
    unsigned voffA[2], voffB[2];
#pragma unroll
    for (int i = 0; i < 2; ++i) { int R, C; stage_rc(tid * 16 + i * 8192, R, C); const int Rb = Epi::PERM ? ((R & ~31) + perm32(R & 31)) : R;
        voffA[i] = (unsigned)(R * K + C) * 2u; voffB[i] = (unsigned)(Rb * K + C) * 2u; }
    const size_t kstep = (size_t)(BK * 2);
    const size_t hstep = (size_t)HALF * K * 2;
    const size_t tstep = 2 * hstep;
    const unsigned ldsw = (unsigned)wid * 1024u;
    const int aoff = lds_byte(wr * 64 + fr, fq * 8), boff = lds_byte(wc * 32 + fr, fq * 8);
#define PG8_SA(b, h) (((b) * 2 + (h)) * HTB)
#define PG8_SB(b, h) ((4 + (b) * 2 + (h)) * HTB)
#define PG8_STAGE(bufoff, gbase, voff) do { _Pragma("unroll") for (int _i = 0; _i < 2; ++_i) \
        __builtin_amdgcn_global_load_lds((const unsigned*)((const char*)(gbase) + (voff)[_i]), (PG8_LAS unsigned*)(lds + (bufoff) + ldsw + _i * 8192), 16, 0, 0); } while (0)
#define PG8_LDA(dst, b, h) do { _Pragma("unroll") for (int m = 0; m < 4; ++m) _Pragma("unroll") for (int k = 0; k < 2; ++k) dst[m][k] = *(const PG8_LAS bf16x8*)(lds + PG8_SA(b, h) + aoff + m * 2048 + k * 1024); } while (0)
#define PG8_LDB(dst, b, h) do { _Pragma("unroll") for (int n = 0; n < 2; ++n) _Pragma("unroll") for (int k = 0; k < 2; ++k) dst[n][k] = *(const PG8_LAS bf16x8*)(lds + PG8_SB(b, h) + boff + n * 2048 + k * 1024); } while (0)
#define PG8_MMA(ai, bj, At, Bt) do { __builtin_amdgcn_s_setprio(1); _Pragma("unroll") for (int m = 0; m < 4; ++m) _Pragma("unroll") for (int n = 0; n < 2; ++n) _Pragma("unroll") for (int k = 0; k < 2; ++k) \
        acc[ai][bj][m][n] = __builtin_amdgcn_mfma_f32_16x16x32_bf16(Bt[n][k], At[m][k], acc[ai][bj][m][n], 0, 0, 0); __builtin_amdgcn_s_setprio(0); } while (0)
#define PG8_WAIT_V(n) asm volatile("s_waitcnt vmcnt(" #n ")" ::: "memory")
#define PG8_WAIT_L(n) asm volatile("s_waitcnt lgkmcnt(" #n ")" ::: "memory")
#define PG8_BAR __builtin_amdgcn_s_barrier()
#define PG8_SCHED __builtin_amdgcn_sched_barrier(0)
    Unit cur, nxt; int ui = 0;
    if (!S.next(0, cur)) return;
    f32x4 acc[2][2][4][2];
#pragma unroll
    for (int a = 0; a < 2; ++a)
#pragma unroll
        for (int b = 0; b < 2; ++b)
#pragma unroll
            for (int m = 0; m < 4; ++m)
#pragma unroll
                for (int n = 0; n < 2; ++n) acc[a][b][m][n] = (f32x4){0.f, 0.f, 0.f, 0.f};
    bf16x8 At[4][2], B0[2][2], B1[2][2];
    const char* cA = (const char*)g.A + (size_t)cur.pm * tstep; const char* cB = (const char*)g.Bt + (size_t)cur.pn * tstep;
    S.a_ready(cur);
    PG8_STAGE(PG8_SB(0, 0), cB, voffB); PG8_STAGE(PG8_SA(0, 0), cA, voffA); PG8_STAGE(PG8_SB(0, 1), cB + hstep, voffB); PG8_STAGE(PG8_SA(0, 1), cA + hstep, voffA);
    if (wr == 1) PG8_BAR;
    PG8_WAIT_V(4); PG8_BAR;
    PG8_STAGE(PG8_SB(1, 0), cB + kstep, voffB); PG8_STAGE(PG8_SA(1, 0), cA + kstep, voffA); PG8_STAGE(PG8_SB(1, 1), cB + hstep + kstep, voffB);
    PG8_WAIT_V(6); PG8_BAR;
    PG8_STAMP();
    for (;;) {
        const bool has_next = S.next(ui + 1, nxt);
        const char* nA = has_next ? (const char*)g.A + (size_t)nxt.pm * tstep : cA; const char* nB = has_next ? (const char*)g.Bt + (size_t)nxt.pn * tstep : cB;
        for (int t = 0; t < nt; t += 2) {
            const bool last = (t == nt - 2);
            const char* a1 = cA + (size_t)(t + 1) * kstep;
            const char* a2 = last ? nA : cA + (size_t)(t + 2) * kstep; const char* b2 = last ? nB : cB + (size_t)(t + 2) * kstep;
            const char* a3 = a2 + kstep; const char* b3 = b2 + kstep;
            if (last && has_next) S.a_ready(nxt);
            PG8_LDB(B0, 0, 0); PG8_SCHED; PG8_LDA(At, 0, 0); PG8_STAGE(PG8_SA(1, 1), a1 + hstep, voffA);
            PG8_WAIT_L(8); PG8_BAR; PG8_WAIT_L(0); PG8_MMA(0, 0, At, B0); PG8_BAR; PG8_SCHED;
            PG8_LDB(B1, 0, 1); PG8_STAGE(PG8_SB(0, 0), b2, voffB);
            PG8_BAR; PG8_WAIT_L(0); PG8_MMA(0, 1, At, B1); PG8_BAR;
            PG8_LDA(At, 0, 1); PG8_STAGE(PG8_SA(0, 0), a2, voffA);
            PG8_BAR; PG8_WAIT_L(0); PG8_MMA(1, 0, At, B0); PG8_BAR; PG8_SCHED;
            PG8_STAGE(PG8_SB(0, 1), b2 + hstep, voffB);
            PG8_WAIT_V(6); PG8_BAR; PG8_MMA(1, 1, At, B1); PG8_BAR;
            PG8_LDB(B0, 1, 0); PG8_SCHED; PG8_LDA(At, 1, 0); PG8_STAGE(PG8_SA(0, 1), a2 + hstep, voffA);
            PG8_WAIT_L(8); PG8_BAR; PG8_WAIT_L(0); PG8_MMA(0, 0, At, B0); PG8_BAR; PG8_SCHED;
            PG8_LDB(B1, 1, 1); PG8_STAGE(PG8_SB(1, 0), b3, voffB);
            PG8_BAR; PG8_WAIT_L(0); PG8_MMA(0, 1, At, B1); PG8_BAR;
            PG8_LDA(At, 1, 1); PG8_STAGE(PG8_SA(1, 0), a3, voffA);
            PG8_BAR; PG8_WAIT_L(0); PG8_MMA(1, 0, At, B0); PG8_BAR; PG8_SCHED;
            PG8_STAGE(PG8_SB(1, 1), b3 + hstep, voffB);
            PG8_WAIT_V(6); PG8_BAR; PG8_MMA(1, 1, At, B1); PG8_BAR;
        }
        PG8_STAMP();
        if constexpr (!Epi::AFTER_DRAIN) { E(acc, cur, wr, wc, fr, fq); S.done(cur); }
        PG8_STAMP();
        if (!has_next) break;
#pragma unroll
        for (int a = 0; a < 2; ++a)
#pragma unroll
            for (int b = 0; b < 2; ++b)
#pragma unroll
                for (int m = 0; m < 4; ++m)
#pragma unroll
                    for (int n = 0; n < 2; ++n) acc[a][b][m][n] = (f32x4){0.f, 0.f, 0.f, 0.f};
        cur = nxt; cA = nA; cB = nB; ++ui;
    }
    PG8_WAIT_V(0);
    if (wr == 0) PG8_BAR;
    PG8_BAR;
    if constexpr (Epi::AFTER_DRAIN) { E.fused(acc, cur, wr, wc, fr, fq, lds, wid, lane); S.done(cur); }
    PG8_STAMP();
    if (STAMP && wid == 0) { stamps[lane] = lane < nts ? (((unsigned long long)(unsigned)ts_hi << 32) | (unsigned)ts_lo) : 0ull;
        if (lane == 62) stamps[62] = rt_entry; if (lane == 63) stamps[63] = (unsigned long long)wall_clock64(); }
#undef PG8_STAMP
#undef PG8_SA
#undef PG8_SB
#undef PG8_STAGE
#undef PG8_LDA
#undef PG8_LDB
#undef PG8_MMA
#undef PG8_WAIT_V
#undef PG8_WAIT_L
#undef PG8_BAR
#undef PG8_SCHED
}
}

template <class F> struct EpiWrap {
  static constexpr bool PERM = false, AFTER_DRAIN = false;
  F f;
  DI void operator()(const f32x4 (&acc)[2][2][4][2], const pg8::Unit& u, int wr, int wc, int fr, int fq) const {
#pragma unroll
    for (int ai = 0; ai < 2; ++ai)
#pragma unroll
      for (int m = 0; m < 4; ++m) {
        const int row = u.pm * 256 + ai * 128 + wr * 64 + m * 16 + fr;
#pragma unroll
        for (int bj = 0; bj < 2; ++bj)
#pragma unroll
          for (int n = 0; n < 2; ++n) f(u.pn * 256 + bj * 128 + wc * 32 + n * 16 + 4 * fq, row, acc[ai][bj][m][n]);
      }
  }
};
template <class F>
DI void run_gemm_on(PG8_LAS unsigned char* lds, const bf16_t* A, const bf16_t* Bt, int M, int N, int K, const F& f, const int tid, int G, int c) {
  pg8::Gemm g; g.A = A; g.Bt = Bt; g.M = M; g.N = N; g.K = K;
  pg8::StaticOrder S; S.init(M, N, G, c);
  EpiWrap<F> E{f};
  pg8::gemm_phase<EpiWrap<F>, pg8::StaticOrder, false>(lds, g, S, E, nullptr, tid);
  __syncthreads();
}
template <class F>
DI void run_gemm(PG8_LAS unsigned char* lds, const bf16_t* A, const bf16_t* Bt, int M, int N, int K, const F& f, const int tid) {
  pg8::Gemm g; g.A = A; g.Bt = Bt; g.M = M; g.N = N; g.K = K;
  pg8::StaticOrder S; S.init(M, N, (int)gridDim.x, (int)blockIdx.x);
  EpiWrap<F> E{f};
  pg8::gemm_phase<EpiWrap<F>, pg8::StaticOrder, false>(lds, g, S, E, nullptr, tid);
  __syncthreads();
}

struct InProjEpi {
  unsigned char* ws;
  DI void operator()(int m, int n, const f32x4& v) const {
    if (m < 3072) {
      const int blk = m >> 8, c = m & 255;
      if (blk == 8) {
        bf16_t* cvt = (bf16_t*)(ws + OFF_CVT);
        const int seq = n >> 13, l = n & 8191;
        bf16_t* d = cvt + ((size_t)(seq * 256 + c)) * 8192 + l;
#pragma unroll
        for (int e = 0; e < 4; ++e) d[(size_t)e * 8192] = f2bf(v[e]);
      } else {
        bf16_t* d;
        if (blk >= 2 && blk <= 4) d = (bf16_t*)(ws + OFF_BQKV) + (size_t)n * 768 + (blk - 2) * 256 + c;
        else if (blk == 0 || blk == 5 || blk == 6 || blk == 10) d = (bf16_t*)(ws + OFF_MIX) + (size_t)n * 1024 + (blk == 0 ? 0 : blk == 5 ? 256 : blk == 6 ? 512 : 768) + c;
        else {
          size_t off = blk == 1 ? OFF_AZ : blk == 7 ? OFF_CK : blk == 9 ? OFF_CZ : OFF_DZ;
          d = (bf16_t*)(ws + off) + (size_t)n * 256 + c;
        }
        uint2 o; o.x = pack2(v[0], v[1]); o.y = pack2(v[2], v[3]); *(uint2*)d = o;
      }
    } else if (m < 3088) {
      float* g = (float*)(ws + OFF_GATES) + (size_t)n * 16 + (m - 3072);
      *(float4*)g = make_float4(v[0], v[1], v[2], v[3]);
    }
  }
};
struct MemKvEpi {
  unsigned char* ws; int l;
  DI void operator()(int m, int n, const f32x4& v) const {
    const int seq = n >> 8, key = n & 255;
    if (m < 256) {
      const int head = m >> 6, dim = m & 63;
      bf16_t* d = (bf16_t*)(ws + OFF_KMEM) + ((size_t)((l * 6 + seq) * 4 + head) * 256 + key) * 64 + dim;
      uint2 o; o.x = pack2(v[0], v[1]); o.y = pack2(v[2], v[3]); *(uint2*)d = o;
    } else {
      const int c = m - 256, head = c >> 6, dim = c & 63;
      bf16_t* d = (bf16_t*)(ws + OFF_VMEMT) + ((size_t)((l * 6 + seq) * 4 + head) * 64 + dim) * 256 + key;
#pragma unroll
      for (int e = 0; e < 4; ++e) d[e * 256] = f2bf(v[e]);
    }
  }
};
struct FnetEpi {
  unsigned char* ws;
  DI void operator()(int m, int n, const f32x4& v) const {
    const uint2 z = *(const uint2*)((const bf16_t*)(ws + OFF_AZ) + (size_t)n * 256 + m);
    uint2 o; o.x = pack2(v[0] * silu(bflo(z.x)), v[1] * silu(bfhi(z.x))); o.y = pack2(v[2] * silu(bflo(z.y)), v[3] * silu(bfhi(z.y)));
    *(uint2*)((bf16_t*)(ws + OFF_MIX) + (size_t)n * 1024 + m) = o;
  }
};
struct FnetEpiDirect {
  static constexpr bool PERM = false, AFTER_DRAIN = false;
  unsigned char* ws;
  DI void operator()(const f32x4 (&acc)[2][2][4][2], const pg8::Unit& u, int wr, int wc, int fr, int fq) const {
    const bf16_t* AZ = (const bf16_t*)(ws + OFF_AZ); bf16_t* MX = (bf16_t*)(ws + OFF_MIX);
    const int col0 = u.pn * 256 + wc * 32 + 4 * fq;
#pragma unroll
    for (int ai = 0; ai < 2; ++ai)
#pragma unroll
      for (int m2 = 0; m2 < 2; ++m2) {
        uint2 z[2][2][2];
#pragma unroll
        for (int mm = 0; mm < 2; ++mm) {
          const size_t row = (size_t)(u.pm * 256 + ai * 128 + wr * 64 + (2 * m2 + mm) * 16 + fr);
#pragma unroll
          for (int bj = 0; bj < 2; ++bj)
#pragma unroll
            for (int n = 0; n < 2; ++n) z[mm][bj][n] = *(const uint2*)(AZ + row * 256 + col0 + bj * 128 + n * 16);
        }
#pragma unroll
        for (int mm = 0; mm < 2; ++mm) {
          const size_t row = (size_t)(u.pm * 256 + ai * 128 + wr * 64 + (2 * m2 + mm) * 16 + fr);
#pragma unroll
          for (int bj = 0; bj < 2; ++bj)
#pragma unroll
            for (int n = 0; n < 2; ++n) {
              const f32x4 v = acc[ai][bj][2 * m2 + mm][n]; const uint2 zz = z[mm][bj][n];
              uint2 o; o.x = pack2(v[0] * silu(bflo(zz.x)), v[1] * silu(bfhi(zz.x))); o.y = pack2(v[2] * silu(bflo(zz.y)), v[3] * silu(bfhi(zz.y)));
              *(uint2*)(MX + row * 1024 + col0 + bj * 128 + n * 16) = o;
            }
        }
      }
  }
};
struct OutEpi {
  bf16_t* dst;
  DI void operator()(int m, int n, const f32x4& v) const { uint2 o; o.x = pack2(v[0], v[1]); o.y = pack2(v[2], v[3]); *(uint2*)(dst + (size_t)n * 1024 + m) = o; }
};

DI int fft_pos(int k) {
  return ((k & 1) << 12) | (((k >> 1) & 3) << 10) | (((k >> 3) & 3) << 8) | (((k >> 5) & 3) << 6) | (((k >> 7) & 3) << 4) | (((k >> 9) & 3) << 2) | ((k >> 11) & 3);
}
DI void fft_task(const Params& p, int task, float2* z, const int tid) {
  const int seq = task >> 7, cp = task & 127;
  const unsigned* au = (const unsigned*)(p.ws + OFF_MIX) + (size_t)seq * 8192 * 512 + cp;
  const float2* tw = (const float2*)(p.ws + OFF_TW);
  for (int i = tid; i < 8192; i += NT) { const unsigned u = au[(size_t)i * 512]; z[i] = make_float2(bflo(u), bfhi(u)); }
  __syncthreads();
  for (int b = tid; b < 4096; b += NT) {
    const float2 a = z[b], c = z[b + 4096], w = tw[b];
    z[b] = make_float2(a.x + c.x, a.y + c.y);
    const float dx = a.x - c.x, dy = a.y - c.y;
    z[b + 4096] = make_float2(dx * w.x - dy * w.y, dx * w.y + dy * w.x);
  }
  __syncthreads();
#pragma unroll 1
  for (int s4 = 0; s4 < 6; ++s4) {
    const int lq = 10 - 2 * s4, q = 1 << lq;
    for (int b = tid; b < 2048; b += NT) {
      const int j = b & (q - 1), i0 = ((b >> lq) << (lq + 2)) + j;
      const float2 a0 = z[i0], a1 = z[i0 + q], a2 = z[i0 + 2 * q], a3 = z[i0 + 3 * q];
      const float2 w1 = tw[j << (1 + 2 * s4)];
      const float2 w2 = make_float2(w1.x * w1.x - w1.y * w1.y, 2.f * w1.x * w1.y);
      const float2 w3 = make_float2(w2.x * w1.x - w2.y * w1.y, w2.x * w1.y + w2.y * w1.x);
      const float t0x = a0.x + a2.x, t0y = a0.y + a2.y, t1x = a0.x - a2.x, t1y = a0.y - a2.y;
      const float t2x = a1.x + a3.x, t2y = a1.y + a3.y, t3x = a1.y - a3.y, t3y = -(a1.x - a3.x);
      z[i0] = make_float2(t0x + t2x, t0y + t2y);
      const float y1x = t1x + t3x, y1y = t1y + t3y, y2x = t0x - t2x, y2y = t0y - t2y, y3x = t1x - t3x, y3y = t1y - t3y;
      z[i0 + q] = make_float2(y1x * w1.x - y1y * w1.y, y1x * w1.y + y1y * w1.x);
      z[i0 + 2 * q] = make_float2(y2x * w2.x - y2y * w2.y, y2x * w2.y + y2y * w2.x);
      z[i0 + 3 * q] = make_float2(y3x * w3.x - y3y * w3.y, y3x * w3.y + y3y * w3.x);
    }
    __syncthreads();
  }
  unsigned* H = (unsigned*)(p.ws + OFF_H) + (size_t)seq * 8192 * 256;
  for (int k = tid; k < 8192; k += NT) {
    const float2 zk = z[fft_pos(k)], zn = z[fft_pos((8192 - k) & 8191)];
    H[(size_t)k * 256 + cp] = pack2(0.5f * (zk.x + zn.x), 0.5f * (zk.y + zn.y));
    H[(size_t)k * 256 + 128 + cp] = pack2(0.5f * (zk.y - zn.y), -0.5f * (zk.x - zn.x));
  }
  __syncthreads();
}

template <bool NA>
DI void attn_core(const Params& p, int layer, int h, int tok0, int r, int c0, int rs, int wsx, const bf16_t* sK, const bf16_t* sVT, const float* sBias, int kb, int pitch, int vstride, int lane) {
  const int fr = lane & 15, fq = lane >> 4;
  bf16_t* Q = (bf16_t*)(p.ws + OFF_MIX) + (NA ? 512 : 768);
  const bf16_t* Z = (const bf16_t*)(p.ws + (NA ? OFF_CZ : OFF_DZ));
  const bf16_t* qp = Q + (size_t)(tok0 + fr) * 1024 + h * 64 + fq * 8;
  bf16x8 qf[2]; qf[0] = ld8(qp); qf[1] = ld8(qp + 32);
  f32x4 s[16];
#pragma unroll
  for (int kt = 0; kt < 16; ++kt) {
    const bf16_t* kp = sK + (kb + (kt >> 1) * pitch + (kt & 1) * 16 + fr) * 72 + fq * 8;
    f32x4 a = (f32x4){0.f, 0.f, 0.f, 0.f};
    a = MFMA16(ld8(kp), qf[0], a);
    a = MFMA16(ld8(kp + 32), qf[1], a);
    s[kt] = a;
  }
  float mx = -1e30f;
  if (NA) {
    const int c = c0 + fr, cs = min(max(c - 8, 0), 48);
#pragma unroll
    for (int kt = 0; kt < 16; ++kt) {
      const int kr = rs + (kt >> 1);
      const float* rb = sBias + (kr - r + 7) * 31;
#pragma unroll
      for (int e = 0; e < 4; ++e) {
        const int kc = wsx + (kt & 1) * 16 + 4 * fq + e;
        const bool valid = kc >= cs && kc < cs + 16;
        const float bias = rb[min(max(kc - c + 15, 0), 30)];
        const float v = valid ? s[kt][e] * 0.125f + bias : -1e30f;
        s[kt][e] = v; mx = fmaxf(mx, v);
      }
    }
  } else {
#pragma unroll
    for (int kt = 0; kt < 16; ++kt)
#pragma unroll
      for (int e = 0; e < 4; ++e) { const float v = s[kt][e] * 0.125f; s[kt][e] = v; mx = fmaxf(mx, v); }
  }
  mx = fmaxf(mx, __shfl_xor(mx, 16, 64)); mx = fmaxf(mx, __shfl_xor(mx, 32, 64));
  float sum = 0.f;
#pragma unroll
  for (int kt = 0; kt < 16; ++kt)
#pragma unroll
    for (int e = 0; e < 4; ++e) { const float pv = __expf(s[kt][e] - mx); s[kt][e] = pv; sum += pv; }
  sum += __shfl_xor(sum, 16, 64); sum += __shfl_xor(sum, 32, 64);
  const float inv = 1.f / sum;
  f32x4 o[4];
#pragma unroll
  for (int mt = 0; mt < 4; ++mt) o[mt] = (f32x4){0.f, 0.f, 0.f, 0.f};
#pragma unroll
  for (int u = 0; u < 8; ++u) {
    const bf16x8 pb = pack8(s[2 * u], s[2 * u + 1]);
#pragma unroll
    for (int mt = 0; mt < 4; ++mt) {
      const bf16_t* vp = sVT + (16 * mt + fr) * vstride + kb + u * pitch + 4 * fq;
      o[mt] = MFMA16(ld4x2(vp, vp + 16), pb, o[mt]);
    }
  }
  const size_t orow = (size_t)(tok0 + fr) * 256 + h * 64 + 4 * fq, qrow = (size_t)(tok0 + fr) * 1024 + h * 64 + 4 * fq;
  uint2 zg[4];
#pragma unroll
  for (int mt = 0; mt < 4; ++mt) zg[mt] = *(const uint2*)(Z + orow + 16 * mt);
#pragma unroll
  for (int mt = 0; mt < 4; ++mt) {
    const uint2 z = zg[mt];
    uint2 w; w.x = pack2(o[mt][0] * inv * silu(bflo(z.x)), o[mt][1] * inv * silu(bfhi(z.x)));
    w.y = pack2(o[mt][2] * inv * silu(bflo(z.y)), o[mt][3] * inv * silu(bfhi(z.y)));
    *(uint2*)(Q + qrow + 16 * mt) = w;
  }
}
DI void na_block(const Params& p, int layer, int bt, char* smem, const int tid) {
  const int half = bt & 1, rg = (bt >> 1) & 31, h = (bt >> 6) & 3, seq = bt >> 8;
  const int r0 = rg * 4, rsmin = min(max(r0 - 4, 0), 120), nrows = min(11, 128 - rsmin), colbase = half ? 24 : 0;
  bf16_t* sK = (bf16_t*)smem; bf16_t* sVT = sK + 440 * 72; float* sBias = (float*)(sVT + 64 * 456);
  if (tid < 465) sBias[tid] = p.rpb[(size_t)(layer * 4 + h) * 465 + tid];
  const bf16_t* CK = (const bf16_t*)(p.ws + OFF_CK) + (size_t)(seq * 8192 + rsmin * 64 + colbase) * 256 + h * 64;
  const bf16_t* CVT = (const bf16_t*)(p.ws + OFF_CVT) + (size_t)(seq * 4 + h) * 64 * 8192 + rsmin * 64 + colbase;
  {
    const int nk = nrows * 40 * 8, per_dim = nrows * 5, nv = 64 * per_dim;
    uint4 rk[7], rv[7]; int dk[7], dv[7];
#pragma unroll
    for (int i = 0; i < 7; ++i) {
      const int idx = tid + NT * i;
      const int key = idx >> 3, ch = idx & 7, ri = key / 40, cj = key - ri * 40;
      dk[i] = idx < nk ? key * 72 + ch * 8 : -1;
      rk[i] = idx < nk ? *(const uint4*)(CK + (size_t)(ri * 64 + cj) * 256 + ch * 8) : make_uint4(0, 0, 0, 0);
      const int dim = idx / per_dim, rem = idx - dim * per_dim, r2 = rem / 5, c5 = rem - r2 * 5;
      dv[i] = idx < nv ? dim * 456 + r2 * 40 + c5 * 8 : -1;
      rv[i] = idx < nv ? *(const uint4*)(CVT + (size_t)dim * 8192 + r2 * 64 + c5 * 8) : make_uint4(0, 0, 0, 0);
    }
#pragma unroll
    for (int i = 0; i < 7; ++i) { if (dk[i] >= 0) *(uint4*)(sK + dk[i]) = rk[i]; if (dv[i] >= 0) *(uint4*)(sVT + dv[i]) = rv[i]; }
  }
  __syncthreads();
  {
    const int wave = tid >> 6, lane = tid & 63;
    const int r = r0 + (wave >> 1), c0 = 32 * half + 16 * (wave & 1);
    const int rs = min(max(r - 4, 0), 120), wsx = min(max(c0 - 8, 0), 32);
    attn_core<true>(p, layer, h, seq * 8192 + r * 64 + c0, r, c0, rs, wsx, sK, sVT, sBias, (rs - rsmin) * 40 + (wsx - colbase), 40, 456, lane);
  }
  __syncthreads();
}
DI void mem_block(const Params& p, int layer, int bt, char* smem, const int tid) {
  const int g = bt & 31, h = (bt >> 5) & 3, seq = bt >> 7;
  bf16_t* sK = (bf16_t*)smem; bf16_t* sVT = sK + 256 * 72;
  const bf16_t* Kg = (const bf16_t*)(p.ws + OFF_KMEM) + (size_t)((layer * 6 + seq) * 4 + h) * 256 * 64;
  const bf16_t* Vg = (const bf16_t*)(p.ws + OFF_VMEMT) + (size_t)((layer * 6 + seq) * 4 + h) * 64 * 256;
  {
    uint4 rk[4], rv[4];
#pragma unroll
    for (int i = 0; i < 4; ++i) { const int idx = tid + NT * i; rk[i] = *(const uint4*)(Kg + (size_t)idx * 8); rv[i] = *(const uint4*)(Vg + (size_t)idx * 8); }
#pragma unroll
    for (int i = 0; i < 4; ++i) { const int idx = tid + NT * i; *(uint4*)(sK + (idx >> 3) * 72 + (idx & 7) * 8) = rk[i]; *(uint4*)(sVT + (idx >> 5) * 264 + (idx & 31) * 8) = rv[i]; }
  }
  __syncthreads();
  {
    const int wave = tid >> 6, lane = tid & 63;
#pragma unroll 1
    for (int i = 0; i < 2; ++i) { int kb0 = 0; asm volatile("" : "+v"(kb0));
      attn_core<false>(p, layer, h, seq * 8192 + (g * 16 + wave * 2 + i) * 16, 0, 0, 0, 0, sK, sVT, nullptr, kb0, 32, 264, lane); }
  }
  __syncthreads();
}

DI void gdn_prep_tok8(const Params& p, int layer, int task, int lane) {
  const int tok0 = task * 8, seq = tok0 >> 13, l0 = tok0 & 8191;
  const bf16_t* X = (const bf16_t*)(p.ws + OFF_BQKV);
  const float* cw = p.conv_w + (size_t)layer * 5 * 768;
  unsigned kp[4][4];
#pragma unroll
  for (int i = 0; i < 3; ++i) {
    const int c = i * 256 + lane * 4;
    uint2 x[12];
#pragma unroll
    for (int jj = 0; jj < 12; ++jj) {
      const int ll = l0 + jj - 2;
      x[jj] = (ll >= 0 && ll < 8192) ? *(const uint2*)(X + (size_t)(tok0 + jj - 2) * 768 + c) : make_uint2(0u, 0u);
    }
    float4 w[5];
#pragma unroll
    for (int j = 0; j < 5; ++j) w[j] = *(const float4*)(cw + j * 768 + c);
    bf16_t* dst = (bf16_t*)(p.ws + (i == 0 ? OFF_QN : i == 1 ? OFF_KN : OFF_VN)) + (size_t)tok0 * 256 + lane * 4;
#pragma unroll
    for (int t = 0; t < 8; ++t) {
      float a0 = 0.f, a1 = 0.f, a2 = 0.f, a3 = 0.f;
#pragma unroll
      for (int j = 0; j < 5; ++j) { const uint2 xv = x[t + j]; a0 += w[j].x * bflo(xv.x); a1 += w[j].y * bfhi(xv.x); a2 += w[j].z * bflo(xv.y); a3 += w[j].w * bfhi(xv.y); }
      a0 = silu(a0); a1 = silu(a1); a2 = silu(a2); a3 = silu(a3);
      if (i < 2) {
        float ss = a0 * a0 + a1 * a1 + a2 * a2 + a3 * a3;
        ss += __shfl_xor(ss, 1, 64); ss += __shfl_xor(ss, 2, 64); ss += __shfl_xor(ss, 4, 64); ss += __shfl_xor(ss, 8, 64);
        const float rs = rsqrtf(ss + 1e-6f) * (i == 0 ? 0.125f : 1.f);
        a0 *= rs; a1 *= rs; a2 *= rs; a3 *= rs;
      }
      uint2 o; o.x = pack2(a0, a1); o.y = pack2(a2, a3);
      *(uint2*)(dst + (size_t)t * 256) = o;
      if (i == 1) {
        if (t & 1) { kp[0][t >> 1] |= (unsigned)f2bf(a0) << 16; kp[1][t >> 1] |= (unsigned)f2bf(a1) << 16; kp[2][t >> 1] |= (unsigned)f2bf(a2) << 16; kp[3][t >> 1] |= (unsigned)f2bf(a3) << 16; }
        else { kp[0][t >> 1] = f2bf(a0); kp[1][t >> 1] = f2bf(a1); kp[2][t >> 1] = f2bf(a2); kp[3][t >> 1] = f2bf(a3); }
      }
    }
  }
  bf16_t* kT = (bf16_t*)(p.ws + OFF_KT) + ((size_t)seq * 256 + lane * 4) * 8192 + l0;
#pragma unroll
  for (int e = 0; e < 4; ++e) *(uint4*)(kT + (size_t)e * 8192) = make_uint4(kp[e][0], kp[e][1], kp[e][2], kp[e][3]);
#pragma unroll
  for (int i2 = 0; i2 < 2; ++i2) {
    const int idx = lane + 64 * i2, gi = idx & 15;
    float* g = (float*)(p.ws + OFF_GATES) + (size_t)tok0 * 16 + idx;
    const float x = *g;
    float r;
    if (gi < 8) {
      const float y = x + p.dt_bias[layer * 8 + gi];
      const float sp = fmaxf(y, 0.f) + __logf(1.f + __expf(-fabsf(y)));
      r = -__expf(p.a_log[layer * 8 + gi]) * sp;
    } else r = __builtin_amdgcn_rcpf(1.f + __expf(-x));
    *g = r;
  }
}

DI void chunk_task(const Params& p, int bt, char* smem, const int tid) {
  const int n = bt & 127, head = (bt >> 7) & 3, seq = bt >> 9;
  const int lane = tid & 63, wave = tid >> 6, fr = lane & 15, fq = lane >> 4;
  float* sL = (float*)smem;
  float* sg = (float*)(smem + 32768);
  float* sbeta = sg + 128; float* sG = sbeta + 128;
  const float* gb = (const float*)(p.ws + OFF_GATES);
  const bf16_t* qn = (const bf16_t*)(p.ws + OFF_QN); const bf16_t* kn = (const bf16_t*)(p.ws + OFF_KN); const bf16_t* vn = (const bf16_t*)(p.ws + OFF_VN);
  const int tokbase = seq * 8192;
  if (tid < 128) {
    const int d = tid >> 6, r = tid & 63; const int pos = d ? 8191 - 64 * n - r : 64 * n + r;
    sg[tid] = gb[(size_t)(tokbase + pos) * 16 + d * 4 + head]; sbeta[tid] = gb[(size_t)(tokbase + pos) * 16 + 8 + d * 4 + head];
  }
  __syncthreads();
  if (tid < 128) {
    float a = sg[tid];
#pragma unroll
    for (int off = 1; off < 64; off <<= 1) { const float t = __shfl_up(a, off, 64); if (lane >= off) a += t; }
    sG[tid] = a;
  }
  __syncthreads();
  {
    const int d = wave >> 1;
    const int ct = ((seq * 4 + head) * 2 + d) * 128 + n;
    if ((wave & 1) == 0) {
      float* cv = (float*)(p.ws + OFF_CVEC) + (size_t)ct * 256;
      const float G = sG[d * 64 + lane], Gl = sG[d * 64 + 63];
      cv[lane] = __expf(G); cv[64 + lane] = __expf(Gl - G); if (lane == 0) cv[128] = __expf(Gl);
    }
    bf16_t* chqk = (bf16_t*)(p.ws + OFF_CHQK) + (size_t)ct * 4096;
    const int hoff = head * 64 + fq * 8;
    bf16x8 kB[4][2];
#pragma unroll
    for (int nt = 0; nt < 4; ++nt) {
      const int rB = 16 * nt + fr; const int posB = d ? 8191 - 64 * n - rB : 64 * n + rB;
      const size_t ob = (size_t)(tokbase + posB) * 256 + hoff;
      kB[nt][0] = ld8(kn + ob); kB[nt][1] = ld8(kn + ob + 32);
    }
    bf16x8 kA[2][2], qA[2][2];
#pragma unroll
    for (int si = 0; si < 2; ++si) {
      const int rA = 16 * (2 * (wave & 1) + si) + fr; const int posA = d ? 8191 - 64 * n - rA : 64 * n + rA;
      const size_t oa = (size_t)(tokbase + posA) * 256 + hoff;
      kA[si][0] = ld8(kn + oa); kA[si][1] = ld8(kn + oa + 32); qA[si][0] = ld8(qn + oa); qA[si][1] = ld8(qn + oa + 32);
    }
#pragma unroll
    for (int si = 0; si < 2; ++si) {
      const int strip = 2 * (wave & 1) + si;
#pragma unroll
      for (int nt = 0; nt < 4; ++nt) {
        f32x4 kk = (f32x4){0.f, 0.f, 0.f, 0.f}, qk = (f32x4){0.f, 0.f, 0.f, 0.f};
        kk = MFMA16(kA[si][0], kB[nt][0], kk); kk = MFMA16(kA[si][1], kB[nt][1], kk);
        qk = MFMA16(qA[si][0], kB[nt][0], qk); qk = MFMA16(qA[si][1], kB[nt][1], qk);
        const int sc = 16 * nt + fr;
#pragma unroll
        for (int e = 0; e < 4; ++e) {
          const int r = 16 * strip + 4 * fq + e;
          const float dec = sc <= r ? __expf(sG[d * 64 + r] - sG[d * 64 + sc]) : 0.f;
          sL[d * 4096 + r * 64 + sc] = sc < r ? sbeta[d * 64 + r] * kk[e] * dec : 0.f;
          chqk[r * 64 + sc] = f2bf(qk[e] * dec);
        }
      }
    }
  }
  __syncthreads();
  {
    const int wvu = __builtin_amdgcn_readfirstlane(wave);
    const int d = wvu >> 1, half = wvu & 1;
    const int ct = ((seq * 4 + head) * 2 + d) * 128 + n;
    const bf16_t* src = (half ? kn : vn) + (size_t)(tokbase + (d ? 8191 - 64 * n : 64 * n)) * 256 + head * 64 + lane;
    const int rstep = d ? -256 : 256;
    float sol[64];
#pragma unroll
    for (int r = 0; r < 64; ++r) sol[r] = bf2f(src[r * rstep]);
#pragma unroll
    for (int r4 = 0; r4 < 16; ++r4) {
      const float4 b4 = *(const float4*)(sbeta + d * 64 + 4 * r4); const float4 g4 = *(const float4*)(sG + d * 64 + 4 * r4);
      sol[4 * r4 + 0] *= half ? b4.x * __expf(g4.x) : b4.x; sol[4 * r4 + 1] *= half ? b4.y * __expf(g4.y) : b4.y;
      sol[4 * r4 + 2] *= half ? b4.z * __expf(g4.z) : b4.z; sol[4 * r4 + 3] *= half ? b4.w * __expf(g4.w) : b4.w;
    }
    const float* Ld = sL + d * 4096;
#pragma unroll
    for (int b = 0; b < 4; ++b) {
#pragma unroll
      for (int j4 = 0; j4 < 4 * b; ++j4) {
        float4 lv[16];
#pragma unroll
        for (int q = 0; q < 16; ++q) lv[q] = *(const float4*)(Ld + (16 * b + q) * 64 + 4 * j4);
#pragma unroll
        for (int q = 0; q < 16; ++q) {
          float a = sol[16 * b + q];
          a -= lv[q].x * sol[4 * j4 + 0]; a -= lv[q].y * sol[4 * j4 + 1]; a -= lv[q].z * sol[4 * j4 + 2]; a -= lv[q].w * sol[4 * j4 + 3];
          sol[16 * b + q] = a;
        }
      }
#pragma unroll
      for (int g4 = 0; g4 < 4; ++g4) {
        float4 lv[16];
#pragma unroll
        for (int q = 4 * g4 + 1; q < 16; ++q) lv[q] = *(const float4*)(Ld + (16 * b + q) * 64 + 16 * b + 4 * g4);
        sol[16 * b + 4 * g4 + 1] -= lv[4 * g4 + 1].x * sol[16 * b + 4 * g4];
        sol[16 * b + 4 * g4 + 2] -= lv[4 * g4 + 2].x * sol[16 * b + 4 * g4] + lv[4 * g4 + 2].y * sol[16 * b + 4 * g4 + 1];
        sol[16 * b + 4 * g4 + 3] -= lv[4 * g4 + 3].x * sol[16 * b + 4 * g4] + lv[4 * g4 + 3].y * sol[16 * b + 4 * g4 + 1] + lv[4 * g4 + 3].z * sol[16 * b + 4 * g4 + 2];
#pragma unroll
        for (int q = 4 * g4 + 4; q < 16; ++q) {
          float a = sol[16 * b + q];
          a -= lv[q].x * sol[16 * b + 4 * g4 + 0]; a -= lv[q].y * sol[16 * b + 4 * g4 + 1]; a -= lv[q].z * sol[16 * b + 4 * g4 + 2]; a -= lv[q].w * sol[16 * b + 4 * g4 + 3];
          sol[16 * b + q] = a;
        }
      }
    }
    if (!half) {
      bf16_t* chu = (bf16_t*)(p.ws + OFF_CHU) + (size_t)ct * 4096 + lane * 64;
#pragma unroll
      for (int r8 = 0; r8 < 8; ++r8) {
        uint4 o; o.x = pack2(sol[r8 * 8 + 0], sol[r8 * 8 + 1]); o.y = pack2(sol[r8 * 8 + 2], sol[r8 * 8 + 3]);
        o.z = pack2(sol[r8 * 8 + 4], sol[r8 * 8 + 5]); o.w = pack2(sol[r8 * 8 + 6], sol[r8 * 8 + 7]);
        *(uint4*)(chu + r8 * 8) = o;
      }
    } else {
      bf16_t* chw = (bf16_t*)(p.ws + OFF_CHW) + (size_t)ct * 4096 + lane;
#pragma unroll
      for (int r = 0; r < 64; ++r) chw[r * 64] = f2bf(sol[r]);
    }
  }
  __syncthreads();
}

DI uint4 rev8(uint4 v) {
  uint4 r;
  r.x = (v.w >> 16) | (v.w << 16); r.y = (v.z >> 16) | (v.z << 16); r.z = (v.y >> 16) | (v.y << 16); r.w = (v.x >> 16) | (v.x << 16);
  return r;
}
DI void scan_task(const Params& p, int task, char* smem, const int tid) {
  const int d = task & 1, head = (task >> 1) & 3, seq = task >> 3;
  const bool loader = tid >= 256;
  const int lt = tid & 255, lane = tid & 63, wave = lt >> 6, fr = lane & 15, fq = lane >> 4;
  const int row0 = lt >> 3, c8 = (lt & 7) * 8, rc8 = (7 - (lt & 7)) * 8;
  constexpr int BUFB = 49152;
  const int ctb = ((seq * 4 + head) * 2 + d) * 128;
  const bf16_t* chw = (const bf16_t*)(p.ws + OFF_CHW); const bf16_t* chu = (const bf16_t*)(p.ws + OFF_CHU); const bf16_t* chqk = (const bf16_t*)(p.ws + OFF_CHQK);
  const float* cvec = (const float*)(p.ws + OFF_CVEC);
  const bf16_t* qn = (const bf16_t*)(p.ws + OFF_QN) + (size_t)seq * 8192 * 256 + head * 64;
  const bf16_t* kT = (const bf16_t*)(p.ws + OFF_KT) + (size_t)(seq * 256 + head * 64) * 8192;
  bf16_t* O = (bf16_t*)(p.ws + (d ? OFF_OB : OFF_OF)) + (size_t)seq * 8192 * 256 + head * 64 + 32 * (wave & 1) + fr;
#define SCAN_STAGE(n_, buf_) do { \
    const size_t cb = (size_t)(ctb + (n_)) * 4096 + row0 * 64 + c8; \
    const uint4 rw0 = *(const uint4*)(chw + cb), rw1 = *(const uint4*)(chw + cb + 2048); \
    const uint4 rqk0 = *(const uint4*)(chqk + cb), rqk1 = *(const uint4*)(chqk + cb + 2048); \
    const uint4 ru0 = *(const uint4*)(chu + cb), ru1 = *(const uint4*)(chu + cb + 2048); \
    const int pos0 = d ? 8191 - 64 * (n_) - row0 : 64 * (n_) + row0, pos1 = d ? pos0 - 32 : pos0 + 32; \
    const uint4 rq0 = *(const uint4*)(qn + (size_t)pos0 * 256 + c8), rq1 = *(const uint4*)(qn + (size_t)pos1 * 256 + c8); \
    const int lbase = d ? 8191 - 64 * (n_) - 63 : 64 * (n_); \
    const uint4 rkt0 = *(const uint4*)(kT + (size_t)row0 * 8192 + lbase + c8), rkt1 = *(const uint4*)(kT + (size_t)(row0 + 32) * 8192 + lbase + c8); \
    const float rv = cvec[(size_t)(ctb + (n_)) * 256 + (lt < 129 ? lt : 128)]; \
    bf16_t* sW_ = (bf16_t*)(smem + (buf_) * BUFB); bf16_t* sQK_ = sW_ + 64 * 72; bf16_t* sQ_ = sQK_ + 64 * 72; bf16_t* sKT_ = sQ_ + 64 * 72; bf16_t* sU_ = sKT_ + 64 * 72; \
    float* sV_ = (float*)(smem + (buf_) * BUFB + 5 * 64 * 72 * 2); \
    *(uint4*)(sW_ + row0 * 72 + c8) = rw0; *(uint4*)(sW_ + (row0 + 32) * 72 + c8) = rw1; \
    *(uint4*)(sQK_ + row0 * 72 + c8) = rqk0; *(uint4*)(sQK_ + (row0 + 32) * 72 + c8) = rqk1; \
    *(uint4*)(sU_ + row0 * 72 + c8) = ru0; *(uint4*)(sU_ + (row0 + 32) * 72 + c8) = ru1; \
    *(uint4*)(sQ_ + row0 * 72 + c8) = rq0; *(uint4*)(sQ_ + (row0 + 32) * 72 + c8) = rq1; \
    if (d) { *(uint4*)(sKT_ + row0 * 72 + rc8) = rev8(rkt0); *(uint4*)(sKT_ + (row0 + 32) * 72 + rc8) = rev8(rkt1); } \
    else { *(uint4*)(sKT_ + row0 * 72 + c8) = rkt0; *(uint4*)(sKT_ + (row0 + 32) * 72 + c8) = rkt1; } \
    if (lt < 129) sV_[lt] = rv; } while (0)
#define SCAN_BAR() do { asm volatile("s_waitcnt lgkmcnt(0)" ::: "memory"); __builtin_amdgcn_s_barrier(); asm volatile("" ::: "memory"); } while (0)
  f32x4 S[4][2];
#pragma unroll
  for (int mt = 0; mt < 4; ++mt) { S[mt][0] = (f32x4){0.f, 0.f, 0.f, 0.f}; S[mt][1] = (f32x4){0.f, 0.f, 0.f, 0.f}; }
#define SCAN_LDF(f_, base_, h2_) do { _Pragma("unroll") for (int m2 = 0; m2 < 2; ++m2) { const bf16_t* p_ = (base_) + (16 * (2 * (h2_) + m2) + fr) * 72 + 4 * fq; \
    f_[m2][0] = ld4x2(p_, p_ + 16); f_[m2][1] = ld4x2(p_ + 32, p_ + 48); } } while (0)
#define SCAN_SB() __builtin_amdgcn_sched_barrier(0)
#define SCAN_COMPUTE(n_, buf_) do { \
    const bf16_t* sW = (const bf16_t*)(smem + (buf_) * BUFB); const bf16_t* sQK = sW + 64 * 72; const bf16_t* sQ = sQK + 64 * 72; const bf16_t* sKT = sQ + 64 * 72; const bf16_t* sU = sKT + 64 * 72; \
    const float* sV = (const float*)(smem + (buf_) * BUFB + 5 * 64 * 72 * 2); \
    bf16x8 fA[2][2], fB[2][2]; \
    SCAN_LDF(fA, sW, 0); SCAN_SB(); \
    bf16x8 Sb[2][2]; \
    _Pragma("unroll") for (int nt = 0; nt < 2; ++nt) { Sb[0][nt] = pack8(S[0][nt], S[1][nt]); Sb[1][nt] = pack8(S[2][nt], S[3][nt]); } \
    f32x4 v[4][2], o[4][2]; \
      \
    SCAN_LDF(fB, sW, 1); \
    _Pragma("unroll") for (int m2 = 0; m2 < 2; ++m2) _Pragma("unroll") for (int nt = 0; nt < 2; ++nt) { \
      v[m2][nt] = MFMA16(fA[m2][0], Sb[0][nt], ((f32x4){0.f, 0.f, 0.f, 0.f})); v[m2][nt] = MFMA16(fA[m2][1], Sb[1][nt], v[m2][nt]); } \
    SCAN_SB(); \
    SCAN_LDF(fA, sQ, 0); \
    _Pragma("unroll") for (int m2 = 0; m2 < 2; ++m2) _Pragma("unroll") for (int nt = 0; nt < 2; ++nt) { \
      v[2 + m2][nt] = MFMA16(fB[m2][0], Sb[0][nt], ((f32x4){0.f, 0.f, 0.f, 0.f})); v[2 + m2][nt] = MFMA16(fB[m2][1], Sb[1][nt], v[2 + m2][nt]); } \
    SCAN_SB(); \
    SCAN_LDF(fB, sQ, 1); \
    _Pragma("unroll") for (int m2 = 0; m2 < 2; ++m2) _Pragma("unroll") for (int nt = 0; nt < 2; ++nt) { \
      o[m2][nt] = MFMA16(fA[m2][0], Sb[0][nt], ((f32x4){0.f, 0.f, 0.f, 0.f})); o[m2][nt] = MFMA16(fA[m2][1], Sb[1][nt], o[m2][nt]); } \
    SCAN_SB(); \
    SCAN_LDF(fA, sKT, 0); \
    _Pragma("unroll") for (int m2 = 0; m2 < 2; ++m2) _Pragma("unroll") for (int nt = 0; nt < 2; ++nt) { \
      o[2 + m2][nt] = MFMA16(fB[m2][0], Sb[0][nt], ((f32x4){0.f, 0.f, 0.f, 0.f})); o[2 + m2][nt] = MFMA16(fB[m2][1], Sb[1][nt], o[2 + m2][nt]); } \
    SCAN_SB(); \
    bf16x8 Vb[2][2], Vkb[2][2]; \
    {   \
      _Pragma("unroll") for (int mt = 0; mt < 4; ++mt) { \
        const float4 eg = *(const float4*)(sV + 16 * mt + 4 * fq); \
        _Pragma("unroll") for (int nt = 0; nt < 2; ++nt) { \
          const uint2 u = *(const uint2*)(sU + (32 * wave + 16 * nt + fr) * 72 + 16 * mt + 4 * fq); \
          v[mt][nt][0] = bflo(u.x) - v[mt][nt][0]; v[mt][nt][1] = bfhi(u.x) - v[mt][nt][1]; v[mt][nt][2] = bflo(u.y) - v[mt][nt][2]; v[mt][nt][3] = bfhi(u.y) - v[mt][nt][3]; \
          o[mt][nt][0] *= eg.x; o[mt][nt][1] *= eg.y; o[mt][nt][2] *= eg.z; o[mt][nt][3] *= eg.w; } \
      } \
      _Pragma("unroll") for (int nt = 0; nt < 2; ++nt) { \
        Vb[0][nt] = pack8(v[0][nt], v[1][nt]); Vb[1][nt] = pack8(v[2][nt], v[3][nt]); } \
      _Pragma("unroll") for (int mt = 0; mt < 4; ++mt) { \
        const float4 ek = *(const float4*)(sV + 64 + 16 * mt + 4 * fq); \
        _Pragma("unroll") for (int nt = 0; nt < 2; ++nt) { v[mt][nt][0] *= ek.x; v[mt][nt][1] *= ek.y; v[mt][nt][2] *= ek.z; v[mt][nt][3] *= ek.w; } } \
      _Pragma("unroll") for (int nt = 0; nt < 2; ++nt) { \
        Vkb[0][nt] = pack8(v[0][nt], v[1][nt]); Vkb[1][nt] = pack8(v[2][nt], v[3][nt]); } \
    } \
    const float gl = sV[128]; \
    SCAN_SB(); \
    SCAN_LDF(fB, sKT, 1); \
    _Pragma("unroll") for (int m2 = 0; m2 < 2; ++m2) _Pragma("unroll") for (int nt = 0; nt < 2; ++nt) { \
      f32x4 a; a[0] = S[m2][nt][0] * gl; a[1] = S[m2][nt][1] * gl; a[2] = S[m2][nt][2] * gl; a[3] = S[m2][nt][3] * gl; \
      a = MFMA16(fA[m2][0], Vkb[0][nt], a); S[m2][nt] = MFMA16(fA[m2][1], Vkb[1][nt], a); } \
    SCAN_SB(); \
    SCAN_LDF(fA, sQK, 0); \
    _Pragma("unroll") for (int m2 = 0; m2 < 2; ++m2) _Pragma("unroll") for (int nt = 0; nt < 2; ++nt) { \
      f32x4 a; a[0] = S[2 + m2][nt][0] * gl; a[1] = S[2 + m2][nt][1] * gl; a[2] = S[2 + m2][nt][2] * gl; a[3] = S[2 + m2][nt][3] * gl; \
      a = MFMA16(fB[m2][0], Vkb[0][nt], a); S[2 + m2][nt] = MFMA16(fB[m2][1], Vkb[1][nt], a); } \
    SCAN_SB(); \
    SCAN_LDF(fB, sQK, 1); \
    _Pragma("unroll") for (int m2 = 0; m2 < 2; ++m2) _Pragma("unroll") for (int nt = 0; nt < 2; ++nt) { \
      o[m2][nt] = MFMA16(fA[m2][0], Vb[0][nt], o[m2][nt]); o[m2][nt] = MFMA16(fA[m2][1], Vb[1][nt], o[m2][nt]); } \
    SCAN_SB(); \
    _Pragma("unroll") for (int m2 = 0; m2 < 2; ++m2) _Pragma("unroll") for (int nt = 0; nt < 2; ++nt) { \
      o[2 + m2][nt] = MFMA16(fB[m2][0], Vb[0][nt], o[2 + m2][nt]); o[2 + m2][nt] = MFMA16(fB[m2][1], Vb[1][nt], o[2 + m2][nt]); } \
    _Pragma("unroll") for (int mt = 0; mt < 4; ++mt) _Pragma("unroll") for (int e = 0; e < 4; ++e) { \
      const int r_ = 16 * mt + 4 * fq + e; const int pos = d ? 8191 - 64 * (n_) - r_ : 64 * (n_) + r_; \
      O[(size_t)pos * 256] = f2bf(o[mt][0][e]); O[(size_t)pos * 256 + 16] = f2bf(o[mt][1][e]); \
    } } while (0)
  __syncthreads();
  if (loader) SCAN_STAGE(0, 0);
  SCAN_BAR();
#pragma unroll 1
  for (int n = 0; n < 128; ++n) {
    if (loader) { if (n + 1 < 128) SCAN_STAGE(n + 1, ((n + 1) & 1)); }
    else if (wave < 2) SCAN_COMPUTE(n, (n & 1));
    SCAN_BAR();
  }
  asm volatile("s_waitcnt vmcnt(0)" ::: "memory");
  __syncthreads();
#undef SCAN_STAGE
#undef SCAN_BAR
#undef SCAN_COMPUTE
#undef SCAN_LDF
#undef SCAN_SB
}

DI void gdn_finish_tok4(const Params& p, int layer, int tok0, int lane) {
  const float4 g = *(const float4*)(p.gdn_g + layer * 64 + (lane & 15) * 4);
  uint2 a[4], b[4], z[4];
#pragma unroll
  for (int t = 0; t < 4; ++t) {
    const size_t ro = (size_t)(tok0 + t) * 256 + lane * 4;
    a[t] = *(const uint2*)((const bf16_t*)(p.ws + OFF_OF) + ro); b[t] = *(const uint2*)((const bf16_t*)(p.ws + OFF_OB) + ro);
    z[t] = *(const uint2*)((const bf16_t*)(p.ws + OFF_MIX) + (size_t)(tok0 + t) * 1024 + 256 + lane * 4);
  }
#pragma unroll
  for (int t = 0; t < 4; ++t) {
    const float o0 = bflo(a[t].x) + bflo(b[t].x), o1 = bfhi(a[t].x) + bfhi(b[t].x), o2 = bflo(a[t].y) + bflo(b[t].y), o3 = bfhi(a[t].y) + bfhi(b[t].y);
    float ss = o0 * o0 + o1 * o1 + o2 * o2 + o3 * o3;
    ss += __shfl_xor(ss, 1, 64); ss += __shfl_xor(ss, 2, 64); ss += __shfl_xor(ss, 4, 64); ss += __shfl_xor(ss, 8, 64);
    const float rs = rsqrtf(ss * (1.f / 64.f) + 1e-6f);
    uint2 w; w.x = pack2(o0 * rs * g.x * silu(bflo(z[t].x)), o1 * rs * g.y * silu(bfhi(z[t].x)));
    w.y = pack2(o2 * rs * g.z * silu(bflo(z[t].y)), o3 * rs * g.w * silu(bfhi(z[t].y)));
    *(uint2*)((bf16_t*)(p.ws + OFF_MIX) + (size_t)(tok0 + t) * 1024 + 256 + lane * 4) = w;
  }
}

DI void post_token2(const Params& p, int layer, int tok0, int lane) {
  const float* pg = p.post_g + layer * 1024;
  uint2 ob[2][4]; float4 xr[2][4], g[4];
#pragma unroll
  for (int t = 0; t < 2; ++t) {
    const bf16_t* o = (const bf16_t*)(p.ws + OFF_OUTTMP) + (size_t)(tok0 + t) * 1024;
    const float* xp = layer == 0 ? xrow(p, tok0 + t) : p.out + (size_t)(tok0 + t) * 1024;
#pragma unroll
    for (int i = 0; i < 4; ++i) { ob[t][i] = *(const uint2*)(o + i * 256 + lane * 4); xr[t][i] = layer == 0 ? ldnt4(xp + i * 256 + lane * 4) : *(const float4*)(xp + i * 256 + lane * 4); }
  }
#pragma unroll
  for (int i = 0; i < 4; ++i) g[i] = *(const float4*)(pg + i * 256 + lane * 4);
#pragma unroll
  for (int t = 0; t < 2; ++t) {
    float4 v[4]; float ss = 0.f;
#pragma unroll
    for (int i = 0; i < 4; ++i) { const uint2 u = ob[t][i]; v[i] = make_float4(bflo(u.x), bfhi(u.x), bflo(u.y), bfhi(u.y));
      ss += v[i].x * v[i].x + v[i].y * v[i].y + v[i].z * v[i].z + v[i].w * v[i].w; }
    ss = wave_sum(ss);
    const float rs = rsqrtf(ss * (1.f / 1024.f) + 1e-6f);
    float ss2 = 0.f;
#pragma unroll
    for (int i = 0; i < 4; ++i) {
      const float4 x = xr[t][i];
      v[i].x = x.x + v[i].x * rs * g[i].x; v[i].y = x.y + v[i].y * rs * g[i].y; v[i].z = x.z + v[i].z * rs * g[i].z; v[i].w = x.w + v[i].w * rs * g[i].w;
      ss2 += v[i].x * v[i].x + v[i].y * v[i].y + v[i].z * v[i].z + v[i].w * v[i].w;
      *(float4*)(p.out + (size_t)(tok0 + t) * 1024 + i * 256 + lane * 4) = v[i];
    }
    if (layer == 0) {
      ss2 = wave_sum(ss2);
      const float rs2 = rsqrtf(ss2 * (1.f / 1024.f) + 1e-6f);
      bf16_t* dst = (bf16_t*)(p.ws + OFF_X) + (size_t)(tok0 + t) * 1024;
#pragma unroll
      for (int i = 0; i < 4; ++i) { uint2 w; w.x = pack2(v[i].x * rs2, v[i].y * rs2); w.y = pack2(v[i].z * rs2, v[i].w * rs2); *(uint2*)(dst + i * 256 + lane * 4) = w; }
    }
  }
}

#define XB_TMO      128
#define XB_XCNT(j)  (256  + 64 * (j))
#define XB_XSUB(j)  (1280 + 64 * (j))
#define XB_XGEN(j)  (2304 + 64 * (j))
#define XB_TOP      3328
#define XB_TOPGEN   3392
#define XCD_BAR_WORDS 3456
#define XB_SPIN_CAP (1u << 18)
#define XLAS __attribute__((address_space(3)))

__device__ __forceinline__ unsigned xb_ld(unsigned* p)              { return __hip_atomic_load(p, __ATOMIC_RELAXED, __HIP_MEMORY_SCOPE_AGENT); }
__device__ __forceinline__ unsigned xb_add(unsigned* p, unsigned v) { return __hip_atomic_fetch_add(p, v, __ATOMIC_RELAXED, __HIP_MEMORY_SCOPE_AGENT); }
__device__ __forceinline__ unsigned xb_xcc_id() { return (unsigned)__builtin_amdgcn_s_getreg((3 << 11) | 20) & 0xFu; }
#define XB_SPIN(cond, bar) do { unsigned _sp = 0; while (cond) { __builtin_amdgcn_s_sleep(1); \
    if ((++_sp & 255u) == 0u) { if (xb_ld(&(bar)[XB_TMO])) break; if (_sp > XB_SPIN_CAP) { atomicAdd(&(bar)[XB_TMO], 1u); break; } } } } while (0)

struct XcdBarrier {
    unsigned* bar; unsigned x;
    volatile XLAS unsigned* st;
};

__device__ __forceinline__ XcdBarrier xcd_barrier_post(unsigned* bar, volatile XLAS unsigned* st) {
    XcdBarrier b; b.bar = bar; b.x = xb_xcc_id(); b.st = st;
    if (threadIdx.x == 0) (void)xb_add(&bar[XB_XCNT(b.x)], 1u);
    return b;
}
__device__ __forceinline__ void xcd_barrier_complete(unsigned* bar, unsigned x, unsigned& nloc, unsigned& nx) {
    const unsigned G = gridDim.x * gridDim.y * gridDim.z;
    unsigned sum, cnt, mine, sp = 0u;
    for (;;) {
        sum = 0u; cnt = 0u; mine = 0u;
#pragma unroll
        for (unsigned j = 0; j < 16; ++j) { const unsigned c = xb_ld(&bar[XB_XCNT(j)]); sum += c; cnt += (c > 0u) ? 1u : 0u; mine = (j == x) ? c : mine; }
        if (sum == G) break;
        __builtin_amdgcn_s_sleep(1);
        if ((++sp & 255u) == 0u) { if (xb_ld(&bar[XB_TMO])) break; if (sp > XB_SPIN_CAP) { atomicAdd(&bar[XB_TMO], 1u); break; } }
    }
    nloc = mine > 0u ? mine : 1u; nx = cnt > 0u ? cnt : 1u;
}

__device__ __forceinline__ void xcd_barrier(const XcdBarrier& b) {
    asm volatile("s_waitcnt vmcnt(0)" ::: "memory");
    __syncthreads();
    if (threadIdx.x == 0) {
        unsigned* bar = b.bar;
        __builtin_amdgcn_s_waitcnt(0);
        unsigned nloc = b.st[0], nx = b.st[1];
        if (nloc == 0u) { xcd_barrier_complete(bar, b.x, nloc, nx); b.st[0] = nloc; b.st[1] = nx; }
        const unsigned old = xb_add(&bar[XB_XSUB(b.x)], 1u);
        const unsigned gen = old / nloc;
        if (old + 1u == (gen + 1u) * nloc) {
            __builtin_amdgcn_fence(__ATOMIC_RELEASE, "agent");
            asm volatile("s_waitcnt vmcnt(0)" ::: "memory");
            const unsigned og = xb_add(&bar[XB_TOP], 1u);
            const unsigned tg = og / nx;
            if (og + 1u == (tg + 1u) * nx) xb_add(&bar[XB_TOPGEN], 1u);
            else XB_SPIN(xb_ld(&bar[XB_TOPGEN]) == tg, bar);
            __builtin_amdgcn_fence(__ATOMIC_ACQUIRE, "agent");
            xb_add(&bar[XB_XGEN(b.x)], 1u);
            asm volatile("s_waitcnt vmcnt(0)" ::: "memory");
        } else {
            XB_SPIN(xb_ld(&bar[XB_XGEN(b.x)]) == gen, bar);
            __builtin_amdgcn_fence(__ATOMIC_ACQUIRE, "agent");
            asm volatile("s_waitcnt vmcnt(0)" ::: "memory");
        }
    }
    __syncthreads();
}

constexpr int LDS_BYTES = 131072;
__global__ void __launch_bounds__(NT, 2) fwd_megakernel(Params p0) {
  cg::grid_group grid = cg::this_grid();
  extern __shared__ __attribute__((aligned(16))) unsigned char shm[];
  char* smem = (char*)shm;
  PG8_LAS unsigned char* lds = (PG8_LAS unsigned char*)shm;
  const int nb = gridDim.x, bid = blockIdx.x, nw = gridDim.x * (NT / 64);
  __shared__ __attribute__((aligned(16))) unsigned xb_st[4];
  if (threadIdx.x < 4) xb_st[threadIdx.x] = 0u;
  __syncthreads();
  const XcdBarrier xbar = xcd_barrier_post((unsigned*)(p0.ws + OFF_BAR), (volatile XLAS unsigned*)xb_st);
#define GSYNC() xcd_barrier(xbar)
#define PH_BEGIN const Params p = launder(p0); const int tid = ltid(); const int lane = tid & 63; const int gw = bid * (NT / 64) + (tid >> 6); (void)lane; (void)gw;
  { PH_BEGIN phase0(p, tid); }
  grid.sync();
#pragma unroll 1
  for (int layer = 0; layer < 2; ++layer) {
    {
      PH_BEGIN
      InProjEpi epi{p.ws};
      run_gemm(lds, (const bf16_t*)(p.ws + OFF_X), (const bf16_t*)(p.ws + OFF_WIN) + (size_t)layer * NPAD * 1024, NTOK, NPAD, 1024, epi, tid);
    }
    if (layer == 0 && bid >= 192 && bid < 216) {
      PH_BEGIN
      const int l2 = (bid - 192) / 12, c = (bid - 192) - 12 * l2;
      MemKvEpi me{p.ws, l2};
      run_gemm_on(lds, (const bf16_t*)(p.ws + OFF_MEMN), (const bf16_t*)(p.ws + OFF_WMEM) + (size_t)l2 * 512 * 1024, 1536, 512, 1024, me, tid, 12, c);
    }
    GSYNC();
    { PH_BEGIN
      if (nb == 256) {
#pragma unroll 1
        for (int k = 0; k < 6; ++k) na_block(p, layer, (bid & 7) * 192 + (bid >> 3) + 32 * k, smem, tid);
      } else {
#pragma unroll 1
        for (int t = bid; t < 1536; t += nb) na_block(p, layer, t, smem, tid);
      } }
    { PH_BEGIN
#pragma unroll 1
      for (int t = gw; t < NTOK / 8; t += nw) gdn_prep_tok8(p, layer, t, lane); }
    GSYNC();
    { PH_BEGIN
      const int half = tid >> 8;
#pragma unroll 1
      for (int t = bid; t < 1536; t += nb) chunk_task(p, 2 * t + half, smem + half * 36864, tid & 255); }
    GSYNC();
    if (bid < 48) { PH_BEGIN scan_task(p, bid, smem, tid); }
    else { PH_BEGIN
      if (nb == 256) {
        const int x = bid & 7, j = (bid - 48) >> 3;
#pragma unroll 1
        for (int li = j; li < 96; li += 26) fft_task(p, (li >> 4) * 128 + 16 * x + (li & 15), (float2*)smem, tid);
      } else {
#pragma unroll 1
        for (int t = bid - 48; t < 768; t += nb - 48) fft_task(p, t, (float2*)smem, tid);
      }
      if (nb == 256) {
        const int x = bid & 7, j = (bid - 48) >> 3;
#pragma unroll 1
        for (int li = j; li < 96; li += 26) mem_block(p, layer, (3 * x + (li >> 5)) * 32 + (li & 31), smem, tid);
      } else {
#pragma unroll 1
        for (int t = bid - 48; t < 768; t += nb - 48) mem_block(p, layer, t, smem, tid);
      } }
    GSYNC();
    { PH_BEGIN
#pragma unroll 1
      for (int t = gw; t < NTOK / 4; t += nw) gdn_finish_tok4(p, layer, 4 * t, lane); }
    {
      PH_BEGIN
      FnetEpiDirect fe{p.ws};
      { pg8::Gemm g; g.A = (const bf16_t*)(p.ws + OFF_H); g.Bt = (const bf16_t*)(p.ws + OFF_WF) + (size_t)layer * 256 * 512; g.M = NTOK; g.N = 256; g.K = 512;
        pg8::StaticOrder S; S.init(NTOK, 256, (int)gridDim.x, (int)blockIdx.x);
        pg8::gemm_phase<FnetEpiDirect, pg8::StaticOrder, false>(lds, g, S, fe, nullptr, tid);
        __syncthreads(); }
    }
    GSYNC();
    {
      PH_BEGIN
      OutEpi oe{(bf16_t*)(p.ws + OFF_OUTTMP)};
      run_gemm(lds, (const bf16_t*)(p.ws + OFF_MIX), (const bf16_t*)(p.ws + OFF_WOUT) + (size_t)layer * 1024 * 1024, NTOK, 1024, 1024, oe, tid);
    }
    GSYNC();
    { PH_BEGIN
#pragma unroll 1
      for (int t = gw; t < NTOK / 2; t += nw) post_token2(p, layer, 2 * t, lane); }
    if (layer == 0) GSYNC();
  }
}

extern "C" void kernel_launch(void* const* d_in, const int* in_sizes, int n_in, void* d_out, int out_size, void* d_ws, size_t ws_size, hipStream_t stream) {
  static int grid_blocks = 0;
  if (!grid_blocks) {
    int dev = 0, cus = 0, per_cu = 0;
    (void)hipGetDevice(&dev);
    (void)hipDeviceGetAttribute(&cus, hipDeviceAttributeMultiprocessorCount, dev);
    if (hipFuncSetAttribute((const void*)fwd_megakernel, hipFuncAttributeMaxDynamicSharedMemorySize, LDS_BYTES) != hipSuccess) fprintf(stderr, "hipFuncSetAttribute failed\n");
    (void)hipOccupancyMaxActiveBlocksPerMultiprocessor(&per_cu, fwd_megakernel, NT, LDS_BYTES);
    if (per_cu > 1) per_cu = 1;
    grid_blocks = cus * per_cu;
    if (grid_blocks <= 0) { fprintf(stderr, "occupancy query returned %d x %d\n", cus, per_cu); grid_blocks = -1; }
  }
  if (grid_blocks < 0) return;
  if (ws_size < WS_NEED || n_in != 16) { fprintf(stderr, "kernel_launch: need %zu bytes of workspace, got %zu (n_in %d)\n", (size_t)WS_NEED, ws_size, n_in); return; }
  Params p{};
  p.x_prompt = (const float*)d_in[0]; p.x_sample = (const float*)d_in[1]; p.mem_prompt = (const float*)d_in[2]; p.mem_sample = (const float*)d_in[3];
  p.pre_g = (const float*)d_in[4]; p.post_g = (const float*)d_in[5]; p.w_in = (const float*)d_in[6]; p.w_fnet = (const float*)d_in[7];
  p.conv_w = (const float*)d_in[8]; p.a_log = (const float*)d_in[9]; p.dt_bias = (const float*)d_in[10]; p.gdn_g = (const float*)d_in[11];
  p.rpb = (const float*)d_in[12]; p.mem_g = (const float*)d_in[13]; p.w_mem_kv = (const float*)d_in[14]; p.w_out = (const float*)d_in[15];
  p.out = (float*)d_out; p.ws = (unsigned char*)d_ws;
  if (hipMemsetAsync((unsigned char*)d_ws + OFF_BAR, 0, XCD_BAR_WORDS * sizeof(unsigned), stream) != hipSuccess) { fprintf(stderr, "memset failed\n"); return; }
  void* args[] = {&p};
  hipError_t e = hipLaunchCooperativeKernel((void*)fwd_megakernel, dim3(grid_blocks), dim3(NT), args, LDS_BYTES, stream);
  if (e != hipSuccess) fprintf(stderr, "cooperative launch failed: %s (grid %d)\n", hipGetErrorString(e), grid_blocks);
}
```
